# Optimizing an MI355X kernel written in HIP

```python
import jax, jax.numpy as jnp
from jax import lax
import numpy as np

D_MODEL = 1024
BATCH = 16
SEQ = 2048
DEPTH = 1

CONV_DIM = 1024
CONV_KERNEL = 31
CONV_PAD = (CONV_KERNEL - 1) // 2
N_HEADS = 16
N_KV_HEADS = 4
HEAD_DIM = 64
ATTN_DIM = N_HEADS * HEAD_DIM
KV_DIM = N_KV_HEADS * HEAD_DIM
WINDOW = 128
BLOCK = 128
NEG_INF = -1e30
N_BRANCH = 2
IN_DIM = 2 * CONV_DIM + ATTN_DIM + 2 * KV_DIM + N_BRANCH * D_MODEL
PEER_HEADS = 8
PEER_KEY_DIM = 256
PEER_HALF = PEER_KEY_DIM // 2
N_KEYS = 128
N_EXPERTS = N_KEYS * N_KEYS
PEER_TOPK = 16
TOKEN_CHUNK = 128
EPS = 1e-6

kernel_name = "hybrid_conformer_swa_peer_block"


def rmsnorm(x, g):
    xf = x.astype(jnp.float32)
    y = xf * lax.rsqrt(jnp.mean(xf * xf, axis=-1, keepdims=True) + EPS)
    return (y * g.astype(jnp.float32)).astype(x.dtype)


def layernorm(x, g, b):
    xf = x.astype(jnp.float32)
    mu = jnp.mean(xf, axis=-1, keepdims=True)
    var = jnp.mean(jnp.square(xf - mu), axis=-1, keepdims=True)
    y = (xf - mu) * lax.rsqrt(var + EPS)
    return (y * g.astype(jnp.float32) + b.astype(jnp.float32)).astype(x.dtype)


def conformer_conv(a_in, dw_w, dw_b, ln_g, ln_b, w_pw):
    u = a_in[..., :CONV_DIM] * jax.nn.sigmoid(a_in[..., CONV_DIM:])
    u = lax.conv_general_dilated(
        u, dw_w[:, None, :], window_strides=(1,), padding=[(CONV_PAD, CONV_PAD)],
        dimension_numbers=('NWC', 'WIO', 'NWC'), feature_group_count=CONV_DIM) + dw_b
    u = layernorm(u, ln_g, ln_b)
    u = jax.nn.silu(u)
    return u @ w_pw


def windowed_gqa(q, k, v, sink):
    b, s = q.shape[0], q.shape[1]
    nb = s // BLOCK
    grp = N_HEADS // N_KV_HEADS
    span = BLOCK + 2 * WINDOW
    kp = jnp.pad(k, ((0, 0), (WINDOW, WINDOW), (0, 0), (0, 0)))
    vp = jnp.pad(v, ((0, 0), (WINDOW, WINDOW), (0, 0), (0, 0)))
    qb = q.reshape(b, nb, BLOCK, N_KV_HEADS, grp, HEAD_DIM).transpose(1, 0, 2, 3, 4, 5)
    slopes = jnp.exp2(-8.0 * jnp.arange(1, N_HEADS + 1, dtype=jnp.float32) / N_HEADS)
    slopes = slopes.reshape(N_KV_HEADS, grp)
    r = jnp.arange(BLOCK)[:, None]
    c = jnp.arange(span)[None, :]
    dist = jnp.abs(r + WINDOW - c)
    bias = -slopes[:, :, None, None] * dist.astype(jnp.float32)[None, None]
    in_window = dist <= WINDOW
    sink_f = sink.astype(jnp.float32).reshape(N_KV_HEADS, grp)[None, :, :, None]
    scale = HEAD_DIM ** -0.5

    def block_fn(args):
        i, qi = args
        start = i * BLOCK
        ks = lax.dynamic_slice_in_dim(kp, start, span, axis=1)
        vs = lax.dynamic_slice_in_dim(vp, start, span, axis=1)
        key_pos = start - WINDOW + jnp.arange(span)
        valid = in_window & ((key_pos >= 0) & (key_pos < s))[None, :]
        logits = jnp.einsum('bqkgd,bskd->bkgqs', qi, ks).astype(jnp.float32) * scale + bias
        logits = jnp.where(valid, logits, NEG_INF)
        m = jnp.maximum(logits.max(-1), sink_f)
        p = jnp.exp(logits - m[..., None])
        denom = p.sum(-1) + jnp.exp(sink_f - m)
        o = jnp.einsum('bkgqs,bskd->bqkgd', p, vs.astype(jnp.float32))
        o = o / denom.transpose(0, 3, 1, 2)[..., None]
        return o.astype(q.dtype)

    out = lax.map(block_fn, (jnp.arange(nb), qb))
    return out.transpose(1, 0, 2, 3, 4, 5).reshape(b, s, ATTN_DIM)


def peer_ffn(h, w_query, sub_keys, expert_u, expert_v):
    b, s, d = h.shape
    hc_all = h.reshape((b * s) // TOKEN_CHUNK, TOKEN_CHUNK, d)

    def chunk_fn(hc):
        q = (hc @ w_query).reshape(TOKEN_CHUNK, PEER_HEADS, 2, PEER_HALF)
        sc = jnp.einsum('thpd,pnd->thpn', q, sub_keys).astype(jnp.float32)
        vals, idx = lax.top_k(sc, PEER_TOPK)
        cand = vals[:, :, 0, :, None] + vals[:, :, 1, None, :]
        cand_idx = idx[:, :, 0, :, None] * N_KEYS + idx[:, :, 1, None, :]
        cand = cand.reshape(TOKEN_CHUNK, PEER_HEADS, PEER_TOPK * PEER_TOPK)
        cand_idx = cand_idx.reshape(TOKEN_CHUNK, PEER_HEADS, PEER_TOPK * PEER_TOPK)
        top_s, pos = lax.top_k(cand, PEER_TOPK)
        expert_idx = jnp.take_along_axis(cand_idx, pos, axis=-1)
        gate = jax.nn.softmax(top_s, axis=-1)
        u = expert_u[expert_idx]
        act = jax.nn.gelu(jnp.einsum('thkd,td->thk', u, hc).astype(jnp.float32), approximate=False)
        vv = expert_v[expert_idx]
        return jnp.einsum('thk,thkd->td', (gate * act).astype(hc.dtype), vv)

    return lax.map(chunk_fn, hc_all).reshape(b, s, d)


def setup_inputs(seed: int = 0) -> dict:
    key = jax.random.key(seed)
    ks = jax.random.split(key, 18)
    f32 = jnp.float32
    nrm = lambda k, shape, sc: jax.random.normal(k, shape, f32) * sc
    return {
        "x": nrm(ks[0], (BATCH, SEQ, D_MODEL), 1.0),
        "norm1_g": 1.0 + nrm(ks[1], (DEPTH, D_MODEL), 0.02),
        "w_in": nrm(ks[2], (DEPTH, D_MODEL, IN_DIM), D_MODEL ** -0.5),
        "conv_dw_w": nrm(ks[3], (DEPTH, CONV_KERNEL, CONV_DIM), CONV_KERNEL ** -0.5),
        "conv_dw_b": nrm(ks[4], (DEPTH, CONV_DIM), 0.02),
        "conv_ln_g": 1.0 + nrm(ks[5], (DEPTH, CONV_DIM), 0.02),
        "conv_ln_b": nrm(ks[6], (DEPTH, CONV_DIM), 0.02),
        "conv_w_pw": nrm(ks[7], (DEPTH, CONV_DIM, D_MODEL), CONV_DIM ** -0.5),
        "attn_sink": nrm(ks[8], (DEPTH, N_HEADS), 0.5),
        "attn_w_o": nrm(ks[9], (DEPTH, ATTN_DIM, D_MODEL), ATTN_DIM ** -0.5),
        "w_out": nrm(ks[10], (DEPTH, D_MODEL, D_MODEL), D_MODEL ** -0.5),
        "norm2_g": 1.0 + nrm(ks[11], (DEPTH, D_MODEL), 0.02),
        "peer_w_query": nrm(ks[12], (DEPTH, D_MODEL, PEER_HEADS * PEER_KEY_DIM), D_MODEL ** -0.5),
        "peer_sub_keys": nrm(ks[13], (DEPTH, 2, N_KEYS, PEER_HALF), PEER_HALF ** -0.5),
        "peer_u": nrm(ks[14], (DEPTH, N_EXPERTS, D_MODEL), D_MODEL ** -0.5),
        "peer_v": nrm(ks[15], (DEPTH, N_EXPERTS, D_MODEL), 0.25),
        "final_g": 1.0 + nrm(ks[16], (D_MODEL,), 0.02),
    }


def reference(x, norm1_g, w_in, conv_dw_w, conv_dw_b, conv_ln_g, conv_ln_b, conv_w_pw,
              attn_sink, attn_w_o, w_out, norm2_g, peer_w_query, peer_sub_keys,
              peer_u, peer_v, final_g):
    b, s, d = x.shape
    o_conv = 2 * CONV_DIM
    o_q = o_conv + ATTN_DIM
    o_k = o_q + KV_DIM
    o_v = o_k + KV_DIM
    for l in range(DEPTH):
        h = rmsnorm(x, norm1_g[l])
        z = h @ w_in[l]
        conv_in = z[..., :o_conv]
        q = z[..., o_conv:o_q].reshape(b, s, N_HEADS, HEAD_DIM)
        k = z[..., o_q:o_k].reshape(b, s, N_KV_HEADS, HEAD_DIM)
        v = z[..., o_k:o_v].reshape(b, s, N_KV_HEADS, HEAD_DIM)
        gates = jax.nn.sigmoid(z[..., o_v:].astype(jnp.float32)).astype(x.dtype)
        gates = gates.reshape(b, s, N_BRANCH, d)
        conv_out = conformer_conv(conv_in, conv_dw_w[l], conv_dw_b[l], conv_ln_g[l],
                                  conv_ln_b[l], conv_w_pw[l])
        attn_out = windowed_gqa(q, k, v, attn_sink[l]) @ attn_w_o[l]
        merged = gates[:, :, 0, :] * conv_out + gates[:, :, 1, :] * attn_out
        x = x + merged @ w_out[l]
        h2 = rmsnorm(x, norm2_g[l])
        x = x + peer_ffn(h2, peer_w_query[l], peer_sub_keys[l], peer_u[l], peer_v[l])
    return rmsnorm(x, final_g)
```

```cpp
#include <hip/hip_runtime.h>
#include <cstdio>
#include <cstdint>

#ifndef MK_N_LAUNCHES
#define MK_N_LAUNCHES 1
#endif

constexpr int BATCH = 16, SEQ = 2048, D = 1024, M = BATCH * SEQ;
constexpr int CK = 31, CPAD = 15;
constexpr int NH = 16, NKV = 4, HD = 64, KVD = 256, WIN = 128;
constexpr int IN_DIM = 5632;
constexpr int PHD = 8, PKD = 256, PHALF = 128, NKEYS = 128, NEXP = 16384, TOPK = 16;
constexpr float EPS = 1e-6f;
constexpr int NWAVES = 8, NTHREADS = 512;
constexpr float LOG2E = 1.4426950408889634f, QSCALE = 0.125f * 1.4426950408889634f;

typedef unsigned short bf16;
typedef unsigned v4u __attribute__((ext_vector_type(4)));
typedef unsigned v2u __attribute__((ext_vector_type(2)));
typedef float f32x4 __attribute__((ext_vector_type(4)));
typedef float f32x2 __attribute__((ext_vector_type(2)));
typedef __bf16 bf16x2_t __attribute__((ext_vector_type(2)));
#define LAS __attribute__((address_space(3)))

__device__ __forceinline__ int opaque_tid() { int t = threadIdx.x; asm volatile("" : "+v"(t)); return t; }
__device__ __forceinline__ void fmac_s(float& acc, float a, float b) { asm volatile("v_fmac_f32 %0, %1, %2" : "+v"(acc) : "v"(a), "v"(b)); }
__device__ __forceinline__ void mul_s(float& x, float a) { asm volatile("v_mul_f32 %0, %0, %1" : "+v"(x) : "v"(a)); }
__device__ __forceinline__ unsigned pk2(float lo, float hi) { f32x2 v = {lo, hi}; bf16x2_t b = __builtin_convertvector(v, bf16x2_t); return __builtin_bit_cast(unsigned, b); }
__device__ __forceinline__ float bflo(unsigned u) { return __uint_as_float(u << 16); }
__device__ __forceinline__ float bfhi(unsigned u) { return __uint_as_float(u & 0xffff0000u); }
__device__ __forceinline__ float sigmoidf_(float x) { return __builtin_amdgcn_rcpf(1.0f + __builtin_amdgcn_exp2f(x * -1.4426950408889634f)); }
__device__ __forceinline__ float wave_sum(float v) {
#pragma unroll
    for (int o = 1; o < 64; o <<= 1) v += __shfl_xor(v, o);
    return v;
}

namespace pg8 {
typedef unsigned short bf16_t;
typedef short bf16x8 __attribute__((ext_vector_type(8)));
constexpr int BM = 256, BK = 64, HALF = 128, HTB = HALF * BK * 2, STAGE_BYTES = 8 * HTB, NXCD = 8, WGM = 8;

__host__ __device__ __forceinline__ int lds_byte(int r, int c) { const int st = (r >> 4) * 2 + (c >> 5), rr = r & 15, cc = c & 31, ob = rr * 64 + cc * 2; return st * 1024 + (ob ^ (((ob >> 9) & 1) << 5)); }
__host__ __device__ __forceinline__ void stage_rc(int b, int& R, int& C) { const int st = b / 1024, sb = b % 1024, swz = sb ^ (((sb >> 9) & 1) << 5); R = (st >> 1) * 16 + swz / 64; C = (st & 1) * 32 + (swz % 64) / 2; }
__host__ __device__ __forceinline__ int perm32(int rho) { const int n = rho >> 4, i = rho & 15; return 8 * (i >> 2) + 4 * n + (i & 3); }

struct Unit { int pm, pn, g; };
struct Gemm { const bf16_t* A0; const bf16_t* B0; const bf16_t* A1; const bf16_t* B1; int M, N, K; };

struct StaticOrder {
    int nM, nN, nwg, G, c, per;
    __host__ __device__ void init(int M_, int N_, int G_, int c_, int per_) { nM = M_ / BM; nN = N_ / BM; nwg = nM * nN; G = G_; c = c_; per = per_; }
    __host__ __device__ bool next(int i, Unit& u) const {
        const int ti = i / per; u.g = i % per;
        const long L = (long)ti * G + c; if (L >= nwg) return false;
        int wgid = (int)L; { const int q = nwg / NXCD, r = nwg % NXCD, xcd = wgid % NXCD, off = wgid / NXCD; wgid = (xcd < r ? xcd * (q + 1) : r * (q + 1) + (xcd - r) * q) + off; }
        const int nig = WGM * nN, gid = wgid / nig, fm = gid * WGM, gsz = (nM - fm) < WGM ? (nM - fm) : WGM;
        u.pm = fm + ((wgid % nig) % gsz); u.pn = (wgid % nig) / gsz; return true;
    }
};

template <class Epi>
__device__ __forceinline__ void gemm_phase(LAS unsigned char* lds, const Gemm g, const StaticOrder& S, const Epi& E) {
    const int tid = opaque_tid(), wid = __builtin_amdgcn_readfirstlane(tid >> 6), lane = tid & 63, wr = wid >> 2, wc = wid & 3, fr = lane & 15, fq = lane >> 4;
    const int K = g.K, nt = K / BK;
    unsigned voffA[2], voffB[2];
#pragma unroll
    for (int i = 0; i < 2; ++i) { int R, C; stage_rc(tid * 16 + i * 8192, R, C); const int Rb = Epi::PERM ? ((R & ~31) + perm32(R & 31)) : R;
        voffA[i] = (unsigned)(R * K + C) * 2u; voffB[i] = (unsigned)(Rb * K + C) * 2u; }
    const size_t kstep = (size_t)(BK * 2);
    const size_t hstep = (size_t)HALF * K * 2;
    const size_t tstep = 2 * hstep;
    const unsigned ldsw = (unsigned)wid * 1024u;
    const int aoff = lds_byte(wr * 64 + fr, fq * 8), boff = lds_byte(wc * 32 + fr, fq * 8);
#define PG8_SA(b, h) (((b) * 2 + (h)) * HTB)
#define PG8_SB(b, h) ((4 + (b) * 2 + (h)) * HTB)
#define PG8_STAGE(bufoff, gbase, voff) do { _Pragma("unroll") for (int _i = 0; _i < 2; ++_i) \
        __builtin_amdgcn_global_load_lds((const unsigned*)((const char*)(gbase) + (voff)[_i]), (LAS unsigned*)(lds + (bufoff) + ldsw + _i * 8192), 16, 0, 0); } while (0)
#define PG8_LDA(dst, b, h) do { _Pragma("unroll") for (int m = 0; m < 4; ++m) _Pragma("unroll") for (int k = 0; k < 2; ++k) dst[m][k] = *(const LAS bf16x8*)(lds + PG8_SA(b, h) + aoff + m * 2048 + k * 1024); } while (0)
#define PG8_LDB(dst, b, h) do { _Pragma("unroll") for (int n = 0; n < 2; ++n) _Pragma("unroll") for (int k = 0; k < 2; ++k) dst[n][k] = *(const LAS bf16x8*)(lds + PG8_SB(b, h) + boff + n * 2048 + k * 1024); } while (0)
#define PG8_MMA(ai, bj, At, Bt) do { __builtin_amdgcn_s_setprio(1); _Pragma("unroll") for (int m = 0; m < 4; ++m) _Pragma("unroll") for (int n = 0; n < 2; ++n) _Pragma("unroll") for (int k = 0; k < 2; ++k) \
        acc[ai][bj][m][n] = __builtin_amdgcn_mfma_f32_16x16x32_bf16(Bt[n][k], At[m][k], acc[ai][bj][m][n], 0, 0, 0); __builtin_amdgcn_s_setprio(0); } while (0)
#define PG8_WAIT_V(n) asm volatile("s_waitcnt vmcnt(" #n ")" ::: "memory")
#define PG8_WAIT_L(n) asm volatile("s_waitcnt lgkmcnt(" #n ")" ::: "memory")
#define PG8_BAR __builtin_amdgcn_s_barrier()
#define PG8_SCHED __builtin_amdgcn_sched_barrier(0)
    Unit cur, nxt; int ui = 0;
    if (!S.next(0, cur)) return;
    f32x4 acc[2][2][4][2];
#pragma unroll
    for (int a = 0; a < 2; ++a)
#pragma unroll
        for (int b = 0; b < 2; ++b)
#pragma unroll
            for (int m = 0; m < 4; ++m)
#pragma unroll
                for (int n = 0; n < 2; ++n) acc[a][b][m][n] = (f32x4){0.f, 0.f, 0.f, 0.f};
    bf16x8 At[4][2], B0[2][2], B1[2][2];
    const char* cA = (const char*)(cur.g ? g.A1 : g.A0) + (size_t)cur.pm * tstep; const char* cB = (const char*)(cur.g ? g.B1 : g.B0) + (size_t)cur.pn * tstep;
    PG8_STAGE(PG8_SB(0, 0), cB, voffB); PG8_STAGE(PG8_SB(0, 1), cB + hstep, voffB); PG8_STAGE(PG8_SA(0, 0), cA, voffA); PG8_STAGE(PG8_SA(0, 1), cA + hstep, voffA);
    if (wr == 1) PG8_BAR;
    PG8_WAIT_V(2); PG8_BAR;
    PG8_STAGE(PG8_SB(1, 0), cB + kstep, voffB); PG8_STAGE(PG8_SA(1, 0), cA + kstep, voffA); PG8_STAGE(PG8_SB(1, 1), cB + hstep + kstep, voffB);
    PG8_WAIT_V(6); PG8_BAR;
    for (;;) {
        const bool has_next = S.next(ui + 1, nxt);
        const char* nA = has_next ? (const char*)(nxt.g ? g.A1 : g.A0) + (size_t)nxt.pm * tstep : cA; const char* nB = has_next ? (const char*)(nxt.g ? g.B1 : g.B0) + (size_t)nxt.pn * tstep : cB;
        for (int t = 0; t < nt; t += 2) {
            const bool last = (t == nt - 2);
            const char* a1 = cA + (size_t)(t + 1) * kstep;
            const char* a2 = last ? nA : cA + (size_t)(t + 2) * kstep; const char* b2 = last ? nB : cB + (size_t)(t + 2) * kstep;
            const char* a3 = a2 + kstep; const char* b3 = b2 + kstep;
            PG8_LDB(B0, 0, 0); PG8_LDB(B1, 0, 1); PG8_SCHED; PG8_LDA(At, 0, 0); PG8_STAGE(PG8_SA(1, 1), a1 + hstep, voffA);
            PG8_WAIT_V(8); PG8_WAIT_L(0); PG8_BAR; PG8_MMA(0, 0, At, B0); PG8_MMA(0, 1, At, B1); PG8_BAR; PG8_SCHED;
            PG8_LDA(At, 0, 1); PG8_STAGE(PG8_SB(0, 0), b2, voffB); PG8_STAGE(PG8_SB(0, 1), b2 + hstep, voffB); PG8_STAGE(PG8_SA(0, 0), a2, voffA);
            PG8_WAIT_V(8); PG8_WAIT_L(0); PG8_BAR; PG8_MMA(1, 0, At, B0); PG8_MMA(1, 1, At, B1); PG8_BAR; PG8_SCHED;
            PG8_LDB(B0, 1, 0); PG8_LDB(B1, 1, 1); PG8_SCHED; PG8_LDA(At, 1, 0); PG8_STAGE(PG8_SA(0, 1), a2 + hstep, voffA);
            PG8_WAIT_V(8); PG8_WAIT_L(0); PG8_BAR; PG8_MMA(0, 0, At, B0); PG8_MMA(0, 1, At, B1); PG8_BAR; PG8_SCHED;
            PG8_LDA(At, 1, 1); PG8_STAGE(PG8_SB(1, 0), b3, voffB); PG8_STAGE(PG8_SB(1, 1), b3 + hstep, voffB); PG8_STAGE(PG8_SA(1, 0), a3, voffA);
            PG8_WAIT_V(8); PG8_WAIT_L(0); PG8_BAR; PG8_MMA(1, 0, At, B0); PG8_MMA(1, 1, At, B1); PG8_BAR; PG8_SCHED;
        }
        if (wr == 0) PG8_BAR;
        E(acc, cur, wr, wc, fr, fq);
        if (!has_next) break;
        if (!(Epi::CHAIN && cur.g == 0))
#pragma unroll
        for (int a = 0; a < 2; ++a)
#pragma unroll
            for (int b = 0; b < 2; ++b)
#pragma unroll
                for (int m = 0; m < 4; ++m)
#pragma unroll
                    for (int n = 0; n < 2; ++n) acc[a][b][m][n] = (f32x4){0.f, 0.f, 0.f, 0.f};
        cur = nxt; cA = nA; cB = nB; ++ui;
        if (wr == 1) PG8_BAR;
    }
    PG8_WAIT_V(0);
    PG8_BAR;
#undef PG8_SA
#undef PG8_SB
#undef PG8_STAGE
#undef PG8_LDA
#undef PG8_LDB
#undef PG8_MMA
#undef PG8_WAIT_V
#undef PG8_WAIT_L
#undef PG8_BAR
#undef PG8_SCHED
}
}

constexpr size_t MiB = 1u << 20;
constexpr size_t WS_CTL = 0;
constexpr size_t WS_WIN = 2 * MiB, WS_WPW = 13 * MiB, WS_WO = 15 * MiB, WS_WOUT = 17 * MiB, WS_WQ = 19 * MiB, WS_SK = 23 * MiB;
constexpr size_t WS_EU = 24 * MiB, WS_EV = 40 * MiB, WS_ESC = 56 * MiB;
constexpr size_t WS_XN = 88 * MiB, WS_U = 152 * MiB;
constexpr size_t WS_MG = 88 * MiB, WS_XG2 = 152 * MiB;
constexpr size_t WS_G = 216 * MiB;
constexpr size_t WS_QP = 216 * MiB;
constexpr size_t WS_Q = 344 * MiB, WS_K = 408 * MiB, WS_V = 424 * MiB;
constexpr size_t WS_IDX = 344 * MiB, WS_GATE = 360 * MiB;
constexpr size_t WS_CA = 440 * MiB;
constexpr size_t WS_END = 504 * MiB;
constexpr int LDS_BYTES = 147456;
constexpr int MISC_OFF = 131072 + 8192;
constexpr int CW_BAR = 4096;
constexpr size_t CTL_ZERO_BYTES = 65536;

struct Args { const float* in[17]; float* out; unsigned char* ws; int ph_lo, ph_hi; };

struct EpiInProj {
    static constexpr bool PERM = true, CHAIN = false;
    bf16 *U, *Q, *K, *V, *G;
    __device__ __forceinline__ void operator()(f32x4 (&acc)[2][2][4][2], const pg8::Unit& u, int wr, int wc, int fr, int fq) const {
        const int row0 = u.pm * 256 + wr * 64 + fr; const int cw = wc * 32 + 8 * fq;
        if (u.pn < 8) {
#pragma unroll
            for (int ai = 0; ai < 2; ++ai)
#pragma unroll
                for (int m = 0; m < 4; ++m) { const size_t row = (size_t)(row0 + ai * 128 + m * 16);
                    f32x4 a0 = acc[ai][0][m][0], a1 = acc[ai][0][m][1], b0 = acc[ai][1][m][0], b1 = acc[ai][1][m][1];
                    v4u w; w.x = pk2(a0[0] * sigmoidf_(b0[0]), a0[1] * sigmoidf_(b0[1])); w.y = pk2(a0[2] * sigmoidf_(b0[2]), a0[3] * sigmoidf_(b0[3]));
                    w.z = pk2(a1[0] * sigmoidf_(b1[0]), a1[1] * sigmoidf_(b1[1])); w.w = pk2(a1[2] * sigmoidf_(b1[2]), a1[3] * sigmoidf_(b1[3]));
                    *(v4u*)(U + row * 1024 + u.pn * 128 + cw) = w; }
        } else if (u.pn >= 14) {
            const int p = u.pn - 14;
#pragma unroll
            for (int ai = 0; ai < 2; ++ai)
#pragma unroll
                for (int m = 0; m < 4; ++m) { bf16* rowp = G + (size_t)(row0 + ai * 128 + m * 16) * 2048 + p * 128 + cw;
                    float rr[8], gb[8];
#pragma unroll
                    for (int n = 0; n < 2; ++n)
#pragma unroll
                        for (int j = 0; j < 4; ++j) { const float a = acc[ai][0][m][n][j], b = acc[ai][1][m][n][j]; const float eb = __builtin_amdgcn_exp2f(b * -LOG2E);
                            gb[4 * n + j] = __builtin_amdgcn_rcpf(1.0f + eb); rr[4 * n + j] = sigmoidf_(a) * (1.0f + eb); }
                    v4u w; w.x = pk2(rr[0], rr[1]); w.y = pk2(rr[2], rr[3]); w.z = pk2(rr[4], rr[5]); w.w = pk2(rr[6], rr[7]); *(v4u*)rowp = w;
                    w.x = pk2(gb[0], gb[1]); w.y = pk2(gb[2], gb[3]); w.z = pk2(gb[4], gb[5]); w.w = pk2(gb[6], gb[7]); *(v4u*)(rowp + 1024) = w; }
        } else {
            bf16* base; int ld, col0; float sc = 1.0f;
            if (u.pn < 12) { base = Q; ld = 1024; col0 = (u.pn - 8) * 256; sc = QSCALE; }
            else if (u.pn == 12) { base = K; ld = 256; col0 = 0; }
            else { base = V; ld = 256; col0 = 0; }
#pragma unroll
            for (int ai = 0; ai < 2; ++ai)
#pragma unroll
                for (int m = 0; m < 4; ++m) { bf16* rowp = base + (size_t)(row0 + ai * 128 + m * 16) * ld + col0 + cw;
#pragma unroll
                    for (int bj = 0; bj < 2; ++bj) { f32x4 v0 = acc[ai][bj][m][0] * sc, v1 = acc[ai][bj][m][1] * sc;
                        v4u w; w.x = pk2(v0[0], v0[1]); w.y = pk2(v0[2], v0[3]); w.z = pk2(v1[0], v1[1]); w.w = pk2(v1[2], v1[3]);
                        *(v4u*)(rowp + bj * 128) = w; } }
        }
    }
};
struct EpiMerge {
    static constexpr bool PERM = true, CHAIN = true;
    const bf16* G; bf16* MG;
    __device__ __forceinline__ void operator()(f32x4 (&acc)[2][2][4][2], const pg8::Unit& u, int wr, int wc, int fr, int fq) const {
        const int row0 = u.pm * 256 + wr * 64 + fr; const int col0 = u.pn * 256 + wc * 32 + 8 * fq;
#pragma unroll
        for (int ai = 0; ai < 2; ++ai) { const size_t row = (size_t)(row0 + ai * 128);
            const bf16* gp = G + row * 2048 + u.g * 1024 + col0; bf16* mp = MG + row * 1024 + col0;
            v4u gw[4][2];
#pragma unroll
            for (int m = 0; m < 4; ++m)
#pragma unroll
                for (int bj = 0; bj < 2; ++bj) gw[m][bj] = *(const v4u*)(gp + (size_t)(m * 16) * 2048 + bj * 128);
#pragma unroll
            for (int m = 0; m < 4; ++m)
#pragma unroll
                for (int bj = 0; bj < 2; ++bj) { const v4u g4 = gw[m][bj]; f32x4 v0 = acc[ai][bj][m][0], v1 = acc[ai][bj][m][1];
                    v0[0] *= bflo(g4.x); v0[1] *= bfhi(g4.x); v0[2] *= bflo(g4.y); v0[3] *= bfhi(g4.y); v1[0] *= bflo(g4.z); v1[1] *= bfhi(g4.z); v1[2] *= bflo(g4.w); v1[3] *= bfhi(g4.w);
                    if (u.g) { v4u w; w.x = pk2(v0[0], v0[1]); w.y = pk2(v0[2], v0[3]); w.z = pk2(v1[0], v1[1]); w.w = pk2(v1[2], v1[3]); *(v4u*)(mp + (size_t)(m * 16) * 1024 + bj * 128) = w; }
                    else { acc[ai][bj][m][0] = v0; acc[ai][bj][m][1] = v1; } } }
    }
};
struct EpiResid {
    static constexpr bool PERM = false, CHAIN = false;
    const float* X; bf16* XG; float* SSQ;
    __device__ __forceinline__ void operator()(f32x4 (&acc)[2][2][4][2], const pg8::Unit& u, int wr, int wc, int fr, int fq) const {
        const int row0 = u.pm * 256 + wr * 64 + fr; const int col0 = u.pn * 256 + wc * 32 + 4 * fq;
#pragma unroll
        for (int ai = 0; ai < 2; ++ai) {
            f32x4 xv[4][2][2];
#pragma unroll
            for (int m = 0; m < 4; ++m) { const size_t off = (size_t)(row0 + ai * 128 + m * 16) * 1024 + col0;
#pragma unroll
                for (int bj = 0; bj < 2; ++bj)
#pragma unroll
                    for (int n = 0; n < 2; ++n) xv[m][bj][n] = *(const f32x4*)(X + off + bj * 128 + n * 16); }
#pragma unroll
            for (int m = 0; m < 4; ++m) { const int row = row0 + ai * 128 + m * 16; const size_t off = (size_t)row * 1024 + col0; float ss = 0.f;
#pragma unroll
                for (int bj = 0; bj < 2; ++bj)
#pragma unroll
                    for (int n = 0; n < 2; ++n) { const f32x4 x1 = xv[m][bj][n] + acc[ai][bj][m][n];
                        ss += (x1[0] * x1[0] + x1[1] * x1[1]) + (x1[2] * x1[2] + x1[3] * x1[3]);
                        v2u w; w.x = pk2(x1[0], x1[1]); w.y = pk2(x1[2], x1[3]); *(v2u*)(XG + off + bj * 128 + n * 16) = w; }
                ss += __shfl_xor(ss, 16); ss += __shfl_xor(ss, 32);
                if (fq == 0) atomicAdd(SSQ + row, ss); }
        }
    }
};
struct EpiBf16Rs {
    static constexpr bool PERM = true, CHAIN = false;
    bf16* O; const float* SSQ;
    __device__ __forceinline__ void operator()(f32x4 (&acc)[2][2][4][2], const pg8::Unit& u, int wr, int wc, int fr, int fq) const {
        const int row0 = u.pm * 256 + wr * 64 + fr;
        float ssq[2][4];
#pragma unroll
        for (int ai = 0; ai < 2; ++ai)
#pragma unroll
            for (int m = 0; m < 4; ++m) ssq[ai][m] = SSQ[row0 + ai * 128 + m * 16];
        const int sidx = 2 * wc + (fq >> 1), hh = fq & 1;
#pragma unroll
        for (int ai = 0; ai < 2; ++ai)
#pragma unroll
            for (int m = 0; m < 4; ++m) { const int row = row0 + ai * 128 + m * 16; const int tile = row >> 5, r32 = row & 31;
                const float rs = 1.0f / sqrtf(ssq[ai][m] * (1.f / 1024.f) + EPS);
#pragma unroll
                for (int bj = 0; bj < 2; ++bj) { const f32x4 v0 = acc[ai][bj][m][0] * rs, v1 = acc[ai][bj][m][1] * rs;
                    v4u w; w.x = pk2(v0[0], v0[1]); w.y = pk2(v0[2], v0[3]); w.z = pk2(v1[0], v1[1]); w.w = pk2(v1[2], v1[3]);
                    *(v4u*)(O + ((((size_t)(tile * 8 + u.pn) * 2 + bj) * 8 + sidx) * 64 + r32 + 32 * hh) * 8) = w; } }
    }
};

__device__ __forceinline__ void p0_transpose_item(const float* W, int K, int N, bf16* WT, int dst0, LAS float* scr, int kb, int nb, int lane, const float* kscale = nullptr) {
    const int k0 = 64 * kb, n0 = 32 * nb;
#pragma unroll 8
    for (int i = 0; i < 32; ++i) { const int kk = 2 * i + (lane >> 5); float wv_ = W[(size_t)(k0 + kk) * N + n0 + (lane & 31)]; if (kscale) wv_ *= kscale[k0 + kk]; scr[kk * 33 + (lane & 31)] = wv_; }
    asm volatile("s_waitcnt lgkmcnt(0)" ::: "memory");
    const int c = lane & 7;
#pragma unroll
    for (int j = 0; j < 4; ++j) { const int n = (lane >> 3) + 8 * j; const LAS float* s = scr + (8 * c) * 33 + n;
        v4u o; o.x = pk2(s[0 * 33], s[1 * 33]); o.y = pk2(s[2 * 33], s[3 * 33]); o.z = pk2(s[4 * 33], s[5 * 33]); o.w = pk2(s[6 * 33], s[7 * 33]);
        *(v4u*)(WT + (size_t)(dst0 + n) * K + k0 + 8 * c) = o; }
    asm volatile("s_waitcnt lgkmcnt(0)" ::: "memory");
}
__device__ __forceinline__ int glu_row(int n0) {
    if (n0 < 1024) return 256 * (n0 >> 7) + (n0 & 127);
    if (n0 < 2048) { const int n1 = n0 - 1024; return 256 * (n1 >> 7) + 128 + (n1 & 127); }
    if (n0 < 3584) return n0;
    if (n0 < 4608) { const int n1 = n0 - 3584; return 3584 + 256 * (n1 >> 7) + (n1 & 127); }
    { const int n1 = n0 - 4608; return 3584 + 256 * (n1 >> 7) + 128 + (n1 & 127); }
}
__device__ __forceinline__ void cvt_stream(const float* src, bf16* dst, size_t n, size_t gtid, size_t gthreads) {
    for (size_t i = gtid * 8; i < n; i += gthreads * 8) {
        const f32x4 a = *(const f32x4*)(src + i), b = *(const f32x4*)(src + i + 4);
        v4u o; o.x = pk2(a[0], a[1]); o.y = pk2(a[2], a[3]); o.z = pk2(b[0], b[1]); o.w = pk2(b[2], b[3]);
        *(v4u*)(dst + i) = o; }
}
typedef float v16f __attribute__((ext_vector_type(16)));
typedef float v32f __attribute__((ext_vector_type(32)));
typedef unsigned v6u __attribute__((ext_vector_type(6)));
typedef __bf16 v32bf __attribute__((ext_vector_type(32)));
constexpr int E6ROW = 768;
__device__ __forceinline__ void rows_to_fp6(const f32x4 (&t)[8], unsigned char* o2rows, float* inv_scale2, int lane, const float* cscale, LAS float* scr) {
    const int c = lane & 31, hf = lane >> 5;
#pragma unroll
    for (int i = 0; i < 8; ++i) { const int e = i * 256 + lane * 4; *(LAS f32x4*)((LAS unsigned char*)scr + (e >> 5) * 144 + (e & 31) * 4) = t[i]; }
    asm volatile("s_waitcnt lgkmcnt(0)" ::: "memory");
    const LAS f32x4* xr = (const LAS f32x4*)((LAS unsigned char*)scr + lane * 144);
    v16f a, b; float am = 0.f;
#pragma unroll
    for (int j = 0; j < 4; ++j) { f32x4 u = xr[j], w = xr[4 + j];
        if (cscale) { u = u * *(const f32x4*)(cscale + c * 32 + 4 * j); w = w * *(const f32x4*)(cscale + c * 32 + 16 + 4 * j); }
#pragma unroll
        for (int k = 0; k < 4; ++k) { am = fmaxf(am, fmaxf(fabsf(u[k]), fabsf(w[k]))); }
        a[2 * j] = u[0]; b[2 * j] = u[1]; a[2 * j + 1] = u[2]; b[2 * j + 1] = u[3];
        a[8 + 2 * j] = w[0]; b[8 + 2 * j] = w[1]; a[8 + 2 * j + 1] = w[2]; b[8 + 2 * j + 1] = w[3]; }
#pragma unroll
    for (int o = 1; o < 32; o <<= 1) am = fmaxf(am, __shfl_xor(am, o));
    am = fmaxf(am, 1e-30f);
    const float sc = 7.5f / am;
    a = a * sc; b = b * sc;
    const v6u d = __builtin_amdgcn_cvt_scalef32_2xpk16_fp6_f32(a, b, 1.0f);
    unsigned char* ob = o2rows + (size_t)hf * E6ROW + c * 8;
    *(v2u*)(ob) = (v2u){d[0], d[1]}; *(v2u*)(ob + 256) = (v2u){d[2], d[3]}; *(v2u*)(ob + 512) = (v2u){d[4], d[5]};
    if (c == 0) inv_scale2[hf] = am * (1.0f / 7.5f);
    asm volatile("s_waitcnt lgkmcnt(0)" ::: "memory");
}
__device__ __forceinline__ void rms_row_to_bf16(const float* xrow, const float* g, bf16* orow, int lane) {
    const f32x4* xr = (const f32x4*)xrow + lane; const f32x4* gr = (const f32x4*)g + lane;
    f32x4 v[4]; float s = 0.f;
#pragma unroll
    for (int j = 0; j < 4; ++j) { v[j] = xr[64 * j]; s += (v[j][0] * v[j][0] + v[j][1] * v[j][1]) + (v[j][2] * v[j][2] + v[j][3] * v[j][3]); }
    const float rs = 1.0f / sqrtf(wave_sum(s) * (1.f / 1024.f) + EPS);
    v2u* o8 = (v2u*)orow + lane;
#pragma unroll
    for (int j = 0; j < 4; ++j) { const f32x4 gg = gr[64 * j]; v2u o; o.x = pk2(v[j][0] * rs * gg[0], v[j][1] * rs * gg[1]); o.y = pk2(v[j][2] * rs * gg[2], v[j][3] * rs * gg[3]); o8[64 * j] = o; }
}

__device__ __forceinline__ void conv_phase(LAS unsigned char* lds, const bf16* U, bf16* CA, const float* dw_w, const float* dw_b, const float* ln_g, const float* ln_b, int vcu, int G) {
    const int tid = opaque_tid(), lane = tid & 63, wave = tid >> 6;
    const int c0 = 2 * tid;
    constexpr int TT = 32, ROWS = TT + 2 * CPAD, TILE_B = ROWS * 2048;
    f32x2 wv[CK];
#pragma unroll
    for (int j = 0; j < CK; ++j) wv[j] = *(const f32x2*)(dw_w + j * 1024 + c0);
    const f32x2 bi = *(const f32x2*)(dw_b + c0), lg = *(const f32x2*)(ln_g + c0), lb = *(const f32x2*)(ln_b + c0);
    LAS float* red = (LAS float*)(lds + TILE_B);
    LAS float* stat = red + 512;
    const LAS unsigned char* xb = lds + c0 * 2;
    for (int item = vcu; item < BATCH * (SEQ / TT); item += G) {
        const int b = item / (SEQ / TT), t0 = (item % (SEQ / TT)) * TT;
#pragma unroll
        for (int hb = 0; hb < 2; ++hb) {
            v4u val[8];
#pragma unroll
            for (int it = 0; it < 8; ++it) { const int i = tid + (hb * 8 + it) * NTHREADS; const int row = i >> 7, ch = i & 127, tt = t0 - CPAD + row; const bool ok = (i < ROWS * 128) && (tt >= 0) && (tt < SEQ);
                val[it] = *(const v4u*)(U + ((size_t)b * SEQ + (ok ? tt : t0)) * 1024 + ch * 8); if (!ok) val[it] = (v4u){0u, 0u, 0u, 0u}; }
#pragma unroll
            for (int it = 0; it < 8; ++it) { const int i = tid + (hb * 8 + it) * NTHREADS; const int row = i >> 7, ch = i & 127; if (i < ROWS * 128) *(LAS v4u*)(lds + row * 2048 + ch * 16) = val[it]; }
        }
        __syncthreads();
#pragma unroll 1
        for (int rd = 0; rd < 2; ++rd) {
            const LAS unsigned char* xr = xb + rd * 16 * 2048;
            float ac0[16], ac1[16];
#pragma unroll
            for (int t = 0; t < 16; ++t) { ac0[t] = bi[0]; ac1[t] = bi[1]; }
#pragma clang loop unroll(full)
            for (int r = 0; r < 16 + 2 * CPAD; ++r) {
                const unsigned raw = *(const LAS unsigned*)(xr + r * 2048); const float x0 = bflo(raw), x1 = bfhi(raw);
#pragma clang loop unroll(full)
                for (int j = 0; j < CK; ++j) { const int t = r - j; if (t >= 0 && t < 16) { fmac_s(ac0[t], wv[j][0], x0); fmac_s(ac1[t], wv[j][1], x1); } }
            }
            float v[32];
#pragma unroll
            for (int t = 0; t < 16; ++t) { v[2 * t] = ac0[t] + ac1[t]; v[2 * t + 1] = ac0[t] * ac0[t] + ac1[t] * ac1[t]; }
#pragma unroll
            for (int o = 32, n = 16; n >= 1; o >>= 1, n >>= 1) { const bool hi = (lane & o) != 0;
#pragma unroll
                for (int k = 0; k < n; ++k) { const float a = v[k], bb = v[k + n]; const float send = hi ? a : bb, keep = hi ? bb : a; v[k] = keep + __shfl_xor(send, o); } }
            const float rr = v[0] + __shfl_xor(v[0], 1);
            if ((lane & 1) == 0) red[wave * 32 + (lane >> 1)] = rr;
            __syncthreads();
            if (tid < 16) { float s1 = 0.f, s2 = 0.f;
#pragma unroll
                for (int w = 0; w < 8; ++w) { s1 += red[w * 32 + 2 * tid]; s2 += red[w * 32 + 2 * tid + 1]; }
                const float mean = s1 * (1.f / 1024.f); const float var = s2 * (1.f / 1024.f) - mean * mean;
                stat[2 * tid] = mean; stat[2 * tid + 1] = 1.0f / sqrtf(var + EPS); }
            __syncthreads();
            bf16* Cb = CA + ((size_t)b * SEQ + t0 + 16 * rd) * 1024 + c0;
#pragma unroll
            for (int t = 0; t < 16; ++t) { const float mean = stat[2 * t], rstd = stat[2 * t + 1];
                float y0 = (ac0[t] - mean) * rstd * lg[0] + lb[0], y1 = (ac1[t] - mean) * rstd * lg[1] + lb[1];
                y0 = y0 * sigmoidf_(y0); y1 = y1 * sigmoidf_(y1);
                *(unsigned*)(Cb + (size_t)t * 1024) = pk2(y0, y1); }
            __syncthreads();
        }
    }
}

namespace att {
typedef short bf16x8 __attribute__((ext_vector_type(8)));
typedef short s16x4 __attribute__((ext_vector_type(4)));
typedef float f32x16 __attribute__((ext_vector_type(16)));
constexpr int KP = 144, SPAN = 320, VOFF = SPAN * KP, WSTG = 2 * SPAN * KP;
__device__ __forceinline__ s16x4 vtr(const LAS unsigned char* p) { return __builtin_bit_cast(s16x4, __builtin_amdgcn_ds_read_tr16_b64_v4i16((LAS s16x4*)p)); }
__device__ __forceinline__ void attn_phase(LAS unsigned char* lds, const bf16* Q, const bf16* K, const bf16* V, bf16* AO, const float* sink, int vcu, int G) {
    const int tid = opaque_tid(), lane = tid & 63, wave = __builtin_amdgcn_readfirstlane(tid >> 6), r32 = lane & 31, hh = lane >> 5;
    v4u kreg[5], vreg[5];
#define ATT_STAGE_LOAD(UNIT) do { const int qb_ = (UNIT) % (SEQ / 64), kvh_ = ((UNIT) / (SEQ / 64)) % NKV, b_ = (UNIT) / ((SEQ / 64) * NKV); const int t0_ = qb_ * 64, s0_ = t0_ - WIN; \
        _Pragma("unroll") for (int it = 0; it < 5; ++it) { const int i = tid + it * NTHREADS; const int row = i >> 3, ch = i & 7, sp = s0_ + row; const bool ok = (sp >= 0) && (sp < SEQ); \
            const size_t go = ((size_t)b_ * SEQ + (ok ? sp : t0_)) * KVD + kvh_ * 64 + ch * 8; kreg[it] = *(const v4u*)(K + go); vreg[it] = *(const v4u*)(V + go); } } while (0)
    if (vcu < BATCH * NKV * (SEQ / 64)) ATT_STAGE_LOAD(vcu);
    for (int unit = vcu; unit < BATCH * NKV * (SEQ / 64); unit += G) {
        const int qb = unit % (SEQ / 64), kvh = (unit / (SEQ / 64)) % NKV, b = unit / ((SEQ / 64) * NKV);
        const int t0 = qb * 64;
#pragma unroll
        for (int it = 0; it < 5; ++it) { const int i = tid + it * NTHREADS; const int row = i >> 3, ch = i & 7;
            *(LAS v4u*)(lds + row * KP + ch * 16) = kreg[it]; *(LAS v4u*)(lds + VOFF + row * KP + ch * 16) = vreg[it]; }
        if (unit + G < BATCH * NKV * (SEQ / 64)) ATT_STAGE_LOAD(unit + G);
        __syncthreads();
        {
            const int head = kvh * 4 + (wave >> 1), qoff = (wave & 1) * 32, q0 = t0 + qoff;
            const float slope2 = exp2f(-0.5f * (float)(head + 1)) * LOG2E, sink2 = sink[head] * LOG2E;
            LAS unsigned char* stg = lds + WSTG + wave * (32 * KP);
            const size_t qbase = ((size_t)b * SEQ + q0) * 1024 + head * 64;
#pragma unroll
            for (int i = 0; i < 4; ++i) { const int id = i * 64 + lane, row = id >> 3, ch = id & 7; *(LAS v4u*)(stg + row * KP + ch * 16) = *(const v4u*)(Q + qbase + (size_t)row * 1024 + ch * 8); }
            bf16x8 qf[4];
#pragma unroll
            for (int s = 0; s < 4; ++s) qf[s] = *(const LAS bf16x8*)(stg + r32 * KP + (2 * s + hh) * 16);
            float m = sink2, l = (hh == 0) ? 1.0f : 0.0f;
            f32x16 O0, O1, negm;
#pragma unroll
            for (int r = 0; r < 16; ++r) { O0[r] = 0.f; O1[r] = 0.f; negm[r] = -sink2; }
            const int q4 = (lane & 15) >> 2, p4 = lane & 3, g16 = (lane >> 4) & 1;
#pragma unroll 1
            for (int it = 0; it < 9; ++it) {
                const int j = (it & 1) ? 4 - ((it + 1) >> 1) : 4 + (it >> 1);
                const int kt0 = q0 - WIN + 32 * j;
                if (kt0 < 0 || kt0 >= SEQ) continue;
                const int lrow0 = qoff + 32 * j;
                f32x16 sa = negm;
#pragma unroll
                for (int s = 0; s < 4; ++s) { const bf16x8 kf = *(const LAS bf16x8*)(lds + (lrow0 + r32) * KP + 32 * s + 16 * hh); sa = __builtin_amdgcn_mfma_f32_32x32x16_bf16(kf, qf[s], sa, 0, 0, 0); }
                const float cf = (float)(WIN - 32 * j + r32 - 4 * hh);
                if (j == 0 || j == 8) {
#pragma unroll
                    for (int r = 0; r < 16; ++r) { const float d = cf - (float)((r & 3) + 8 * (r >> 2)); float v = fmaf(-slope2, fabsf(d), sa[r]); v = (fabsf(d) > (float)WIN) ? -1e30f : v; sa[r] = v; }
                } else {
#pragma unroll
                    for (int r = 0; r < 16; ++r) { const float d = cf - (float)((r & 3) + 8 * (r >> 2)); sa[r] = fmaf(-slope2, fabsf(d), sa[r]); }
                }
                float tmax = fmaxf(fmaxf(sa[0], sa[1]), sa[2]);
#pragma unroll
                for (int r = 3; r < 15; r += 2) tmax = fmaxf(fmaxf(tmax, sa[r]), sa[r + 1]);
                tmax = fmaxf(tmax, sa[15]);
                if (__any(tmax > 16.0f)) {
                    tmax = fmaxf(tmax, __shfl_xor(tmax, 32));
                    const float dl = fmaxf(tmax, 0.f), alpha = __builtin_amdgcn_exp2f(-dl); m += dl; l *= alpha;
#pragma unroll
                    for (int r = 0; r < 16; ++r) { O0[r] *= alpha; O1[r] *= alpha; sa[r] -= dl; negm[r] = -m; }
                }
                float ls0 = 0.f, ls1 = 0.f;
#pragma unroll
                for (int r = 0; r < 16; r += 2) { sa[r] = __builtin_amdgcn_exp2f(sa[r]); sa[r + 1] = __builtin_amdgcn_exp2f(sa[r + 1]); ls0 += sa[r]; ls1 += sa[r + 1]; }
                l += ls0 + ls1;
                v4u pw0, pw1;
                pw0.x = pk2(sa[0], sa[1]); pw0.y = pk2(sa[2], sa[3]); pw0.z = pk2(sa[4], sa[5]); pw0.w = pk2(sa[6], sa[7]);
                pw1.x = pk2(sa[8], sa[9]); pw1.y = pk2(sa[10], sa[11]); pw1.z = pk2(sa[12], sa[13]); pw1.w = pk2(sa[14], sa[15]);
                const bf16x8 pb0 = __builtin_bit_cast(bf16x8, pw0), pb1 = __builtin_bit_cast(bf16x8, pw1);
                const LAS unsigned char* vb = lds + VOFF + (lrow0 + 4 * hh + q4) * KP + (16 * g16 + 4 * p4) * 2;
#pragma unroll
                for (int s2 = 0; s2 < 2; ++s2) {
                    const s16x4 a0l = vtr(vb + (16 * s2) * KP), a0h = vtr(vb + (16 * s2 + 8) * KP);
                    const s16x4 a1l = vtr(vb + (16 * s2) * KP + 64), a1h = vtr(vb + (16 * s2 + 8) * KP + 64);
                    const bf16x8 A0 = (bf16x8){a0l[0], a0l[1], a0l[2], a0l[3], a0h[0], a0h[1], a0h[2], a0h[3]};
                    const bf16x8 A1 = (bf16x8){a1l[0], a1l[1], a1l[2], a1l[3], a1h[0], a1h[1], a1h[2], a1h[3]};
                    O0 = __builtin_amdgcn_mfma_f32_32x32x16_bf16(A0, s2 ? pb1 : pb0, O0, 0, 0, 0);
                    O1 = __builtin_amdgcn_mfma_f32_32x32x16_bf16(A1, s2 ? pb1 : pb0, O1, 0, 0, 0);
                }
            }
            const float inv = 1.0f / (l + __shfl_xor(l, 32));
#pragma unroll
            for (int g4 = 0; g4 < 4; ++g4) { v2u w0, w1;
                w0.x = pk2(O0[4 * g4] * inv, O0[4 * g4 + 1] * inv); w0.y = pk2(O0[4 * g4 + 2] * inv, O0[4 * g4 + 3] * inv);
                w1.x = pk2(O1[4 * g4] * inv, O1[4 * g4 + 1] * inv); w1.y = pk2(O1[4 * g4 + 2] * inv, O1[4 * g4 + 3] * inv);
                *(LAS v2u*)(stg + r32 * KP + (8 * g4 + 4 * hh) * 2) = w0; *(LAS v2u*)(stg + r32 * KP + (32 + 8 * g4 + 4 * hh) * 2) = w1; }
#pragma unroll
            for (int i = 0; i < 4; ++i) { const int id = i * 64 + lane, row = id >> 3, ch = id & 7; *(v4u*)(AO + qbase + (size_t)row * 1024 + ch * 8) = *(const LAS v4u*)(stg + row * KP + ch * 16); }
        }
        __syncthreads();
    }
}
#undef ATT_STAGE_LOAD
}

namespace tk {
typedef short bf16x8 __attribute__((ext_vector_type(8)));
typedef float f32x16 __attribute__((ext_vector_type(16)));
constexpr int SKP = 272;
#define TK_CAND50(X) X(0,0,0) X(1,0,1) X(2,0,2) X(3,0,3) X(4,0,4) X(5,0,5) X(6,0,6) X(7,0,7) X(8,0,8) X(9,0,9) X(10,0,10) X(11,0,11) X(12,0,12) X(13,0,13) X(14,0,14) X(15,0,15) X(16,1,0) X(17,1,1) X(18,1,2) X(19,1,3) X(20,1,4) X(21,1,5) X(22,1,6) X(23,1,7) X(24,2,0) X(25,2,1) X(26,2,2) X(27,2,3) X(28,2,4) X(29,3,0) X(30,3,1) X(31,3,2) X(32,3,3) X(33,4,0) X(34,4,1) X(35,4,2) X(36,5,0) X(37,5,1) X(38,6,0) X(39,6,1) X(40,7,0) X(41,7,1) X(42,8,0) X(43,9,0) X(44,10,0) X(45,11,0) X(46,12,0) X(47,13,0) X(48,14,0) X(49,15,0)
#define TK_PAIR25(X) X(0,0,0,2,1) X(1,0,1,2,2) X(2,0,2,2,3) X(3,0,3,2,4) X(4,0,4,3,0) X(5,0,5,3,1) X(6,0,6,3,2) X(7,0,7,3,3) X(8,0,8,4,0) X(9,0,9,4,1) X(10,0,10,4,2) X(11,0,11,5,0) X(12,0,12,5,1) X(13,0,13,6,0) X(14,0,14,6,1) X(15,0,15,7,0) X(16,1,0,7,1) X(17,1,1,8,0) X(18,1,2,9,0) X(19,1,3,10,0) X(20,1,4,11,0) X(21,1,5,12,0) X(22,1,6,13,0) X(23,1,7,14,0) X(24,2,0,15,0)
template <int OFF> __device__ __forceinline__ void sort16(float (&v)[64]) {
#pragma unroll
    for (int k = 2; k <= 16; k <<= 1)
#pragma unroll
        for (int j = k >> 1; j > 0; j >>= 1)
#pragma unroll
            for (int i = 0; i < 16; ++i) { const int l = i ^ j; if (l > i) { const float a = v[OFF + i], b = v[OFF + l]; const float hi = fmaxf(a, b), lo = fminf(a, b);
                if ((i & k) == 0) { v[OFF + i] = hi; v[OFF + l] = lo; } else { v[OFF + i] = lo; v[OFF + l] = hi; } } }
}
template <int OFF> __device__ __forceinline__ void merge16(float (&v)[64]) {
#pragma unroll
    for (int j = 8; j > 0; j >>= 1)
#pragma unroll
        for (int i = 0; i < 16; ++i) { const int l = i ^ j; if (l > i) { const float a = v[OFF + i], b = v[OFF + l]; v[OFF + i] = fmaxf(a, b); v[OFF + l] = fminf(a, b); } }
}
template <int A, int B> __device__ __forceinline__ void top16_merge(float (&v)[64]) {
#pragma unroll
    for (int i = 0; i < 16; ++i) v[A + i] = fmaxf(v[A + i], v[B + 15 - i]);
    merge16<A>(v);
}
__device__ __forceinline__ void top16_of_64(float (&v)[64]) {
    sort16<0>(v); sort16<16>(v); sort16<32>(v); sort16<48>(v);
    top16_merge<0, 16>(v); top16_merge<32, 48>(v); top16_merge<0, 32>(v);
}
__device__ __forceinline__ void topk_phase(LAS unsigned char* lds, const bf16* QP, const bf16* SKb, int* IDX, float* GATE, int vcu, int G) {
    const int tid = opaque_tid(), lane = tid & 63, wave = __builtin_amdgcn_readfirstlane(tid >> 6), r32 = lane & 31, hh = lane >> 5;
    for (int i = tid; i < 256 * 16; i += NTHREADS) { const int row = i >> 4, ch = i & 15; *(LAS v4u*)(lds + row * SKP + ch * 16) = *(const v4u*)(SKb + row * 128 + ch * 8); }
    __syncthreads();
    for (int unit = vcu * NWAVES + wave; unit < (M / 32) * PHD; unit += G * NWAVES) {
        const int tile = unit >> 3, h = unit & 7; const int tok = tile * 32 + r32;
        float L[2][16];
#pragma unroll
        for (int p = 0; p < 2; ++p) {
            bf16x8 qf[8];
#pragma unroll
            for (int sidx = 0; sidx < 8; ++sidx) qf[sidx] = *(const bf16x8*)(QP + ((((size_t)(tile * 8 + h) * 2 + p) * 8 + sidx) * 64 + lane) * 8);
            float v[64];
#define TK_KT(kt) { f32x16 acc; \
                _Pragma("unroll") for (int r = 0; r < 16; ++r) acc[r] = 0.f; \
                _Pragma("unroll") for (int sidx = 0; sidx < 8; ++sidx) { const bf16x8 kf = *(const LAS bf16x8*)(lds + (p * 128 + 32 * kt + r32) * SKP + 32 * sidx + 16 * hh); acc = __builtin_amdgcn_mfma_f32_32x32x16_bf16(kf, qf[sidx], acc, 0, 0, 0); } \
                _Pragma("unroll") for (int r = 0; r < 16; ++r) { const unsigned kidx = (unsigned)(32 * kt + (r & 3) + 8 * (r >> 2)); v[16 * kt + r] = __uint_as_float(((__float_as_uint(acc[r]) & 0xffffff80u) | (unsigned)(hh << 2)) | kidx); } \
                sort16<16 * kt>(v); __builtin_amdgcn_sched_barrier(0); }
            TK_KT(0) TK_KT(1) top16_merge<0, 16>(v); __builtin_amdgcn_sched_barrier(0);
            TK_KT(2) TK_KT(3) top16_merge<32, 48>(v); __builtin_amdgcn_sched_barrier(0);
            top16_merge<0, 32>(v); __builtin_amdgcn_sched_barrier(0);
#undef TK_KT
            float t[16];
#pragma unroll
            for (int i = 0; i < 16; ++i) t[i] = __shfl_xor(v[15 - i], 32);
#pragma unroll
            for (int i = 0; i < 16; ++i) v[i] = fmaxf(v[i], t[i]);
            merge16<0>(v);
#pragma unroll
            for (int i = 0; i < 16; ++i) L[p][i] = v[i];
        }
        float sm[25];
#define X(c, i0, j0, i1, j1) { const float s0 = L[0][i0] + L[1][j0], s1 = L[0][i1] + L[1][j1]; sm[c] = hh ? s1 : s0; }
        TK_PAIR25(X)
#undef X
        float v[64];
#pragma unroll
        for (int c = 0; c < 25; ++c) v[c] = sm[c];
#pragma unroll
        for (int c = 25; c < 32; ++c) v[c] = -3.0e38f;
        sort16<0>(v); sort16<16>(v); top16_merge<0, 16>(v);
        float T;
        { float t[16];
#pragma unroll
          for (int i = 0; i < 16; ++i) t[i] = __shfl_xor(v[15 - i], 32);
#pragma unroll
          for (int i = 0; i < 16; ++i) t[i] = fmaxf(v[i], t[i]);
          T = fminf(fminf(t[0], t[1]), t[2]);
#pragma unroll
          for (int i = 3; i < 15; i += 2) T = fminf(fminf(T, t[i]), t[i + 1]);
          T = fminf(T, t[15]); }
        const float smax = L[0][0] + L[1][0];
        unsigned ia[16], ib[16];
#pragma unroll
        for (int i = 0; i < 16; ++i) { ia[i] = (__float_as_uint(L[0][i]) & 127u) << 7; ib[i] = __float_as_uint(L[1][i]) & 127u; }
        float pe[25]; float den = 0.f; int cnt = 0;
#pragma unroll
        for (int c = 0; c < 25; ++c) { const bool sel = sm[c] >= T; const float e = __builtin_amdgcn_exp2f((sm[c] - smax) * LOG2E); pe[c] = e; den += sel ? e : 0.f; cnt += sel ? 1 : 0; }
        den += __shfl_xor(den, 32);
        const int ocnt = __shfl_xor(cnt, 32);
        int pos = hh ? ocnt : 0;
        const float inv = 1.0f / den;
        const size_t ob = (size_t)tok * 128 + h * 16;
#define X(c, i0, j0, i1, j1) { const unsigned e0 = ia[i0] + ib[j0], e1 = ia[i1] + ib[j1]; const unsigned em = hh ? e1 : e0; \
            const bool sel = sm[c] >= T; \
            if (sel && pos < 16) { GATE[ob + pos] = pe[c] * inv; IDX[ob + pos] = (int)em; } \
            pos += sel ? 1 : 0; }
        TK_PAIR25(X)
#undef X
    }
}
}

__device__ __forceinline__ float dot2bf(unsigned a, unsigned b, float c) { return __builtin_amdgcn_fdot2_f32_bf16(__builtin_bit_cast(bf16x2_t, a), __builtin_bit_cast(bf16x2_t, b), c, false); }
__device__ __forceinline__ float gelu_erf(float x) { return 0.5f * x * (1.0f + erff(x * 0.70710678118654752f)); }
__device__ __forceinline__ void gather_phase(const bf16* XG2, const float* SSQ, const unsigned char* EU, const unsigned char* EV, const float* SU, const float* SV, const int* IDX, const float* GATE, float* WGT, const float* fg, float* OUT, int vcu, int G) {
    const int tid = opaque_tid(), lane = tid & 63, wave = tid >> 6, c32 = lane & 31, hf = lane >> 5;
    const int emap = 16 * (lane & 3) + 2 * ((lane >> 2) & 7) + hf;
    const unsigned loff = (unsigned)c32 * 8u;
    for (int tok = vcu * NWAVES + wave; tok < M; tok += G * NWAVES) {
        unsigned hq[16];
        { const v4u* hp = (const v4u*)(XG2 + (size_t)tok * 1024 + c32 * 32);
#pragma unroll
          for (int j = 0; j < 4; ++j) { const v4u w = hp[j]; hq[4 * j] = w.x; hq[4 * j + 1] = w.y; hq[4 * j + 2] = w.z; hq[4 * j + 3] = w.w; } }
        const float rs2 = 1.0f / sqrtf(SSQ[tok] * (1.f / 1024.f) + EPS);
        int idxl[2];
#pragma unroll
        for (int blk = 0; blk < 2; ++blk) {
            idxl[blk] = IDX[(size_t)tok * 128 + blk * 64 + emap];
            const float gate = GATE[(size_t)tok * 128 + blk * 64 + emap];
            const float isu = SU[idxl[blk]] * rs2, isv = SV[idxl[blk]];
            float dots = 0.f;
#pragma unroll
            for (int grp = 0; grp < 4; ++grp) {
                v2u ur[8][3];
#pragma unroll
                for (int i = 0; i < 8; ++i) { const int ia = __builtin_amdgcn_readlane(idxl[blk], 4 * i + grp), ib = __builtin_amdgcn_readlane(idxl[blk], 32 + 4 * i + grp);
                    const unsigned char* up = EU + (size_t)(hf ? ib : ia) * E6ROW + loff;
                    ur[i][0] = *(const v2u*)up; ur[i][1] = *(const v2u*)(up + 256); ur[i][2] = *(const v2u*)(up + 512); }
                float pp[8];
#pragma unroll
                for (int i = 0; i < 8; ++i) { const v6u d = {ur[i][0].x, ur[i][0].y, ur[i][1].x, ur[i][1].y, ur[i][2].x, ur[i][2].y};
                    const v32bf rb = __builtin_amdgcn_cvt_scalef32_pk32_bf16_fp6(d, 1.0f);
                    typedef unsigned v16u __attribute__((ext_vector_type(16)));
                    const v16u rw = __builtin_bit_cast(v16u, rb);
                    float a0 = 0.f, a1 = 0.f;
#pragma unroll
                    for (int j = 0; j < 8; ++j) { a0 = dot2bf(rw[2 * j], hq[2 * j], a0); a1 = dot2bf(rw[2 * j + 1], hq[2 * j + 1], a1); }
                    pp[i] = a0 + a1; }
#pragma unroll
                for (int o = 16, n = 4; n >= 1; o >>= 1, n >>= 1) { const bool hi = (lane & o) != 0;
#pragma unroll
                    for (int k = 0; k < n; ++k) { const float a = pp[k], b = pp[k + n]; const float send = hi ? a : b, keep = hi ? b : a; pp[k] = keep + __shfl_xor(send, o); } }
                float r = pp[0]; r += __shfl_xor(r, 2); r += __shfl_xor(r, 1);
                dots = ((lane & 3) == grp) ? r : dots;
            }
            WGT[(size_t)tok * 128 + blk * 64 + emap] = gate * gelu_erf(dots * isu) * isv;
        }
    }
    for (int tok = vcu * NWAVES + wave; tok < M; tok += G * NWAVES) {
        int idxl[2]; float wl[2];
#pragma unroll
        for (int blk = 0; blk < 2; ++blk) { idxl[blk] = IDX[(size_t)tok * 128 + blk * 64 + emap]; wl[blk] = WGT[(size_t)tok * 128 + blk * 64 + emap]; }
        v32f acc;
#pragma unroll
        for (int k = 0; k < 32; ++k) acc[k] = 0.f;
#pragma unroll
        for (int blk = 0; blk < 2; ++blk) {
#pragma unroll 1
            for (int bt = 0; bt < 4; ++bt) {
                v2u vr[8][3];
#pragma unroll
                for (int i = 0; i < 8; ++i) { const int pr = bt * 8 + i; const int ia = __builtin_amdgcn_readlane(idxl[blk], pr), ib = __builtin_amdgcn_readlane(idxl[blk], 32 + pr);
                    const unsigned char* vp = EV + (size_t)(hf ? ib : ia) * E6ROW + loff;
                    vr[i][0] = *(const v2u*)vp; vr[i][1] = *(const v2u*)(vp + 256); vr[i][2] = *(const v2u*)(vp + 512); }
#pragma unroll
                for (int i = 0; i < 8; ++i) { const int pr = bt * 8 + i;
                    const int wa = __builtin_amdgcn_readlane((int)__float_as_uint(wl[blk]), pr), wb = __builtin_amdgcn_readlane((int)__float_as_uint(wl[blk]), 32 + pr);
                    const float w = __uint_as_float((unsigned)(hf ? wb : wa));
                    const v6u d = {vr[i][0].x, vr[i][0].y, vr[i][1].x, vr[i][1].y, vr[i][2].x, vr[i][2].y};
                    const v32f rv = __builtin_amdgcn_cvt_scalef32_pk32_f32_fp6(d, 1.0f);
                    acc = acc + rv * w; }
            }
        }
        float o16[16];
#pragma unroll
        for (int k = 0; k < 16; ++k) { const float lo = acc[k], hi = acc[16 + k]; const float mine = hf ? hi : lo, other = hf ? lo : hi; o16[k] = mine + __shfl_xor(other, 32); }
        const size_t co = (size_t)tok * 1024 + c32 * 32 + hf * 16;
        float* orow = OUT + co; float ss = 0.f; f32x4 x2[4];
        { const v4u* xp = (const v4u*)(XG2 + co); const v4u w0 = xp[0], w1 = xp[1];
          x2[0] = (f32x4){bflo(w0.x) + o16[0], bfhi(w0.x) + o16[1], bflo(w0.y) + o16[2], bfhi(w0.y) + o16[3]};
          x2[1] = (f32x4){bflo(w0.z) + o16[4], bfhi(w0.z) + o16[5], bflo(w0.w) + o16[6], bfhi(w0.w) + o16[7]};
          x2[2] = (f32x4){bflo(w1.x) + o16[8], bfhi(w1.x) + o16[9], bflo(w1.y) + o16[10], bfhi(w1.y) + o16[11]};
          x2[3] = (f32x4){bflo(w1.z) + o16[12], bfhi(w1.z) + o16[13], bflo(w1.w) + o16[14], bfhi(w1.w) + o16[15]}; }
#pragma unroll
        for (int j = 0; j < 4; ++j) ss += (x2[j][0] * x2[j][0] + x2[j][1] * x2[j][1]) + (x2[j][2] * x2[j][2] + x2[j][3] * x2[j][3]);
        const float rs = 1.0f / sqrtf(wave_sum(ss) * (1.f / 1024.f) + EPS);
#pragma unroll
        for (int j = 0; j < 4; ++j) { const f32x4 g4 = *(const f32x4*)(fg + c32 * 32 + hf * 16 + 4 * j); *(f32x4*)(orow + 4 * j) = x2[j] * rs * g4; }
    }
}

#define RLX_AGENT __ATOMIC_RELAXED, __HIP_MEMORY_SCOPE_AGENT
#define XB_TMO      128
#define XB_XCNT(j)  (256  + 64 * (j))
#define XB_XSUB(j)  (1280 + 64 * (j))
#define XB_XGEN(j)  (2304 + 64 * (j))
#define XB_TOP      3328
#define XB_TOPGEN   3392
#define XCD_BAR_WORDS 3456
#define XB_SPIN_CAP (1u << 18)

__device__ __forceinline__ unsigned xb_ld(unsigned* p)              { return __hip_atomic_load(p, __ATOMIC_RELAXED, __HIP_MEMORY_SCOPE_AGENT); }
__device__ __forceinline__ unsigned xb_add(unsigned* p, unsigned v) { return __hip_atomic_fetch_add(p, v, __ATOMIC_RELAXED, __HIP_MEMORY_SCOPE_AGENT); }
__device__ __forceinline__ unsigned xb_xcc_id() { return (unsigned)__builtin_amdgcn_s_getreg((3 << 11) | 20) & 0xFu; }
#define XB_SPIN(cond, bar) do { unsigned _sp = 0; while (cond) { __builtin_amdgcn_s_sleep(1); \
    if ((++_sp & 255u) == 0u) { if (xb_ld(&(bar)[XB_TMO])) break; if (_sp > XB_SPIN_CAP) { atomicAdd(&(bar)[XB_TMO], 1u); break; } } } } while (0)

struct XcdBarrier {
    unsigned* bar; unsigned x;
    volatile LAS unsigned* st;
};

__device__ __forceinline__ XcdBarrier xcd_barrier_post(unsigned* bar, volatile LAS unsigned* st) {
    XcdBarrier b; b.bar = bar; b.x = xb_xcc_id(); b.st = st;
    if (threadIdx.x == 0) (void)xb_add(&bar[XB_XCNT(b.x)], 1u);
    return b;
}
__device__ __forceinline__ void xcd_barrier_complete(unsigned* bar, unsigned x, unsigned& nloc, unsigned& nx) {
    const unsigned G = gridDim.x * gridDim.y * gridDim.z;
    unsigned sum, cnt, mine, sp = 0u;
    for (;;) {
        sum = 0u; cnt = 0u; mine = 0u;
#pragma unroll
        for (unsigned j = 0; j < 16; ++j) { const unsigned c = xb_ld(&bar[XB_XCNT(j)]); sum += c; cnt += (c > 0u) ? 1u : 0u; mine = (j == x) ? c : mine; }
        if (sum == G) break;
        __builtin_amdgcn_s_sleep(1);
        if ((++sp & 255u) == 0u) { if (xb_ld(&bar[XB_TMO])) break; if (sp > XB_SPIN_CAP) { atomicAdd(&bar[XB_TMO], 1u); break; } }
    }
    nloc = mine > 0u ? mine : 1u; nx = cnt > 0u ? cnt : 1u;
}

__device__ __forceinline__ void xcd_barrier(const XcdBarrier& b) {
    asm volatile("s_waitcnt vmcnt(0)" ::: "memory");
    __syncthreads();
    if (threadIdx.x == 0) {
        unsigned* bar = b.bar;
        __builtin_amdgcn_s_waitcnt(0);
        unsigned nloc = b.st[0], nx = b.st[1];
        if (nloc == 0u) { xcd_barrier_complete(bar, b.x, nloc, nx); b.st[0] = nloc; b.st[1] = nx; }
        const unsigned old = xb_add(&bar[XB_XSUB(b.x)], 1u);
        const unsigned gen = old / nloc;
        if (old + 1u == (gen + 1u) * nloc) {
            __builtin_amdgcn_fence(__ATOMIC_RELEASE, "agent");
            asm volatile("s_waitcnt vmcnt(0)" ::: "memory");
            const unsigned og = xb_add(&bar[XB_TOP], 1u);
            const unsigned tg = og / nx;
            if (og + 1u == (tg + 1u) * nx) xb_add(&bar[XB_TOPGEN], 1u);
            else XB_SPIN(xb_ld(&bar[XB_TOPGEN]) == tg, bar);
            __builtin_amdgcn_fence(__ATOMIC_ACQUIRE, "agent");
            xb_add(&bar[XB_XGEN(b.x)], 1u);
            asm volatile("s_waitcnt vmcnt(0)" ::: "memory");
        } else {
            XB_SPIN(xb_ld(&bar[XB_XGEN(b.x)]) == gen, bar);
            __builtin_amdgcn_fence(__ATOMIC_ACQUIRE, "agent");
            asm volatile("s_waitcnt vmcnt(0)" ::: "memory");
        }
    }
    __syncthreads();
}


__global__ void __launch_bounds__(NTHREADS, 2) fwd_kernel(Args args) {
    extern __shared__ __attribute__((aligned(16))) unsigned char lds[];
    const int tid = threadIdx.x, lane = tid & 63, wave = __builtin_amdgcn_readfirstlane(tid >> 6);
    const int G = gridDim.x, bx = blockIdx.x;
    const int vcu = (G % 8 == 0) ? (bx % 8) * (G / 8) + bx / 8 : bx;
    unsigned char* ws = args.ws;
    const float* x = args.in[0];
    bf16* WinT = (bf16*)(ws + WS_WIN); bf16* WpwT = (bf16*)(ws + WS_WPW); bf16* WoT = (bf16*)(ws + WS_WO); bf16* WoutT = (bf16*)(ws + WS_WOUT); bf16* WqT = (bf16*)(ws + WS_WQ);
    unsigned char* EU = ws + WS_EU; unsigned char* EV = ws + WS_EV; float* SU = (float*)(ws + WS_ESC); float* SV = SU + NEXP; float* SSQ = SV + NEXP; bf16* SKb = (bf16*)(ws + WS_SK);
    bf16* XN = (bf16*)(ws + WS_XN); bf16* Ub = (bf16*)(ws + WS_U); bf16* MG = (bf16*)(ws + WS_MG); bf16* XG2 = (bf16*)(ws + WS_XG2);
    bf16* Gt = (bf16*)(ws + WS_G); bf16* QP = (bf16*)(ws + WS_QP);
    bf16* Qb = (bf16*)(ws + WS_Q); bf16* Kb = (bf16*)(ws + WS_K); bf16* Vb = (bf16*)(ws + WS_V);
    int* IDX = (int*)(ws + WS_IDX); float* GATE = (float*)(ws + WS_GATE);
    bf16* CA = (bf16*)(ws + WS_CA);
    LAS unsigned char* lds3 = (LAS unsigned char*)lds;
    const int lo = args.ph_lo, hi = args.ph_hi;
    volatile LAS unsigned* MISC = (volatile LAS unsigned*)(lds3 + MISC_OFF);
    if (tid < 32) MISC[tid] = 0u;
    __syncthreads();
    XcdBarrier bar_; bar_.bar = (unsigned*)(ws + WS_CTL) + CW_BAR; bar_.x = 0; bar_.st = nullptr;
    if (hi - lo > 1) bar_ = xcd_barrier_post((unsigned*)(ws + WS_CTL) + CW_BAR, MISC + 8);
#define SEAM(k) do { if (IN(k) && IN((k) + 1)) xcd_barrier(bar_); } while (0)
#ifdef ONLY_PHASE
#define IN(k) ((k) == ONLY_PHASE && lo <= (k) && (k) < hi)
#else
#define IN(k) (lo <= (k) && (k) < hi)
#endif

    if (IN(0)) {
        LAS float* scr = (LAS float*)(lds3 + wave * 16384);
        const int gw = vcu * NWAVES + wave, NGW = G * NWAVES;
        constexpr int I_IN = 16 * (IN_DIM / 32), I_SQ = 16 * 32, I_Q = 16 * 64;
        constexpr int NITEMS = I_IN + 3 * I_SQ + I_Q;
        for (int it = gw; it < NITEMS; it += NGW) {
            int r = it;
            if (r < I_IN) { const int nblk = IN_DIM / 32, kb = r / nblk, nb = r % nblk; p0_transpose_item(args.in[2], D, IN_DIM, WinT, glu_row(32 * nb), scr, kb, nb, lane); continue; } r -= I_IN;
            if (r < I_SQ) { p0_transpose_item(args.in[7], D, D, WpwT, 32 * (r % 32), scr, r / 32, r % 32, lane); continue; } r -= I_SQ;
            if (r < I_SQ) { p0_transpose_item(args.in[9], D, D, WoT, 32 * (r % 32), scr, r / 32, r % 32, lane); continue; } r -= I_SQ;
            if (r < I_SQ) { p0_transpose_item(args.in[10], D, D, WoutT, 32 * (r % 32), scr, r / 32, r % 32, lane); continue; } r -= I_SQ;
            p0_transpose_item(args.in[12], D, 2048, WqT, 32 * (r % 64), scr, r / 64, r % 64, lane, args.in[11]);
        }
        const size_t gt = (size_t)vcu * NTHREADS + tid, ngt = (size_t)G * NTHREADS;
        for (size_t i = gt; i < (size_t)M; i += ngt) SSQ[i] = 0.f;
        cvt_stream(args.in[13], SKb, (size_t)2 * NKEYS * PHALF, gt, ngt);
        { f32x4 tn[8];
#define EXP_LOAD(R) do { const int tb_ = (R) >= NEXP / 2, e_ = 2 * ((R) - tb_ * (NEXP / 2)); const float* src_ = args.in[14 + tb_] + (size_t)e_ * D; \
            _Pragma("unroll") for (int i = 0; i < 8; ++i) tn[i] = *(const f32x4*)(src_ + i * 256 + lane * 4); } while (0)
          if (gw < NEXP) EXP_LOAD(gw);
          for (int r = gw; r < NEXP; r += NGW) { const int tb = r >= NEXP / 2, e = 2 * (r - tb * (NEXP / 2));
              f32x4 t[8];
#pragma unroll
              for (int i = 0; i < 8; ++i) t[i] = tn[i];
              if (r + NGW < NEXP) EXP_LOAD(r + NGW);
              rows_to_fp6(t, (tb ? EV : EU) + (size_t)e * E6ROW, (tb ? SV : SU) + e, lane, tb ? nullptr : args.in[11], scr); }
#undef EXP_LOAD
        }
        for (int m = gw; m < M; m += 4 * NGW) {
            f32x4 v[4][4]; float ssr[4];
#pragma unroll
            for (int r = 0; r < 4; ++r) { const f32x4* xr = (const f32x4*)(x + (size_t)(m + r * NGW) * D) + lane;
#pragma unroll
                for (int j = 0; j < 4; ++j) v[r][j] = xr[64 * j]; }
#pragma unroll
            for (int r = 0; r < 4; ++r) { float q = 0.f;
#pragma unroll
                for (int j = 0; j < 4; ++j) q += (v[r][j][0] * v[r][j][0] + v[r][j][1] * v[r][j][1]) + (v[r][j][2] * v[r][j][2] + v[r][j][3] * v[r][j][3]);
                ssr[r] = q; }
#pragma unroll
            for (int o = 1; o < 64; o <<= 1) {
#pragma unroll
                for (int r = 0; r < 4; ++r) ssr[r] += __shfl_xor(ssr[r], o); }
#pragma unroll
            for (int r = 0; r < 4; ++r) { const float rs = 1.0f / sqrtf(ssr[r] * (1.f / 1024.f) + EPS); v2u* o8 = (v2u*)(XN + (size_t)(m + r * NGW) * D) + lane;
#pragma unroll
                for (int j = 0; j < 4; ++j) { const f32x4 gg = ((const f32x4*)args.in[1])[lane + 64 * j]; v2u o; o.x = pk2(v[r][j][0] * rs * gg[0], v[r][j][1] * rs * gg[1]); o.y = pk2(v[r][j][2] * rs * gg[2], v[r][j][3] * rs * gg[3]); o8[64 * j] = o; } }
        }
    }
    SEAM(0);
    if (IN(1)) {
        pg8::Gemm g{XN, WinT, XN, WinT, M, IN_DIM, D}; pg8::StaticOrder S; S.init(M, IN_DIM, G, bx, 1);
        EpiInProj E{Ub, Qb, Kb, Vb, Gt};
        pg8::gemm_phase<EpiInProj>(lds3, g, S, E);
    }
    SEAM(1);
    if (IN(2)) {
        conv_phase(lds3, Ub, CA, args.in[3], args.in[4], args.in[5], args.in[6], vcu, G);
        __syncthreads();
        att::attn_phase(lds3, Qb, Kb, Vb, Qb, args.in[8], vcu, G);
    }
    SEAM(2);
    if (IN(3)) {
        pg8::Gemm g{CA, WpwT, Qb, WoT, M, D, D}; pg8::StaticOrder S; S.init(M, D, G, bx, 2);
        EpiMerge E{Gt, MG};
        pg8::gemm_phase<EpiMerge>(lds3, g, S, E);
    }
    SEAM(3);
    if (IN(4)) {
        pg8::Gemm g{MG, WoutT, MG, WoutT, M, D, D}; pg8::StaticOrder S; S.init(M, D, G, bx, 1);
        EpiResid E{x, XG2, SSQ};
        pg8::gemm_phase<EpiResid>(lds3, g, S, E);
    }
    SEAM(4);
    if (IN(5)) {
        pg8::Gemm g{XG2, WqT, XG2, WqT, M, 2048, D}; pg8::StaticOrder S; S.init(M, 2048, G, bx, 1);
        EpiBf16Rs E{QP, SSQ};
        pg8::gemm_phase<EpiBf16Rs>(lds3, g, S, E);
    }
    SEAM(5);
    if (IN(6)) tk::topk_phase(lds3, QP, SKb, IDX, GATE, vcu, G);
    SEAM(6);
    if (IN(7)) gather_phase(XG2, SSQ, EU, EV, SU, SV, IDX, GATE, GATE, args.in[16], args.out, vcu, G);
#undef IN
#undef SEAM
}

extern "C" void kernel_launch(void* const* d_in, const int* in_sizes, int n_in, void* d_out, int out_size, void* d_ws, size_t ws_size, hipStream_t stream) {
    static int grid = 0;
    if (grid == 0) {
        if (n_in != 17 || in_sizes[0] != M * D || out_size != M * D || ws_size < WS_END) { fprintf(stderr, "kernel_launch: unexpected shapes (n_in %d, in0 %d, out %d, ws %zu)\n", n_in, n_in > 0 ? in_sizes[0] : -1, out_size, ws_size); grid = -1; return; }
        int dev = 0, cus = 0;
        if (hipGetDevice(&dev) != hipSuccess || hipDeviceGetAttribute(&cus, hipDeviceAttributeMultiprocessorCount, dev) != hipSuccess) { grid = -1; return; }
        if (hipFuncSetAttribute((const void*)fwd_kernel, hipFuncAttributeMaxDynamicSharedMemorySize, LDS_BYTES) != hipSuccess) { fprintf(stderr, "kernel_launch: hipFuncSetAttribute failed\n"); grid = -1; return; }
        int per_cu = 0;
        if (hipOccupancyMaxActiveBlocksPerMultiprocessor(&per_cu, (const void*)fwd_kernel, NTHREADS, LDS_BYTES) != hipSuccess || per_cu < 1) { fprintf(stderr, "kernel_launch: occupancy query says %d\n", per_cu); }
        (void)hipGetLastError();
        grid = cus;
    }
    if (grid < 0) return;
    Args a{};
    for (int i = 0; i < 17; ++i) a.in[i] = (const float*)d_in[i];
    a.out = (float*)d_out; a.ws = (unsigned char*)d_ws;
    if (MK_N_LAUNCHES == 1) {
        a.ph_lo = 0; a.ph_hi = 8;
        if (hipMemsetAsync((char*)d_ws + WS_CTL, 0, CTL_ZERO_BYTES, stream) != hipSuccess) { fprintf(stderr, "kernel_launch: memset failed\n"); return; }
        hipLaunchKernelGGL(fwd_kernel, dim3(grid), dim3(NTHREADS), LDS_BYTES, stream, a);
    } else {
        for (int p = 0; p < 8; ++p) {
            a.ph_lo = p; a.ph_hi = p + 1;
            hipLaunchKernelGGL(fwd_kernel, dim3(grid), dim3(NTHREADS), LDS_BYTES, stream, a);
        }
    }
}
```

```cpp
#include <hip/hip_runtime.h>
#include <cstdio>
#include <cstdint>

#ifndef MK_N_LAUNCHES
#define MK_N_LAUNCHES 1
#endif

constexpr int BATCH = 16, SEQ = 2048, D = 1024, M = BATCH * SEQ;
constexpr int CK = 31, CPAD = 15;
constexpr int NH = 16, NKV = 4, HD = 64, KVD = 256, WIN = 128;
constexpr int IN_DIM = 5632;
constexpr int PHD = 8, PKD = 256, PHALF = 128, NKEYS = 128, NEXP = 16384, TOPK = 16;
constexpr float EPS = 1e-6f;
constexpr int NWAVES = 8, NTHREADS = 512;
constexpr float LOG2E = 1.4426950408889634f, QSCALE = 0.125f * 1.4426950408889634f;

typedef unsigned short bf16;
typedef unsigned v4u __attribute__((ext_vector_type(4)));
typedef unsigned v2u __attribute__((ext_vector_type(2)));
typedef float f32x4 __attribute__((ext_vector_type(4)));
typedef float f32x2 __attribute__((ext_vector_type(2)));
typedef __bf16 bf16x2_t __attribute__((ext_vector_type(2)));
#define LAS __attribute__((address_space(3)))

__device__ __forceinline__ int opaque_tid() { int t = threadIdx.x; asm volatile("" : "+v"(t)); return t; }
__device__ __forceinline__ void fmac_s(float& acc, float a, float b) { asm volatile("v_fmac_f32 %0, %1, %2" : "+v"(acc) : "v"(a), "v"(b)); }
__device__ __forceinline__ void mul_s(float& x, float a) { asm volatile("v_mul_f32 %0, %0, %1" : "+v"(x) : "v"(a)); }
__device__ __forceinline__ unsigned pk2(float lo, float hi) { f32x2 v = {lo, hi}; bf16x2_t b = __builtin_convertvector(v, bf16x2_t); return __builtin_bit_cast(unsigned, b); }
__device__ __forceinline__ float bflo(unsigned u) { return __uint_as_float(u << 16); }
__device__ __forceinline__ float bfhi(unsigned u) { return __uint_as_float(u & 0xffff0000u); }
__device__ __forceinline__ float sigmoidf_(float x) { return __builtin_amdgcn_rcpf(1.0f + __builtin_amdgcn_exp2f(x * -1.4426950408889634f)); }
__device__ __forceinline__ float wave_sum(float v) {
#pragma unroll
    for (int o = 1; o < 64; o <<= 1) v += __shfl_xor(v, o);
    return v;
}

namespace pg8 {
typedef unsigned short bf16_t;
typedef short bf16x8 __attribute__((ext_vector_type(8)));
constexpr int BM = 256, BK = 64, HALF = 128, HTB = HALF * BK * 2, STAGE_BYTES = 8 * HTB, NXCD = 8, WGM = 8;

__host__ __device__ __forceinline__ int lds_byte(int r, int c) { const int st = (r >> 4) * 2 + (c >> 5), rr = r & 15, cc = c & 31, ob = rr * 64 + cc * 2; return st * 1024 + (ob ^ (((ob >> 9) & 1) << 5)); }
__host__ __device__ __forceinline__ void stage_rc(int b, int& R, int& C) { const int st = b / 1024, sb = b % 1024, swz = sb ^ (((sb >> 9) & 1) << 5); R = (st >> 1) * 16 + swz / 64; C = (st & 1) * 32 + (swz % 64) / 2; }
__host__ __device__ __forceinline__ int perm32(int rho) { const int n = rho >> 4, i = rho & 15; return 8 * (i >> 2) + 4 * n + (i & 3); }

struct Unit { int pm, pn, g; };
struct Gemm { const bf16_t* A0; const bf16_t* B0; const bf16_t* A1; const bf16_t* B1; int M, N, K; };

struct StaticOrder {
    int nM, nN, nwg, G, c, per;
    __host__ __device__ void init(int M_, int N_, int G_, int c_, int per_) { nM = M_ / BM; nN = N_ / BM; nwg = nM * nN; G = G_; c = c_; per = per_; }
    __host__ __device__ bool next(int i, Unit& u) const {
        const int ti = i / per; u.g = i % per;
        const long L = (long)ti * G + c; if (L >= nwg) return false;
        int wgid = (int)L; { const int q = nwg / NXCD, r = nwg % NXCD, xcd = wgid % NXCD, off = wgid / NXCD; wgid = (xcd < r ? xcd * (q + 1) : r * (q + 1) + (xcd - r) * q) + off; }
        const int nig = WGM * nN, gid = wgid / nig, fm = gid * WGM, gsz = (nM - fm) < WGM ? (nM - fm) : WGM;
        u.pm = fm + ((wgid % nig) % gsz); u.pn = (wgid % nig) / gsz; return true;
    }
};

template <class Epi>
__device__ __forceinline__ void gemm_phase(LAS unsigned char* lds, const Gemm g, const StaticOrder& S, const Epi& E) {
    const int tid = opaque_tid(), wid = __builtin_amdgcn_readfirstlane(tid >> 6), lane = tid & 63, wr = wid >> 2, wc = wid & 3, fr = lane & 15, fq = lane >> 4;
    const int K = g.K, nt = K / BK;
    unsigned voffA[2], voffB[2];
#pragma unroll
    for (int i = 0; i < 2; ++i) { int R, C; stage_rc(tid * 16 + i * 8192, R, C); const int Rb = Epi::PERM ? ((R & ~31) + perm32(R & 31)) : R;
        voffA[i] = (unsigned)(R * K + C) * 2u; voffB[i] = (unsigned)(Rb * K + C) * 2u; }
    const size_t kstep = (size_t)(BK * 2);
    const size_t hstep = (size_t)HALF * K * 2;
    const size_t tstep = 2 * hstep;
    const unsigned ldsw = (unsigned)wid * 1024u;
    const int aoff = lds_byte(wr * 64 + fr, fq * 8), boff = lds_byte(wc * 32 + fr, fq * 8);
#define PG8_SA(b, h) (((b) * 2 + (h)) * HTB)
#define PG8_SB(b, h) ((4 + (b) * 2 + (h)) * HTB)
#define PG8_STAGE(bufoff, gbase, voff) do { _Pragma("unroll") for (int _i = 0; _i < 2; ++_i) \
        __builtin_amdgcn_global_load_lds((const unsigned*)((const char*)(gbase) + (voff)[_i]), (LAS unsigned*)(lds + (bufoff) + ldsw + _i * 8192), 16, 0, 0); } while (0)
#define PG8_LDA(dst, b, h) do { _Pragma("unroll") for (int m = 0; m < 4; ++m) _Pragma("unroll") for (int k = 0; k < 2; ++k) dst[m][k] = *(const LAS bf16x8*)(lds + PG8_SA(b, h) + aoff + m * 2048 + k * 1024); } while (0)
#define PG8_LDB(dst, b, h) do { _Pragma("unroll") for (int n = 0; n < 2; ++n) _Pragma("unroll") for (int k = 0; k < 2; ++k) dst[n][k] = *(const LAS bf16x8*)(lds + PG8_SB(b, h) + boff + n * 2048 + k * 1024); } while (0)
#define PG8_MMA(ai, bj, At, Bt) do { __builtin_amdgcn_s_setprio(1); _Pragma("unroll") for (int m = 0; m < 4; ++m) _Pragma("unroll") for (int n = 0; n < 2; ++n) _Pragma("unroll") for (int k = 0; k < 2; ++k) \
        acc[ai][bj][m][n] = __builtin_amdgcn_mfma_f32_16x16x32_bf16(Bt[n][k], At[m][k], acc[ai][bj][m][n], 0, 0, 0); __builtin_amdgcn_s_setprio(0); } while (0)
#define PG8_WAIT_V(n) asm volatile("s_waitcnt vmcnt(" #n ")" ::: "memory")
#define PG8_WAIT_L(n) asm volatile("s_waitcnt lgkmcnt(" #n ")" ::: "memory")
#define PG8_BAR __builtin_amdgcn_s_barrier()
#define PG8_SCHED __builtin_amdgcn_sched_barrier(0)
    Unit cur, nxt; int ui = 0;
    if (!S.next(0, cur)) return;
    f32x4 acc[2][2][4][2];
#pragma unroll
    for (int a = 0; a < 2; ++a)
#pragma unroll
        for (int b = 0; b < 2; ++b)
#pragma unroll
            for (int m = 0; m < 4; ++m)
#pragma unroll
                for (int n = 0; n < 2; ++n) acc[a][b][m][n] = (f32x4){0.f, 0.f, 0.f, 0.f};
    bf16x8 At[4][2], B0[2][2], B1[2][2];
    const char* cA = (const char*)(cur.g ? g.A1 : g.A0) + (size_t)cur.pm * tstep; const char* cB = (const char*)(cur.g ? g.B1 : g.B0) + (size_t)cur.pn * tstep;
    PG8_STAGE(PG8_SB(0, 0), cB, voffB); PG8_STAGE(PG8_SB(0, 1), cB + hstep, voffB); PG8_STAGE(PG8_SA(0, 0), cA, voffA); PG8_STAGE(PG8_SA(0, 1), cA + hstep, voffA);
    if (wr == 1) PG8_BAR;
    PG8_WAIT_V(2); PG8_BAR;
    PG8_STAGE(PG8_SB(1, 0), cB + kstep, voffB); PG8_STAGE(PG8_SA(1, 0), cA + kstep, voffA); PG8_STAGE(PG8_SB(1, 1), cB + hstep + kstep, voffB);
    PG8_WAIT_V(6); PG8_BAR;
    for (;;) {
        const bool has_next = S.next(ui + 1, nxt);
        const char* nA = has_next ? (const char*)(nxt.g ? g.A1 : g.A0) + (size_t)nxt.pm * tstep : cA; const char* nB = has_next ? (const char*)(nxt.g ? g.B1 : g.B0) + (size_t)nxt.pn * tstep : cB;
        for (int t = 0; t < nt; t += 2) {
            const bool last = (t == nt - 2);
            const char* a1 = cA + (size_t)(t + 1) * kstep;
            const char* a2 = last ? nA : cA + (size_t)(t + 2) * kstep; const char* b2 = last ? nB : cB + (size_t)(t + 2) * kstep;
            const char* a3 = a2 + kstep; const char* b3 = b2 + kstep;
            PG8_LDB(B0, 0, 0); PG8_LDB(B1, 0, 1); PG8_SCHED; PG8_LDA(At, 0, 0); PG8_STAGE(PG8_SA(1, 1), a1 + hstep, voffA);
            PG8_WAIT_V(8); PG8_WAIT_L(0); PG8_BAR; PG8_MMA(0, 0, At, B0); PG8_MMA(0, 1, At, B1); PG8_BAR; PG8_SCHED;
            PG8_LDA(At, 0, 1); PG8_STAGE(PG8_SB(0, 0), b2, voffB); PG8_STAGE(PG8_SB(0, 1), b2 + hstep, voffB); PG8_STAGE(PG8_SA(0, 0), a2, voffA);
            PG8_WAIT_V(8); PG8_WAIT_L(0); PG8_BAR; PG8_MMA(1, 0, At, B0); PG8_MMA(1, 1, At, B1); PG8_BAR; PG8_SCHED;
            PG8_LDB(B0, 1, 0); PG8_LDB(B1, 1, 1); PG8_SCHED; PG8_LDA(At, 1, 0); PG8_STAGE(PG8_SA(0, 1), a2 + hstep, voffA);
            PG8_WAIT_V(8); PG8_WAIT_L(0); PG8_BAR; PG8_MMA(0, 0, At, B0); PG8_MMA(0, 1, At, B1); PG8_BAR; PG8_SCHED;
            PG8_LDA(At, 1, 1); PG8_STAGE(PG8_SB(1, 0), b3, voffB); PG8_STAGE(PG8_SB(1, 1), b3 + hstep, voffB); PG8_STAGE(PG8_SA(1, 0), a3, voffA);
            PG8_WAIT_V(8); PG8_WAIT_L(0); PG8_BAR; PG8_MMA(1, 0, At, B0); PG8_MMA(1, 1, At, B1); PG8_BAR; PG8_SCHED;
        }
        if (wr == 0) PG8_BAR;
        E(acc, cur, wr, wc, fr, fq);
        if (!has_next) break;
        if (!(Epi::CHAIN && cur.g == 0))
#pragma unroll
        for (int a = 0; a < 2; ++a)
#pragma unroll
            for (int b = 0; b < 2; ++b)
#pragma unroll
                for (int m = 0; m < 4; ++m)
#pragma unroll
                    for (int n = 0; n < 2; ++n) acc[a][b][m][n] = (f32x4){0.f, 0.f, 0.f, 0.f};
        cur = nxt; cA = nA; cB = nB; ++ui;
        if (wr == 1) PG8_BAR;
    }
    PG8_WAIT_V(0);
    PG8_BAR;
#undef PG8_SA
#undef PG8_SB
#undef PG8_STAGE
#undef PG8_LDA
#undef PG8_LDB
#undef PG8_MMA
#undef PG8_WAIT_V
#undef PG8_WAIT_L
#undef PG8_BAR
#undef PG8_SCHED
}
}

constexpr size_t MiB = 1u << 20;
constexpr size_t WS_CTL = 0;
constexpr size_t WS_WIN = 2 * MiB, WS_WPW = 13 * MiB, WS_WO = 15 * MiB, WS_WOUT = 17 * MiB, WS_WQ = 19 * MiB, WS_SK = 23 * MiB;
constexpr size_t WS_EU = 24 * MiB, WS_EV = 40 * MiB, WS_ESC = 56 * MiB;
constexpr size_t WS_XN = 88 * MiB, WS_U = 152 * MiB;
constexpr size_t WS_MG = 88 * MiB, WS_XG2 = 152 * MiB;
constexpr size_t WS_G = 216 * MiB;
constexpr size_t WS_QP = 216 * MiB;
constexpr size_t WS_Q = 344 * MiB, WS_K = 408 * MiB, WS_V = 424 * MiB;
constexpr size_t WS_IDX = 344 * MiB, WS_GATE = 360 * MiB;
constexpr size_t WS_CA = 440 * MiB;
constexpr size_t WS_END = 504 * MiB;
constexpr int LDS_BYTES = 147456;
constexpr int MISC_OFF = 131072 + 8192;
constexpr int CW_BAR = 4096;
constexpr size_t CTL_ZERO_BYTES = 65536;

struct Args { const float* in[17]; float* out; unsigned char* ws; int ph_lo, ph_hi; };

struct EpiInProj {
    static constexpr bool PERM = true, CHAIN = false;
    bf16 *U, *Q, *K, *V, *G;
    __device__ __forceinline__ void operator()(f32x4 (&acc)[2][2][4][2], const pg8::Unit& u, int wr, int wc, int fr, int fq) const {
        const int row0 = u.pm * 256 + wr * 64 + fr; const int cw = wc * 32 + 8 * fq;
        if (u.pn < 8) {
#pragma unroll
            for (int ai = 0; ai < 2; ++ai)
#pragma unroll
                for (int m = 0; m < 4; ++m) { const size_t row = (size_t)(row0 + ai * 128 + m * 16);
                    f32x4 a0 = acc[ai][0][m][0], a1 = acc[ai][0][m][1], b0 = acc[ai][1][m][0], b1 = acc[ai][1][m][1];
                    v4u w; w.x = pk2(a0[0] * sigmoidf_(b0[0]), a0[1] * sigmoidf_(b0[1])); w.y = pk2(a0[2] * sigmoidf_(b0[2]), a0[3] * sigmoidf_(b0[3]));
                    w.z = pk2(a1[0] * sigmoidf_(b1[0]), a1[1] * sigmoidf_(b1[1])); w.w = pk2(a1[2] * sigmoidf_(b1[2]), a1[3] * sigmoidf_(b1[3]));
                    *(v4u*)(U + row * 1024 + u.pn * 128 + cw) = w; }
        } else if (u.pn >= 14) {
            const int p = u.pn - 14;
#pragma unroll
            for (int ai = 0; ai < 2; ++ai)
#pragma unroll
                for (int m = 0; m < 4; ++m) { bf16* rowp = G + (size_t)(row0 + ai * 128 + m * 16) * 2048 + p * 128 + cw;
                    float rr[8], gb[8];
#pragma unroll
                    for (int n = 0; n < 2; ++n)
#pragma unroll
                        for (int j = 0; j < 4; ++j) { const float a = acc[ai][0][m][n][j], b = acc[ai][1][m][n][j]; const float eb = __builtin_amdgcn_exp2f(b * -LOG2E);
                            gb[4 * n + j] = __builtin_amdgcn_rcpf(1.0f + eb); rr[4 * n + j] = sigmoidf_(a) * (1.0f + eb); }
                    v4u w; w.x = pk2(rr[0], rr[1]); w.y = pk2(rr[2], rr[3]); w.z = pk2(rr[4], rr[5]); w.w = pk2(rr[6], rr[7]); *(v4u*)rowp = w;
                    w.x = pk2(gb[0], gb[1]); w.y = pk2(gb[2], gb[3]); w.z = pk2(gb[4], gb[5]); w.w = pk2(gb[6], gb[7]); *(v4u*)(rowp + 1024) = w; }
        } else {
            bf16* base; int ld, col0; float sc = 1.0f;
            if (u.pn < 12) { base = Q; ld = 1024; col0 = (u.pn - 8) * 256; sc = QSCALE; }
            else if (u.pn == 12) { base = K; ld = 256; col0 = 0; }
            else { base = V; ld = 256; col0 = 0; }
#pragma unroll
            for (int ai = 0; ai < 2; ++ai)
#pragma unroll
                for (int m = 0; m < 4; ++m) { bf16* rowp = base + (size_t)(row0 + ai * 128 + m * 16) * ld + col0 + cw;
#pragma unroll
                    for (int bj = 0; bj < 2; ++bj) { f32x4 v0 = acc[ai][bj][m][0] * sc, v1 = acc[ai][bj][m][1] * sc;
                        v4u w; w.x = pk2(v0[0], v0[1]); w.y = pk2(v0[2], v0[3]); w.z = pk2(v1[0], v1[1]); w.w = pk2(v1[2], v1[3]);
                        *(v4u*)(rowp + bj * 128) = w; } }
        }
    }
};
struct EpiMerge {
    static constexpr bool PERM = true, CHAIN = true;
    const bf16* G; bf16* MG;
    __device__ __forceinline__ void operator()(f32x4 (&acc)[2][2][4][2], const pg8::Unit& u, int wr, int wc, int fr, int fq) const {
        const int row0 = u.pm * 256 + wr * 64 + fr; const int col0 = u.pn * 256 + wc * 32 + 8 * fq;
#pragma unroll
        for (int ai = 0; ai < 2; ++ai) { const size_t row = (size_t)(row0 + ai * 128);
            const bf16* gp = G + row * 2048 + u.g * 1024 + col0; bf16* mp = MG + row * 1024 + col0;
            v4u gw[4][2];
#pragma unroll
            for (int m = 0; m < 4; ++m)
#pragma unroll
                for (int bj = 0; bj < 2; ++bj) gw[m][bj] = *(const v4u*)(gp + (size_t)(m * 16) * 2048 + bj * 128);
#pragma unroll
            for (int m = 0; m < 4; ++m)
#pragma unroll
                for (int bj = 0; bj < 2; ++bj) { const v4u g4 = gw[m][bj]; f32x4 v0 = acc[ai][bj][m][0], v1 = acc[ai][bj][m][1];
                    v0[0] *= bflo(g4.x); v0[1] *= bfhi(g4.x); v0[2] *= bflo(g4.y); v0[3] *= bfhi(g4.y); v1[0] *= bflo(g4.z); v1[1] *= bfhi(g4.z); v1[2] *= bflo(g4.w); v1[3] *= bfhi(g4.w);
                    if (u.g) { v4u w; w.x = pk2(v0[0], v0[1]); w.y = pk2(v0[2], v0[3]); w.z = pk2(v1[0], v1[1]); w.w = pk2(v1[2], v1[3]); *(v4u*)(mp + (size_t)(m * 16) * 1024 + bj * 128) = w; }
                    else { acc[ai][bj][m][0] = v0; acc[ai][bj][m][1] = v1; } } }
    }
};
struct EpiResid {
    static constexpr bool PERM = false, CHAIN = false;
    const float* X; bf16* XG; float* SSQ;
    __device__ __forceinline__ void operator()(f32x4 (&acc)[2][2][4][2], const pg8::Unit& u, int wr, int wc, int fr, int fq) const {
        const int row0 = u.pm * 256 + wr * 64 + fr; const int col0 = u.pn * 256 + wc * 32 + 4 * fq;
#pragma unroll
        for (int ai = 0; ai < 2; ++ai) {
            f32x4 xv[4][2][2];
#pragma unroll
            for (int m = 0; m < 4; ++m) { const size_t off = (size_t)(row0 + ai * 128 + m * 16) * 1024 + col0;
#pragma unroll
                for (int bj = 0; bj < 2; ++bj)
#pragma unroll
                    for (int n = 0; n < 2; ++n) xv[m][bj][n] = *(const f32x4*)(X + off + bj * 128 + n * 16); }
#pragma unroll
            for (int m = 0; m < 4; ++m) { const int row = row0 + ai * 128 + m * 16; const size_t off = (size_t)row * 1024 + col0; float ss = 0.f;
#pragma unroll
                for (int bj = 0; bj < 2; ++bj)
#pragma unroll
                    for (int n = 0; n < 2; ++n) { const f32x4 x1 = xv[m][bj][n] + acc[ai][bj][m][n];
                        ss += (x1[0] * x1[0] + x1[1] * x1[1]) + (x1[2] * x1[2] + x1[3] * x1[3]);
                        v2u w; w.x = pk2(x1[0], x1[1]); w.y = pk2(x1[2], x1[3]); *(v2u*)(XG + off + bj * 128 + n * 16) = w; }
                ss += __shfl_xor(ss, 16); ss += __shfl_xor(ss, 32);
                if (fq == 0) atomicAdd(SSQ + row, ss); }
        }
    }
};
struct EpiBf16Rs {
    static constexpr bool PERM = true, CHAIN = false;
    bf16* O; const float* SSQ;
    __device__ __forceinline__ void operator()(f32x4 (&acc)[2][2][4][2], const pg8::Unit& u, int wr, int wc, int fr, int fq) const {
        const int row0 = u.pm * 256 + wr * 64 + fr;
        float ssq[2][4];
#pragma unroll
        for (int ai = 0; ai < 2; ++ai)
#pragma unroll
            for (int m = 0; m < 4; ++m) ssq[ai][m] = SSQ[row0 + ai * 128 + m * 16];
        const int sidx = 2 * wc + (fq >> 1), hh = fq & 1;
#pragma unroll
        for (int ai = 0; ai < 2; ++ai)
#pragma unroll
            for (int m = 0; m < 4; ++m) { const int row = row0 + ai * 128 + m * 16; const int tile = row >> 5, r32 = row & 31;
                const float rs = 1.0f / sqrtf(ssq[ai][m] * (1.f / 1024.f) + EPS);
#pragma unroll
                for (int bj = 0; bj < 2; ++bj) { const f32x4 v0 = acc[ai][bj][m][0] * rs, v1 = acc[ai][bj][m][1] * rs;
                    v4u w; w.x = pk2(v0[0], v0[1]); w.y = pk2(v0[2], v0[3]); w.z = pk2(v1[0], v1[1]); w.w = pk2(v1[2], v1[3]);
                    *(v4u*)(O + ((((size_t)(tile * 8 + u.pn) * 2 + bj) * 8 + sidx) * 64 + r32 + 32 * hh) * 8) = w; } }
    }
};

__device__ __forceinline__ void p0_transpose_item(const float* W, int K, int N, bf16* WT, int dst0, LAS float* scr, int kb, int nb, int lane, const float* kscale = nullptr) {
    const int k0 = 64 * kb, n0 = 32 * nb;
#pragma unroll 8
    for (int i = 0; i < 32; ++i) { const int kk = 2 * i + (lane >> 5); float wv_ = W[(size_t)(k0 + kk) * N + n0 + (lane & 31)]; if (kscale) wv_ *= kscale[k0 + kk]; scr[kk * 33 + (lane & 31)] = wv_; }
    asm volatile("s_waitcnt lgkmcnt(0)" ::: "memory");
    const int c = lane & 7;
#pragma unroll
    for (int j = 0; j < 4; ++j) { const int n = (lane >> 3) + 8 * j; const LAS float* s = scr + (8 * c) * 33 + n;
        v4u o; o.x = pk2(s[0 * 33], s[1 * 33]); o.y = pk2(s[2 * 33], s[3 * 33]); o.z = pk2(s[4 * 33], s[5 * 33]); o.w = pk2(s[6 * 33], s[7 * 33]);
        *(v4u*)(WT + (size_t)(dst0 + n) * K + k0 + 8 * c) = o; }
    asm volatile("s_waitcnt lgkmcnt(0)" ::: "memory");
}
__device__ __forceinline__ int glu_row(int n0) {
    if (n0 < 1024) return 256 * (n0 >> 7) + (n0 & 127);
    if (n0 < 2048) { const int n1 = n0 - 1024; return 256 * (n1 >> 7) + 128 + (n1 & 127); }
    if (n0 < 3584) return n0;
    if (n0 < 4608) { const int n1 = n0 - 3584; return 3584 + 256 * (n1 >> 7) + (n1 & 127); }
    { const int n1 = n0 - 4608; return 3584 + 256 * (n1 >> 7) + 128 + (n1 & 127); }
}
__device__ __forceinline__ void cvt_stream(const float* src, bf16* dst, size_t n, size_t gtid, size_t gthreads) {
    for (size_t i = gtid * 8; i < n; i += gthreads * 8) {
        const f32x4 a = *(const f32x4*)(src + i), b = *(const f32x4*)(src + i + 4);
        v4u o; o.x = pk2(a[0], a[1]); o.y = pk2(a[2], a[3]); o.z = pk2(b[0], b[1]); o.w = pk2(b[2], b[3]);
        *(v4u*)(dst + i) = o; }
}
typedef float v16f __attribute__((ext_vector_type(16)));
typedef float v32f __attribute__((ext_vector_type(32)));
typedef unsigned v6u __attribute__((ext_vector_type(6)));
typedef __bf16 v32bf __attribute__((ext_vector_type(32)));
constexpr int E6ROW = 768;
__device__ __forceinline__ void rows_to_fp6(const float* x2rows, unsigned char* o2rows, float* inv_scale2, int lane, const float* cscale, LAS float* scr) {
    const int c = lane & 31, hf = lane >> 5;
    { f32x4 t[8];
#pragma unroll
      for (int i = 0; i < 8; ++i) t[i] = *(const f32x4*)(x2rows + i * 256 + lane * 4);
#pragma unroll
      for (int i = 0; i < 8; ++i) { const int e = i * 256 + lane * 4; *(LAS f32x4*)((LAS unsigned char*)scr + (e >> 5) * 144 + (e & 31) * 4) = t[i]; }
      asm volatile("s_waitcnt lgkmcnt(0)" ::: "memory"); }
    const LAS f32x4* xr = (const LAS f32x4*)((LAS unsigned char*)scr + lane * 144);
    v16f a, b; float am = 0.f;
#pragma unroll
    for (int j = 0; j < 4; ++j) { f32x4 u = xr[j], w = xr[4 + j];
        if (cscale) { u = u * *(const f32x4*)(cscale + c * 32 + 4 * j); w = w * *(const f32x4*)(cscale + c * 32 + 16 + 4 * j); }
#pragma unroll
        for (int k = 0; k < 4; ++k) { am = fmaxf(am, fmaxf(fabsf(u[k]), fabsf(w[k]))); }
        a[2 * j] = u[0]; b[2 * j] = u[1]; a[2 * j + 1] = u[2]; b[2 * j + 1] = u[3];
        a[8 + 2 * j] = w[0]; b[8 + 2 * j] = w[1]; a[8 + 2 * j + 1] = w[2]; b[8 + 2 * j + 1] = w[3]; }
#pragma unroll
    for (int o = 1; o < 32; o <<= 1) am = fmaxf(am, __shfl_xor(am, o));
    am = fmaxf(am, 1e-30f);
    const float sc = 7.5f / am;
    a = a * sc; b = b * sc;
    const v6u d = __builtin_amdgcn_cvt_scalef32_2xpk16_fp6_f32(a, b, 1.0f);
    unsigned char* ob = o2rows + (size_t)hf * E6ROW + c * 24;
    *(v2u*)(ob) = (v2u){d[0], d[1]}; *(v2u*)(ob + 8) = (v2u){d[2], d[3]}; *(v2u*)(ob + 16) = (v2u){d[4], d[5]};
    if (c == 0) inv_scale2[hf] = am * (1.0f / 7.5f);
    asm volatile("s_waitcnt lgkmcnt(0)" ::: "memory");
}
__device__ __forceinline__ void rms_row_to_bf16(const float* xrow, const float* g, bf16* orow, int lane) {
    const f32x4* xr = (const f32x4*)xrow + lane; const f32x4* gr = (const f32x4*)g + lane;
    f32x4 v[4]; float s = 0.f;
#pragma unroll
    for (int j = 0; j < 4; ++j) { v[j] = xr[64 * j]; s += (v[j][0] * v[j][0] + v[j][1] * v[j][1]) + (v[j][2] * v[j][2] + v[j][3] * v[j][3]); }
    const float rs = 1.0f / sqrtf(wave_sum(s) * (1.f / 1024.f) + EPS);
    v2u* o8 = (v2u*)orow + lane;
#pragma unroll
    for (int j = 0; j < 4; ++j) { const f32x4 gg = gr[64 * j]; v2u o; o.x = pk2(v[j][0] * rs * gg[0], v[j][1] * rs * gg[1]); o.y = pk2(v[j][2] * rs * gg[2], v[j][3] * rs * gg[3]); o8[64 * j] = o; }
}

__device__ __forceinline__ void conv_phase(LAS unsigned char* lds, const bf16* U, bf16* CA, const float* dw_w, const float* dw_b, const float* ln_g, const float* ln_b, int vcu, int G) {
    const int tid = opaque_tid(), lane = tid & 63, wave = tid >> 6;
    const int c0 = 2 * tid;
    constexpr int TT = 32, ROWS = TT + 2 * CPAD, TILE_B = ROWS * 2048;
    f32x2 wv[CK];
#pragma unroll
    for (int j = 0; j < CK; ++j) wv[j] = *(const f32x2*)(dw_w + j * 1024 + c0);
    const f32x2 bi = *(const f32x2*)(dw_b + c0), lg = *(const f32x2*)(ln_g + c0), lb = *(const f32x2*)(ln_b + c0);
    LAS float* red = (LAS float*)(lds + TILE_B);
    LAS float* stat = red + 512;
    const LAS unsigned char* xb = lds + c0 * 2;
    for (int item = vcu; item < BATCH * (SEQ / TT); item += G) {
        const int b = item / (SEQ / TT), t0 = (item % (SEQ / TT)) * TT;
#pragma unroll
        for (int hb = 0; hb < 2; ++hb) {
            v4u val[8];
#pragma unroll
            for (int it = 0; it < 8; ++it) { const int i = tid + (hb * 8 + it) * NTHREADS; const int row = i >> 7, ch = i & 127, tt = t0 - CPAD + row; const bool ok = (i < ROWS * 128) && (tt >= 0) && (tt < SEQ);
                val[it] = *(const v4u*)(U + ((size_t)b * SEQ + (ok ? tt : t0)) * 1024 + ch * 8); if (!ok) val[it] = (v4u){0u, 0u, 0u, 0u}; }
#pragma unroll
            for (int it = 0; it < 8; ++it) { const int i = tid + (hb * 8 + it) * NTHREADS; const int row = i >> 7, ch = i & 127; if (i < ROWS * 128) *(LAS v4u*)(lds + row * 2048 + ch * 16) = val[it]; }
        }
        __syncthreads();
#pragma unroll 1
        for (int rd = 0; rd < 2; ++rd) {
            const LAS unsigned char* xr = xb + rd * 16 * 2048;
            float ac0[16], ac1[16];
#pragma unroll
            for (int t = 0; t < 16; ++t) { ac0[t] = bi[0]; ac1[t] = bi[1]; }
#pragma clang loop unroll(full)
            for (int r = 0; r < 16 + 2 * CPAD; ++r) {
                const unsigned raw = *(const LAS unsigned*)(xr + r * 2048); const float x0 = bflo(raw), x1 = bfhi(raw);
#pragma clang loop unroll(full)
                for (int j = 0; j < CK; ++j) { const int t = r - j; if (t >= 0 && t < 16) { fmac_s(ac0[t], wv[j][0], x0); fmac_s(ac1[t], wv[j][1], x1); } }
            }
            float v[32];
#pragma unroll
            for (int t = 0; t < 16; ++t) { v[2 * t] = ac0[t] + ac1[t]; v[2 * t + 1] = ac0[t] * ac0[t] + ac1[t] * ac1[t]; }
#pragma unroll
            for (int o = 32, n = 16; n >= 1; o >>= 1, n >>= 1) { const bool hi = (lane & o) != 0;
#pragma unroll
                for (int k = 0; k < n; ++k) { const float a = v[k], bb = v[k + n]; const float send = hi ? a : bb, keep = hi ? bb : a; v[k] = keep + __shfl_xor(send, o); } }
            const float rr = v[0] + __shfl_xor(v[0], 1);
            if ((lane & 1) == 0) red[wave * 32 + (lane >> 1)] = rr;
            __syncthreads();
            if (tid < 16) { float s1 = 0.f, s2 = 0.f;
#pragma unroll
                for (int w = 0; w < 8; ++w) { s1 += red[w * 32 + 2 * tid]; s2 += red[w * 32 + 2 * tid + 1]; }
                const float mean = s1 * (1.f / 1024.f); const float var = s2 * (1.f / 1024.f) - mean * mean;
                stat[2 * tid] = mean; stat[2 * tid + 1] = 1.0f / sqrtf(var + EPS); }
            __syncthreads();
            bf16* Cb = CA + ((size_t)b * SEQ + t0 + 16 * rd) * 1024 + c0;
#pragma unroll
            for (int t = 0; t < 16; ++t) { const float mean = stat[2 * t], rstd = stat[2 * t + 1];
                float y0 = (ac0[t] - mean) * rstd * lg[0] + lb[0], y1 = (ac1[t] - mean) * rstd * lg[1] + lb[1];
                y0 = y0 * sigmoidf_(y0); y1 = y1 * sigmoidf_(y1);
                *(unsigned*)(Cb + (size_t)t * 1024) = pk2(y0, y1); }
            __syncthreads();
        }
    }
}

namespace att {
typedef short bf16x8 __attribute__((ext_vector_type(8)));
typedef short s16x4 __attribute__((ext_vector_type(4)));
typedef float f32x16 __attribute__((ext_vector_type(16)));
constexpr int KP = 144, SPAN = 320, VOFF = SPAN * KP, WSTG = 2 * SPAN * KP;
__device__ __forceinline__ s16x4 vtr(const LAS unsigned char* p) { return __builtin_bit_cast(s16x4, __builtin_amdgcn_ds_read_tr16_b64_v4i16((LAS s16x4*)p)); }
__device__ __forceinline__ void attn_phase(LAS unsigned char* lds, const bf16* Q, const bf16* K, const bf16* V, bf16* AO, const float* sink, int vcu, int G) {
    const int tid = opaque_tid(), lane = tid & 63, wave = __builtin_amdgcn_readfirstlane(tid >> 6), r32 = lane & 31, hh = lane >> 5;
    v4u kreg[5], vreg[5];
#define ATT_STAGE_LOAD(UNIT) do { const int qb_ = (UNIT) % (SEQ / 64), kvh_ = ((UNIT) / (SEQ / 64)) % NKV, b_ = (UNIT) / ((SEQ / 64) * NKV); const int t0_ = qb_ * 64, s0_ = t0_ - WIN; \
        _Pragma("unroll") for (int it = 0; it < 5; ++it) { const int i = tid + it * NTHREADS; const int row = i >> 3, ch = i & 7, sp = s0_ + row; const bool ok = (sp >= 0) && (sp < SEQ); \
            const size_t go = ((size_t)b_ * SEQ + (ok ? sp : t0_)) * KVD + kvh_ * 64 + ch * 8; kreg[it] = *(const v4u*)(K + go); vreg[it] = *(const v4u*)(V + go); } } while (0)
    if (vcu < BATCH * NKV * (SEQ / 64)) ATT_STAGE_LOAD(vcu);
    for (int unit = vcu; unit < BATCH * NKV * (SEQ / 64); unit += G) {
        const int qb = unit % (SEQ / 64), kvh = (unit / (SEQ / 64)) % NKV, b = unit / ((SEQ / 64) * NKV);
        const int t0 = qb * 64;
#pragma unroll
        for (int it = 0; it < 5; ++it) { const int i = tid + it * NTHREADS; const int row = i >> 3, ch = i & 7;
            *(LAS v4u*)(lds + row * KP + ch * 16) = kreg[it]; *(LAS v4u*)(lds + VOFF + row * KP + ch * 16) = vreg[it]; }
        if (unit + G < BATCH * NKV * (SEQ / 64)) ATT_STAGE_LOAD(unit + G);
        __syncthreads();
        {
            const int head = kvh * 4 + (wave >> 1), qoff = (wave & 1) * 32, q0 = t0 + qoff;
            const float slope2 = exp2f(-0.5f * (float)(head + 1)) * LOG2E, sink2 = sink[head] * LOG2E;
            LAS unsigned char* stg = lds + WSTG + wave * (32 * KP);
            const size_t qbase = ((size_t)b * SEQ + q0) * 1024 + head * 64;
#pragma unroll
            for (int i = 0; i < 4; ++i) { const int id = i * 64 + lane, row = id >> 3, ch = id & 7; *(LAS v4u*)(stg + row * KP + ch * 16) = *(const v4u*)(Q + qbase + (size_t)row * 1024 + ch * 8); }
            bf16x8 qf[4];
#pragma unroll
            for (int s = 0; s < 4; ++s) qf[s] = *(const LAS bf16x8*)(stg + r32 * KP + (2 * s + hh) * 16);
            float m = sink2, l = (hh == 0) ? 1.0f : 0.0f;
            f32x16 O0, O1, negm;
#pragma unroll
            for (int r = 0; r < 16; ++r) { O0[r] = 0.f; O1[r] = 0.f; negm[r] = -sink2; }
            const int q4 = (lane & 15) >> 2, p4 = lane & 3, g16 = (lane >> 4) & 1;
#pragma unroll 1
            for (int it = 0; it < 9; ++it) {
                const int j = (it & 1) ? 4 - ((it + 1) >> 1) : 4 + (it >> 1);
                const int kt0 = q0 - WIN + 32 * j;
                if (kt0 < 0 || kt0 >= SEQ) continue;
                const int lrow0 = qoff + 32 * j;
                f32x16 sa = negm;
#pragma unroll
                for (int s = 0; s < 4; ++s) { const bf16x8 kf = *(const LAS bf16x8*)(lds + (lrow0 + r32) * KP + 32 * s + 16 * hh); sa = __builtin_amdgcn_mfma_f32_32x32x16_bf16(kf, qf[s], sa, 0, 0, 0); }
                const float cf = (float)(WIN - 32 * j + r32 - 4 * hh);
                if (j == 0 || j == 8) {
#pragma unroll
                    for (int r = 0; r < 16; ++r) { const float d = cf - (float)((r & 3) + 8 * (r >> 2)); float v = fmaf(-slope2, fabsf(d), sa[r]); v = (fabsf(d) > (float)WIN) ? -1e30f : v; sa[r] = v; }
                } else {
#pragma unroll
                    for (int r = 0; r < 16; ++r) { const float d = cf - (float)((r & 3) + 8 * (r >> 2)); sa[r] = fmaf(-slope2, fabsf(d), sa[r]); }
                }
                float tmax = fmaxf(fmaxf(sa[0], sa[1]), sa[2]);
#pragma unroll
                for (int r = 3; r < 15; r += 2) tmax = fmaxf(fmaxf(tmax, sa[r]), sa[r + 1]);
                tmax = fmaxf(tmax, sa[15]);
                if (__any(tmax > 16.0f)) {
                    tmax = fmaxf(tmax, __shfl_xor(tmax, 32));
                    const float dl = fmaxf(tmax, 0.f), alpha = __builtin_amdgcn_exp2f(-dl); m += dl; l *= alpha;
#pragma unroll
                    for (int r = 0; r < 16; ++r) { O0[r] *= alpha; O1[r] *= alpha; sa[r] -= dl; negm[r] = -m; }
                }
                float ls0 = 0.f, ls1 = 0.f;
#pragma unroll
                for (int r = 0; r < 16; r += 2) { sa[r] = __builtin_amdgcn_exp2f(sa[r]); sa[r + 1] = __builtin_amdgcn_exp2f(sa[r + 1]); ls0 += sa[r]; ls1 += sa[r + 1]; }
                l += ls0 + ls1;
                v4u pw0, pw1;
                pw0.x = pk2(sa[0], sa[1]); pw0.y = pk2(sa[2], sa[3]); pw0.z = pk2(sa[4], sa[5]); pw0.w = pk2(sa[6], sa[7]);
                pw1.x = pk2(sa[8], sa[9]); pw1.y = pk2(sa[10], sa[11]); pw1.z = pk2(sa[12], sa[13]); pw1.w = pk2(sa[14], sa[15]);
                const bf16x8 pb0 = __builtin_bit_cast(bf16x8, pw0), pb1 = __builtin_bit_cast(bf16x8, pw1);
                const LAS unsigned char* vb = lds + VOFF + (lrow0 + 4 * hh + q4) * KP + (16 * g16 + 4 * p4) * 2;
#pragma unroll
                for (int s2 = 0; s2 < 2; ++s2) {
                    const s16x4 a0l = vtr(vb + (16 * s2) * KP), a0h = vtr(vb + (16 * s2 + 8) * KP);
                    const s16x4 a1l = vtr(vb + (16 * s2) * KP + 64), a1h = vtr(vb + (16 * s2 + 8) * KP + 64);
                    const bf16x8 A0 = (bf16x8){a0l[0], a0l[1], a0l[2], a0l[3], a0h[0], a0h[1], a0h[2], a0h[3]};
                    const bf16x8 A1 = (bf16x8){a1l[0], a1l[1], a1l[2], a1l[3], a1h[0], a1h[1], a1h[2], a1h[3]};
                    O0 = __builtin_amdgcn_mfma_f32_32x32x16_bf16(A0, s2 ? pb1 : pb0, O0, 0, 0, 0);
                    O1 = __builtin_amdgcn_mfma_f32_32x32x16_bf16(A1, s2 ? pb1 : pb0, O1, 0, 0, 0);
                }
            }
            const float inv = 1.0f / (l + __shfl_xor(l, 32));
#pragma unroll
            for (int g4 = 0; g4 < 4; ++g4) { v2u w0, w1;
                w0.x = pk2(O0[4 * g4] * inv, O0[4 * g4 + 1] * inv); w0.y = pk2(O0[4 * g4 + 2] * inv, O0[4 * g4 + 3] * inv);
                w1.x = pk2(O1[4 * g4] * inv, O1[4 * g4 + 1] * inv); w1.y = pk2(O1[4 * g4 + 2] * inv, O1[4 * g4 + 3] * inv);
                *(LAS v2u*)(stg + r32 * KP + (8 * g4 + 4 * hh) * 2) = w0; *(LAS v2u*)(stg + r32 * KP + (32 + 8 * g4 + 4 * hh) * 2) = w1; }
#pragma unroll
            for (int i = 0; i < 4; ++i) { const int id = i * 64 + lane, row = id >> 3, ch = id & 7; *(v4u*)(AO + qbase + (size_t)row * 1024 + ch * 8) = *(const LAS v4u*)(stg + row * KP + ch * 16); }
        }
        __syncthreads();
    }
}
#undef ATT_STAGE_LOAD
}

namespace tk {
typedef short bf16x8 __attribute__((ext_vector_type(8)));
typedef float f32x16 __attribute__((ext_vector_type(16)));
constexpr int SKP = 272;
#define TK_CAND50(X) X(0,0,0) X(1,0,1) X(2,0,2) X(3,0,3) X(4,0,4) X(5,0,5) X(6,0,6) X(7,0,7) X(8,0,8) X(9,0,9) X(10,0,10) X(11,0,11) X(12,0,12) X(13,0,13) X(14,0,14) X(15,0,15) X(16,1,0) X(17,1,1) X(18,1,2) X(19,1,3) X(20,1,4) X(21,1,5) X(22,1,6) X(23,1,7) X(24,2,0) X(25,2,1) X(26,2,2) X(27,2,3) X(28,2,4) X(29,3,0) X(30,3,1) X(31,3,2) X(32,3,3) X(33,4,0) X(34,4,1) X(35,4,2) X(36,5,0) X(37,5,1) X(38,6,0) X(39,6,1) X(40,7,0) X(41,7,1) X(42,8,0) X(43,9,0) X(44,10,0) X(45,11,0) X(46,12,0) X(47,13,0) X(48,14,0) X(49,15,0)
#define TK_PAIR25(X) X(0,0,0,2,1) X(1,0,1,2,2) X(2,0,2,2,3) X(3,0,3,2,4) X(4,0,4,3,0) X(5,0,5,3,1) X(6,0,6,3,2) X(7,0,7,3,3) X(8,0,8,4,0) X(9,0,9,4,1) X(10,0,10,4,2) X(11,0,11,5,0) X(12,0,12,5,1) X(13,0,13,6,0) X(14,0,14,6,1) X(15,0,15,7,0) X(16,1,0,7,1) X(17,1,1,8,0) X(18,1,2,9,0) X(19,1,3,10,0) X(20,1,4,11,0) X(21,1,5,12,0) X(22,1,6,13,0) X(23,1,7,14,0) X(24,2,0,15,0)
template <int OFF> __device__ __forceinline__ void sort16(float (&v)[64]) {
#pragma unroll
    for (int k = 2; k <= 16; k <<= 1)
#pragma unroll
        for (int j = k >> 1; j > 0; j >>= 1)
#pragma unroll
            for (int i = 0; i < 16; ++i) { const int l = i ^ j; if (l > i) { const float a = v[OFF + i], b = v[OFF + l]; const float hi = fmaxf(a, b), lo = fminf(a, b);
                if ((i & k) == 0) { v[OFF + i] = hi; v[OFF + l] = lo; } else { v[OFF + i] = lo; v[OFF + l] = hi; } } }
}
template <int OFF> __device__ __forceinline__ void merge16(float (&v)[64]) {
#pragma unroll
    for (int j = 8; j > 0; j >>= 1)
#pragma unroll
        for (int i = 0; i < 16; ++i) { const int l = i ^ j; if (l > i) { const float a = v[OFF + i], b = v[OFF + l]; v[OFF + i] = fmaxf(a, b); v[OFF + l] = fminf(a, b); } }
}
template <int A, int B> __device__ __forceinline__ void top16_merge(float (&v)[64]) {
#pragma unroll
    for (int i = 0; i < 16; ++i) v[A + i] = fmaxf(v[A + i], v[B + 15 - i]);
    merge16<A>(v);
}
__device__ __forceinline__ void top16_of_64(float (&v)[64]) {
    sort16<0>(v); sort16<16>(v); sort16<32>(v); sort16<48>(v);
    top16_merge<0, 16>(v); top16_merge<32, 48>(v); top16_merge<0, 32>(v);
}
__device__ __forceinline__ void topk_phase(LAS unsigned char* lds, const bf16* QP, const bf16* SKb, int* IDX, float* GATE, int vcu, int G) {
    const int tid = opaque_tid(), lane = tid & 63, wave = __builtin_amdgcn_readfirstlane(tid >> 6), r32 = lane & 31, hh = lane >> 5;
    for (int i = tid; i < 256 * 16; i += NTHREADS) { const int row = i >> 4, ch = i & 15; *(LAS v4u*)(lds + row * SKP + ch * 16) = *(const v4u*)(SKb + row * 128 + ch * 8); }
    __syncthreads();
    for (int unit = vcu * NWAVES + wave; unit < (M / 32) * PHD; unit += G * NWAVES) {
        const int tile = unit >> 3, h = unit & 7; const int tok = tile * 32 + r32;
        float L[2][16];
#pragma unroll
        for (int p = 0; p < 2; ++p) {
            bf16x8 qf[8];
#pragma unroll
            for (int sidx = 0; sidx < 8; ++sidx) qf[sidx] = *(const bf16x8*)(QP + ((((size_t)(tile * 8 + h) * 2 + p) * 8 + sidx) * 64 + lane) * 8);
            float v[64];
#define TK_KT(kt) { f32x16 acc; \
                _Pragma("unroll") for (int r = 0; r < 16; ++r) acc[r] = 0.f; \
                _Pragma("unroll") for (int sidx = 0; sidx < 8; ++sidx) { const bf16x8 kf = *(const LAS bf16x8*)(lds + (p * 128 + 32 * kt + r32) * SKP + 32 * sidx + 16 * hh); acc = __builtin_amdgcn_mfma_f32_32x32x16_bf16(kf, qf[sidx], acc, 0, 0, 0); } \
                _Pragma("unroll") for (int r = 0; r < 16; ++r) { const unsigned kidx = (unsigned)(32 * kt + (r & 3) + 8 * (r >> 2)); v[16 * kt + r] = __uint_as_float(((__float_as_uint(acc[r]) & 0xffffff80u) | (unsigned)(hh << 2)) | kidx); } \
                sort16<16 * kt>(v); __builtin_amdgcn_sched_barrier(0); }
            TK_KT(0) TK_KT(1) top16_merge<0, 16>(v); __builtin_amdgcn_sched_barrier(0);
            TK_KT(2) TK_KT(3) top16_merge<32, 48>(v); __builtin_amdgcn_sched_barrier(0);
            top16_merge<0, 32>(v); __builtin_amdgcn_sched_barrier(0);
#undef TK_KT
            float t[16];
#pragma unroll
            for (int i = 0; i < 16; ++i) t[i] = __shfl_xor(v[15 - i], 32);
#pragma unroll
            for (int i = 0; i < 16; ++i) v[i] = fmaxf(v[i], t[i]);
            merge16<0>(v);
#pragma unroll
            for (int i = 0; i < 16; ++i) L[p][i] = v[i];
        }
        float sm[25];
#define X(c, i0, j0, i1, j1) { const float s0 = L[0][i0] + L[1][j0], s1 = L[0][i1] + L[1][j1]; sm[c] = hh ? s1 : s0; }
        TK_PAIR25(X)
#undef X
        float v[64];
#pragma unroll
        for (int c = 0; c < 25; ++c) v[c] = sm[c];
#pragma unroll
        for (int c = 25; c < 32; ++c) v[c] = -3.0e38f;
        sort16<0>(v); sort16<16>(v); top16_merge<0, 16>(v);
        float T;
        { float t[16];
#pragma unroll
          for (int i = 0; i < 16; ++i) t[i] = __shfl_xor(v[15 - i], 32);
#pragma unroll
          for (int i = 0; i < 16; ++i) t[i] = fmaxf(v[i], t[i]);
          T = fminf(fminf(t[0], t[1]), t[2]);
#pragma unroll
          for (int i = 3; i < 15; i += 2) T = fminf(fminf(T, t[i]), t[i + 1]);
          T = fminf(T, t[15]); }
        const float smax = L[0][0] + L[1][0];
        unsigned ia[16], ib[16];
#pragma unroll
        for (int i = 0; i < 16; ++i) { ia[i] = (__float_as_uint(L[0][i]) & 127u) << 7; ib[i] = __float_as_uint(L[1][i]) & 127u; }
        float pe[25]; float den = 0.f; int cnt = 0;
#pragma unroll
        for (int c = 0; c < 25; ++c) { const bool sel = sm[c] >= T; const float e = __builtin_amdgcn_exp2f((sm[c] - smax) * LOG2E); pe[c] = e; den += sel ? e : 0.f; cnt += sel ? 1 : 0; }
        den += __shfl_xor(den, 32);
        const int ocnt = __shfl_xor(cnt, 32);
        int pos = hh ? ocnt : 0;
        const float inv = 1.0f / den;
        const size_t ob = (size_t)tok * 128 + h * 16;
#define X(c, i0, j0, i1, j1) { const unsigned e0 = ia[i0] + ib[j0], e1 = ia[i1] + ib[j1]; const unsigned em = hh ? e1 : e0; \
            const bool sel = sm[c] >= T; \
            if (sel && pos < 16) { GATE[ob + pos] = pe[c] * inv; IDX[ob + pos] = (int)em; } \
            pos += sel ? 1 : 0; }
        TK_PAIR25(X)
#undef X
    }
}
}

__device__ __forceinline__ float dot2bf(unsigned a, unsigned b, float c) { return __builtin_amdgcn_fdot2_f32_bf16(__builtin_bit_cast(bf16x2_t, a), __builtin_bit_cast(bf16x2_t, b), c, false); }
__device__ __forceinline__ float gelu_erf(float x) { return 0.5f * x * (1.0f + erff(x * 0.70710678118654752f)); }
__device__ __forceinline__ void gather_phase(const bf16* XG2, const float* SSQ, const unsigned char* EU, const unsigned char* EV, const float* SU, const float* SV, const int* IDX, const float* GATE, float* WGT, const float* fg, float* OUT, int vcu, int G) {
    const int tid = opaque_tid(), lane = tid & 63, wave = tid >> 6, c32 = lane & 31, hf = lane >> 5;
    const int emap = 16 * (lane & 3) + 2 * ((lane >> 2) & 7) + hf;
    const unsigned loff = (unsigned)c32 * 24u;
    struct __attribute__((packed, aligned(4))) U6 { unsigned d[6]; };
    for (int tok = vcu * NWAVES + wave; tok < M; tok += G * NWAVES) {
        unsigned hq[16];
        { const v4u* hp = (const v4u*)(XG2 + (size_t)tok * 1024 + c32 * 32);
#pragma unroll
          for (int j = 0; j < 4; ++j) { const v4u w = hp[j]; hq[4 * j] = w.x; hq[4 * j + 1] = w.y; hq[4 * j + 2] = w.z; hq[4 * j + 3] = w.w; } }
        const float rs2 = 1.0f / sqrtf(SSQ[tok] * (1.f / 1024.f) + EPS);
        int idxl[2];
#pragma unroll
        for (int blk = 0; blk < 2; ++blk) {
            idxl[blk] = IDX[(size_t)tok * 128 + blk * 64 + emap];
            const float gate = GATE[(size_t)tok * 128 + blk * 64 + emap];
            const float isu = SU[idxl[blk]] * rs2, isv = SV[idxl[blk]];
            float dots = 0.f;
#pragma unroll
            for (int grp = 0; grp < 4; ++grp) {
                U6 ur[8];
#pragma unroll
                for (int i = 0; i < 8; ++i) { const int ia = __builtin_amdgcn_readlane(idxl[blk], 4 * i + grp), ib = __builtin_amdgcn_readlane(idxl[blk], 32 + 4 * i + grp);
                    ur[i] = *(const U6*)(EU + (size_t)(hf ? ib : ia) * E6ROW + loff); }
                float pp[8];
#pragma unroll
                for (int i = 0; i < 8; ++i) { const v6u d = {ur[i].d[0], ur[i].d[1], ur[i].d[2], ur[i].d[3], ur[i].d[4], ur[i].d[5]};
                    const v32bf rb = __builtin_amdgcn_cvt_scalef32_pk32_bf16_fp6(d, 1.0f);
                    typedef unsigned v16u __attribute__((ext_vector_type(16)));
                    const v16u rw = __builtin_bit_cast(v16u, rb);
                    float a0 = 0.f, a1 = 0.f;
#pragma unroll
                    for (int j = 0; j < 8; ++j) { a0 = dot2bf(rw[2 * j], hq[2 * j], a0); a1 = dot2bf(rw[2 * j + 1], hq[2 * j + 1], a1); }
                    pp[i] = a0 + a1; }
#pragma unroll
                for (int o = 16, n = 4; n >= 1; o >>= 1, n >>= 1) { const bool hi = (lane & o) != 0;
#pragma unroll
                    for (int k = 0; k < n; ++k) { const float a = pp[k], b = pp[k + n]; const float send = hi ? a : b, keep = hi ? b : a; pp[k] = keep + __shfl_xor(send, o); } }
                float r = pp[0]; r += __shfl_xor(r, 2); r += __shfl_xor(r, 1);
                dots = ((lane & 3) == grp) ? r : dots;
            }
            WGT[(size_t)tok * 128 + blk * 64 + emap] = gate * gelu_erf(dots * isu) * isv;
        }
    }
    for (int tok = vcu * NWAVES + wave; tok < M; tok += G * NWAVES) {
        int idxl[2]; float wl[2];
#pragma unroll
        for (int blk = 0; blk < 2; ++blk) { idxl[blk] = IDX[(size_t)tok * 128 + blk * 64 + emap]; wl[blk] = WGT[(size_t)tok * 128 + blk * 64 + emap]; }
        v32f acc;
#pragma unroll
        for (int k = 0; k < 32; ++k) acc[k] = 0.f;
#pragma unroll
        for (int blk = 0; blk < 2; ++blk) {
#pragma unroll 1
            for (int bt = 0; bt < 4; ++bt) {
                U6 vr[8];
#pragma unroll
                for (int i = 0; i < 8; ++i) { const int pr = bt * 8 + i; const int ia = __builtin_amdgcn_readlane(idxl[blk], pr), ib = __builtin_amdgcn_readlane(idxl[blk], 32 + pr);
                    vr[i] = *(const U6*)(EV + (size_t)(hf ? ib : ia) * E6ROW + loff); }
#pragma unroll
                for (int i = 0; i < 8; ++i) { const int pr = bt * 8 + i;
                    const int wa = __builtin_amdgcn_readlane((int)__float_as_uint(wl[blk]), pr), wb = __builtin_amdgcn_readlane((int)__float_as_uint(wl[blk]), 32 + pr);
                    const float w = __uint_as_float((unsigned)(hf ? wb : wa));
                    const v6u d = {vr[i].d[0], vr[i].d[1], vr[i].d[2], vr[i].d[3], vr[i].d[4], vr[i].d[5]};
                    const v32f rv = __builtin_amdgcn_cvt_scalef32_pk32_f32_fp6(d, 1.0f);
                    acc = acc + rv * w; }
            }
        }
        float o16[16];
#pragma unroll
        for (int k = 0; k < 16; ++k) { const float lo = acc[k], hi = acc[16 + k]; const float mine = hf ? hi : lo, other = hf ? lo : hi; o16[k] = mine + __shfl_xor(other, 32); }
        const size_t co = (size_t)tok * 1024 + c32 * 32 + hf * 16;
        float* orow = OUT + co; float ss = 0.f; f32x4 x2[4];
        { const v4u* xp = (const v4u*)(XG2 + co); const v4u w0 = xp[0], w1 = xp[1];
          x2[0] = (f32x4){bflo(w0.x) + o16[0], bfhi(w0.x) + o16[1], bflo(w0.y) + o16[2], bfhi(w0.y) + o16[3]};
          x2[1] = (f32x4){bflo(w0.z) + o16[4], bfhi(w0.z) + o16[5], bflo(w0.w) + o16[6], bfhi(w0.w) + o16[7]};
          x2[2] = (f32x4){bflo(w1.x) + o16[8], bfhi(w1.x) + o16[9], bflo(w1.y) + o16[10], bfhi(w1.y) + o16[11]};
          x2[3] = (f32x4){bflo(w1.z) + o16[12], bfhi(w1.z) + o16[13], bflo(w1.w) + o16[14], bfhi(w1.w) + o16[15]}; }
#pragma unroll
        for (int j = 0; j < 4; ++j) ss += (x2[j][0] * x2[j][0] + x2[j][1] * x2[j][1]) + (x2[j][2] * x2[j][2] + x2[j][3] * x2[j][3]);
        const float rs = 1.0f / sqrtf(wave_sum(ss) * (1.f / 1024.f) + EPS);
#pragma unroll
        for (int j = 0; j < 4; ++j) { const f32x4 g4 = *(const f32x4*)(fg + c32 * 32 + hf * 16 + 4 * j); *(f32x4*)(orow + 4 * j) = x2[j] * rs * g4; }
    }
}

#define RLX_AGENT __ATOMIC_RELAXED, __HIP_MEMORY_SCOPE_AGENT
#define XB_TMO      128
#define XB_XCNT(j)  (256  + 64 * (j))
#define XB_XSUB(j)  (1280 + 64 * (j))
#define XB_XGEN(j)  (2304 + 64 * (j))
#define XB_TOP      3328
#define XB_TOPGEN   3392
#define XCD_BAR_WORDS 3456
#define XB_SPIN_CAP (1u << 18)

__device__ __forceinline__ unsigned xb_ld(unsigned* p)              { return __hip_atomic_load(p, __ATOMIC_RELAXED, __HIP_MEMORY_SCOPE_AGENT); }
__device__ __forceinline__ unsigned xb_add(unsigned* p, unsigned v) { return __hip_atomic_fetch_add(p, v, __ATOMIC_RELAXED, __HIP_MEMORY_SCOPE_AGENT); }
__device__ __forceinline__ unsigned xb_xcc_id() { return (unsigned)__builtin_amdgcn_s_getreg((3 << 11) | 20) & 0xFu; }
#define XB_SPIN(cond, bar) do { unsigned _sp = 0; while (cond) { __builtin_amdgcn_s_sleep(1); \
    if ((++_sp & 255u) == 0u) { if (xb_ld(&(bar)[XB_TMO])) break; if (_sp > XB_SPIN_CAP) { atomicAdd(&(bar)[XB_TMO], 1u); break; } } } } while (0)

struct XcdBarrier {
    unsigned* bar; unsigned x;
    volatile LAS unsigned* st;
};

__device__ __forceinline__ XcdBarrier xcd_barrier_post(unsigned* bar, volatile LAS unsigned* st) {
    XcdBarrier b; b.bar = bar; b.x = xb_xcc_id(); b.st = st;
    if (threadIdx.x == 0) (void)xb_add(&bar[XB_XCNT(b.x)], 1u);
    return b;
}
__device__ __forceinline__ void xcd_barrier_complete(unsigned* bar, unsigned x, unsigned& nloc, unsigned& nx) {
    const unsigned G = gridDim.x * gridDim.y * gridDim.z;
    unsigned sum, cnt, mine, sp = 0u;
    for (;;) {
        sum = 0u; cnt = 0u; mine = 0u;
#pragma unroll
        for (unsigned j = 0; j < 16; ++j) { const unsigned c = xb_ld(&bar[XB_XCNT(j)]); sum += c; cnt += (c > 0u) ? 1u : 0u; mine = (j == x) ? c : mine; }
        if (sum == G) break;
        __builtin_amdgcn_s_sleep(1);
        if ((++sp & 255u) == 0u) { if (xb_ld(&bar[XB_TMO])) break; if (sp > XB_SPIN_CAP) { atomicAdd(&bar[XB_TMO], 1u); break; } }
    }
    nloc = mine > 0u ? mine : 1u; nx = cnt > 0u ? cnt : 1u;
}

__device__ __forceinline__ void xcd_barrier(const XcdBarrier& b) {
    asm volatile("s_waitcnt vmcnt(0)" ::: "memory");
    __syncthreads();
    if (threadIdx.x == 0) {
        unsigned* bar = b.bar;
        __builtin_amdgcn_s_waitcnt(0);
        unsigned nloc = b.st[0], nx = b.st[1];
        if (nloc == 0u) { xcd_barrier_complete(bar, b.x, nloc, nx); b.st[0] = nloc; b.st[1] = nx; }
        const unsigned old = xb_add(&bar[XB_XSUB(b.x)], 1u);
        const unsigned gen = old / nloc;
        if (old + 1u == (gen + 1u) * nloc) {
            __builtin_amdgcn_fence(__ATOMIC_RELEASE, "agent");
            asm volatile("s_waitcnt vmcnt(0)" ::: "memory");
            const unsigned og = xb_add(&bar[XB_TOP], 1u);
            const unsigned tg = og / nx;
            if (og + 1u == (tg + 1u) * nx) xb_add(&bar[XB_TOPGEN], 1u);
            else XB_SPIN(xb_ld(&bar[XB_TOPGEN]) == tg, bar);
            __builtin_amdgcn_fence(__ATOMIC_ACQUIRE, "agent");
            xb_add(&bar[XB_XGEN(b.x)], 1u);
            asm volatile("s_waitcnt vmcnt(0)" ::: "memory");
        } else {
            XB_SPIN(xb_ld(&bar[XB_XGEN(b.x)]) == gen, bar);
            __builtin_amdgcn_fence(__ATOMIC_ACQUIRE, "agent");
            asm volatile("s_waitcnt vmcnt(0)" ::: "memory");
        }
    }
    __syncthreads();
}


__global__ void __launch_bounds__(NTHREADS, 2) fwd_kernel(Args args) {
    extern __shared__ __attribute__((aligned(16))) unsigned char lds[];
    const int tid = threadIdx.x, lane = tid & 63, wave = __builtin_amdgcn_readfirstlane(tid >> 6);
    const int G = gridDim.x, bx = blockIdx.x;
    const int vcu = (G % 8 == 0) ? (bx % 8) * (G / 8) + bx / 8 : bx;
    unsigned char* ws = args.ws;
    const float* x = args.in[0];
    bf16* WinT = (bf16*)(ws + WS_WIN); bf16* WpwT = (bf16*)(ws + WS_WPW); bf16* WoT = (bf16*)(ws + WS_WO); bf16* WoutT = (bf16*)(ws + WS_WOUT); bf16* WqT = (bf16*)(ws + WS_WQ);
    unsigned char* EU = ws + WS_EU; unsigned char* EV = ws + WS_EV; float* SU = (float*)(ws + WS_ESC); float* SV = SU + NEXP; float* SSQ = SV + NEXP; bf16* SKb = (bf16*)(ws + WS_SK);
    bf16* XN = (bf16*)(ws + WS_XN); bf16* Ub = (bf16*)(ws + WS_U); bf16* MG = (bf16*)(ws + WS_MG); bf16* XG2 = (bf16*)(ws + WS_XG2);
    bf16* Gt = (bf16*)(ws + WS_G); bf16* QP = (bf16*)(ws + WS_QP);
    bf16* Qb = (bf16*)(ws + WS_Q); bf16* Kb = (bf16*)(ws + WS_K); bf16* Vb = (bf16*)(ws + WS_V);
    int* IDX = (int*)(ws + WS_IDX); float* GATE = (float*)(ws + WS_GATE);
    bf16* CA = (bf16*)(ws + WS_CA);
    LAS unsigned char* lds3 = (LAS unsigned char*)lds;
    const int lo = args.ph_lo, hi = args.ph_hi;
    volatile LAS unsigned* MISC = (volatile LAS unsigned*)(lds3 + MISC_OFF);
    if (tid < 32) MISC[tid] = 0u;
    __syncthreads();
    XcdBarrier bar_; bar_.bar = (unsigned*)(ws + WS_CTL) + CW_BAR; bar_.x = 0; bar_.st = nullptr;
    if (hi - lo > 1) bar_ = xcd_barrier_post((unsigned*)(ws + WS_CTL) + CW_BAR, MISC + 8);
#define SEAM(k) do { if (IN(k) && IN((k) + 1)) xcd_barrier(bar_); } while (0)
#ifdef ONLY_PHASE
#define IN(k) ((k) == ONLY_PHASE && lo <= (k) && (k) < hi)
#else
#define IN(k) (lo <= (k) && (k) < hi)
#endif

    if (IN(0)) {
        LAS float* scr = (LAS float*)(lds3 + wave * 16384);
        const int gw = vcu * NWAVES + wave, NGW = G * NWAVES;
        constexpr int I_IN = 16 * (IN_DIM / 32), I_SQ = 16 * 32, I_Q = 16 * 64;
        constexpr int NITEMS = I_IN + 3 * I_SQ + I_Q;
        for (int it = gw; it < NITEMS; it += NGW) {
            int r = it;
            if (r < I_IN) { const int nblk = IN_DIM / 32, kb = r / nblk, nb = r % nblk; p0_transpose_item(args.in[2], D, IN_DIM, WinT, glu_row(32 * nb), scr, kb, nb, lane); continue; } r -= I_IN;
            if (r < I_SQ) { p0_transpose_item(args.in[7], D, D, WpwT, 32 * (r % 32), scr, r / 32, r % 32, lane); continue; } r -= I_SQ;
            if (r < I_SQ) { p0_transpose_item(args.in[9], D, D, WoT, 32 * (r % 32), scr, r / 32, r % 32, lane); continue; } r -= I_SQ;
            if (r < I_SQ) { p0_transpose_item(args.in[10], D, D, WoutT, 32 * (r % 32), scr, r / 32, r % 32, lane); continue; } r -= I_SQ;
            p0_transpose_item(args.in[12], D, 2048, WqT, 32 * (r % 64), scr, r / 64, r % 64, lane, args.in[11]);
        }
        const size_t gt = (size_t)vcu * NTHREADS + tid, ngt = (size_t)G * NTHREADS;
        for (size_t i = gt; i < (size_t)M; i += ngt) SSQ[i] = 0.f;
        cvt_stream(args.in[13], SKb, (size_t)2 * NKEYS * PHALF, gt, ngt);
        for (int r = gw; r < NEXP; r += NGW) { const int tb = r >= NEXP / 2, e = 2 * (r - tb * (NEXP / 2)); rows_to_fp6(args.in[14 + tb] + (size_t)e * D, (tb ? EV : EU) + (size_t)e * E6ROW, (tb ? SV : SU) + e, lane, tb ? nullptr : args.in[11], scr); }
        for (int m = gw; m < M; m += 4 * NGW) {
            f32x4 v[4][4]; float ssr[4];
#pragma unroll
            for (int r = 0; r < 4; ++r) { const f32x4* xr = (const f32x4*)(x + (size_t)(m + r * NGW) * D) + lane;
#pragma unroll
                for (int j = 0; j < 4; ++j) v[r][j] = xr[64 * j]; }
#pragma unroll
            for (int r = 0; r < 4; ++r) { float q = 0.f;
#pragma unroll
                for (int j = 0; j < 4; ++j) q += (v[r][j][0] * v[r][j][0] + v[r][j][1] * v[r][j][1]) + (v[r][j][2] * v[r][j][2] + v[r][j][3] * v[r][j][3]);
                ssr[r] = q; }
#pragma unroll
            for (int o = 1; o < 64; o <<= 1) {
#pragma unroll
                for (int r = 0; r < 4; ++r) ssr[r] += __shfl_xor(ssr[r], o); }
#pragma unroll
            for (int r = 0; r < 4; ++r) { const float rs = 1.0f / sqrtf(ssr[r] * (1.f / 1024.f) + EPS); v2u* o8 = (v2u*)(XN + (size_t)(m + r * NGW) * D) + lane;
#pragma unroll
                for (int j = 0; j < 4; ++j) { const f32x4 gg = ((const f32x4*)args.in[1])[lane + 64 * j]; v2u o; o.x = pk2(v[r][j][0] * rs * gg[0], v[r][j][1] * rs * gg[1]); o.y = pk2(v[r][j][2] * rs * gg[2], v[r][j][3] * rs * gg[3]); o8[64 * j] = o; } }
        }
    }
    SEAM(0);
    if (IN(1)) {
        pg8::Gemm g{XN, WinT, XN, WinT, M, IN_DIM, D}; pg8::StaticOrder S; S.init(M, IN_DIM, G, bx, 1);
        EpiInProj E{Ub, Qb, Kb, Vb, Gt};
        pg8::gemm_phase<EpiInProj>(lds3, g, S, E);
    }
    SEAM(1);
    if (IN(2)) {
        conv_phase(lds3, Ub, CA, args.in[3], args.in[4], args.in[5], args.in[6], vcu, G);
        __syncthreads();
        att::attn_phase(lds3, Qb, Kb, Vb, Qb, args.in[8], vcu, G);
    }
    SEAM(2);
    if (IN(3)) {
        pg8::Gemm g{CA, WpwT, Qb, WoT, M, D, D}; pg8::StaticOrder S; S.init(M, D, G, bx, 2);
        EpiMerge E{Gt, MG};
        pg8::gemm_phase<EpiMerge>(lds3, g, S, E);
    }
    SEAM(3);
    if (IN(4)) {
        pg8::Gemm g{MG, WoutT, MG, WoutT, M, D, D}; pg8::StaticOrder S; S.init(M, D, G, bx, 1);
        EpiResid E{x, XG2, SSQ};
        pg8::gemm_phase<EpiResid>(lds3, g, S, E);
    }
    SEAM(4);
    if (IN(5)) {
        pg8::Gemm g{XG2, WqT, XG2, WqT, M, 2048, D}; pg8::StaticOrder S; S.init(M, 2048, G, bx, 1);
        EpiBf16Rs E{QP, SSQ};
        pg8::gemm_phase<EpiBf16Rs>(lds3, g, S, E);
    }
    SEAM(5);
    if (IN(6)) tk::topk_phase(lds3, QP, SKb, IDX, GATE, vcu, G);
    SEAM(6);
    if (IN(7)) gather_phase(XG2, SSQ, EU, EV, SU, SV, IDX, GATE, GATE, args.in[16], args.out, vcu, G);
#undef IN
#undef SEAM
}

extern "C" void kernel_launch(void* const* d_in, const int* in_sizes, int n_in, void* d_out, int out_size, void* d_ws, size_t ws_size, hipStream_t stream) {
    static int grid = 0;
    if (grid == 0) {
        if (n_in != 17 || in_sizes[0] != M * D || out_size != M * D || ws_size < WS_END) { fprintf(stderr, "kernel_launch: unexpected shapes (n_in %d, in0 %d, out %d, ws %zu)\n", n_in, n_in > 0 ? in_sizes[0] : -1, out_size, ws_size); grid = -1; return; }
        int dev = 0, cus = 0;
        if (hipGetDevice(&dev) != hipSuccess || hipDeviceGetAttribute(&cus, hipDeviceAttributeMultiprocessorCount, dev) != hipSuccess) { grid = -1; return; }
        if (hipFuncSetAttribute((const void*)fwd_kernel, hipFuncAttributeMaxDynamicSharedMemorySize, LDS_BYTES) != hipSuccess) { fprintf(stderr, "kernel_launch: hipFuncSetAttribute failed\n"); grid = -1; return; }
        int per_cu = 0;
        if (hipOccupancyMaxActiveBlocksPerMultiprocessor(&per_cu, (const void*)fwd_kernel, NTHREADS, LDS_BYTES) != hipSuccess || per_cu < 1) { fprintf(stderr, "kernel_launch: occupancy query says %d\n", per_cu); }
        (void)hipGetLastError();
        grid = cus;
    }
    if (grid < 0) return;
    Args a{};
    for (int i = 0; i < 17; ++i) a.in[i] = (const float*)d_in[i];
    a.out = (float*)d_out; a.ws = (unsigned char*)d_ws;
    if (MK_N_LAUNCHES == 1) {
        a.ph_lo = 0; a.ph_hi = 8;
        if (hipMemsetAsync((char*)d_ws + WS_CTL, 0, CTL_ZERO_BYTES, stream) != hipSuccess) { fprintf(stderr, "kernel_launch: memset failed\n"); return; }
        hipLaunchKernelGGL(fwd_kernel, dim3(grid), dim3(NTHREADS), LDS_BYTES, stream, a);
    } else {
        for (int p = 0; p < 8; ++p) {
            a.ph_lo = p; a.ph_hi = p + 1;
            hipLaunchKernelGGL(fwd_kernel, dim3(grid), dim3(NTHREADS), LDS_BYTES, stream, a);
        }
    }
}
```

```cpp
#include <hip/hip_runtime.h>
#include <cstdio>
#include <cstdint>

#ifndef MK_N_LAUNCHES
#define MK_N_LAUNCHES 1
#endif

constexpr int BATCH = 16, SEQ = 2048, D = 1024, M = BATCH * SEQ;
constexpr int CK = 31, CPAD = 15;
constexpr int NH = 16, NKV = 4, HD = 64, KVD = 256, WIN = 128;
constexpr int IN_DIM = 5632;
constexpr int PHD = 8, PKD = 256, PHALF = 128, NKEYS = 128, NEXP = 16384, TOPK = 16;
constexpr float EPS = 1e-6f;
constexpr int NWAVES = 8, NTHREADS = 512;
constexpr float LOG2E = 1.4426950408889634f, QSCALE = 0.125f * 1.4426950408889634f;

typedef unsigned short bf16;
typedef unsigned v4u __attribute__((ext_vector_type(4)));
typedef unsigned v2u __attribute__((ext_vector_type(2)));
typedef float f32x4 __attribute__((ext_vector_type(4)));
typedef float f32x2 __attribute__((ext_vector_type(2)));
typedef __bf16 bf16x2_t __attribute__((ext_vector_type(2)));
#define LAS __attribute__((address_space(3)))

__device__ __forceinline__ int opaque_tid() { int t = threadIdx.x; asm volatile("" : "+v"(t)); return t; }
__device__ __forceinline__ void fmac_s(float& acc, float a, float b) { asm volatile("v_fmac_f32 %0, %1, %2" : "+v"(acc) : "v"(a), "v"(b)); }
__device__ __forceinline__ void mul_s(float& x, float a) { asm volatile("v_mul_f32 %0, %0, %1" : "+v"(x) : "v"(a)); }
__device__ __forceinline__ unsigned pk2(float lo, float hi) { f32x2 v = {lo, hi}; bf16x2_t b = __builtin_convertvector(v, bf16x2_t); return __builtin_bit_cast(unsigned, b); }
__device__ __forceinline__ float bflo(unsigned u) { return __uint_as_float(u << 16); }
__device__ __forceinline__ float bfhi(unsigned u) { return __uint_as_float(u & 0xffff0000u); }
__device__ __forceinline__ float sigmoidf_(float x) { return __builtin_amdgcn_rcpf(1.0f + __builtin_amdgcn_exp2f(x * -1.4426950408889634f)); }
__device__ __forceinline__ float wave_sum(float v) {
#pragma unroll
    for (int o = 1; o < 64; o <<= 1) v += __shfl_xor(v, o);
    return v;
}

namespace pg8 {
typedef unsigned short bf16_t;
typedef short bf16x8 __attribute__((ext_vector_type(8)));
constexpr int BM = 256, BK = 64, HALF = 128, HTB = HALF * BK * 2, STAGE_BYTES = 8 * HTB, NXCD = 8, WGM = 8;

__host__ __device__ __forceinline__ int lds_byte(int r, int c) { const int st = (r >> 4) * 2 + (c >> 5), rr = r & 15, cc = c & 31, ob = rr * 64 + cc * 2; return st * 1024 + (ob ^ (((ob >> 9) & 1) << 5)); }
__host__ __device__ __forceinline__ void stage_rc(int b, int& R, int& C) { const int st = b / 1024, sb = b % 1024, swz = sb ^ (((sb >> 9) & 1) << 5); R = (st >> 1) * 16 + swz / 64; C = (st & 1) * 32 + (swz % 64) / 2; }
__host__ __device__ __forceinline__ int perm32(int rho) { const int n = rho >> 4, i = rho & 15; return 8 * (i >> 2) + 4 * n + (i & 3); }

struct Unit { int pm, pn, g; };
struct Gemm { const bf16_t* A0; const bf16_t* B0; const bf16_t* A1; const bf16_t* B1; int M, N, K; };

struct StaticOrder {
    int nM, nN, nwg, G, c, per;
    __host__ __device__ void init(int M_, int N_, int G_, int c_, int per_) { nM = M_ / BM; nN = N_ / BM; nwg = nM * nN; G = G_; c = c_; per = per_; }
    __host__ __device__ bool next(int i, Unit& u) const {
        const int ti = i / per; u.g = i % per;
        const long L = (long)ti * G + c; if (L >= nwg) return false;
        int wgid = (int)L; { const int q = nwg / NXCD, r = nwg % NXCD, xcd = wgid % NXCD, off = wgid / NXCD; wgid = (xcd < r ? xcd * (q + 1) : r * (q + 1) + (xcd - r) * q) + off; }
        const int nig = WGM * nN, gid = wgid / nig, fm = gid * WGM, gsz = (nM - fm) < WGM ? (nM - fm) : WGM;
        u.pm = fm + ((wgid % nig) % gsz); u.pn = (wgid % nig) / gsz; return true;
    }
};

template <class Epi>
__device__ __forceinline__ void gemm_phase(LAS unsigned char* lds, const Gemm g, const StaticOrder& S, const Epi& E) {
    const int tid = opaque_tid(), wid = __builtin_amdgcn_readfirstlane(tid >> 6), lane = tid & 63, wr = wid >> 2, wc = wid & 3, fr = lane & 15, fq = lane >> 4;
    const int K = g.K, nt = K / BK;
    unsigned voffA[2], voffB[2];
#pragma unroll
    for (int i = 0; i < 2; ++i) { int R, C; stage_rc(tid * 16 + i * 8192, R, C); const int Rb = Epi::PERM ? ((R & ~31) + perm32(R & 31)) : R;
        voffA[i] = (unsigned)(R * K + C) * 2u; voffB[i] = (unsigned)(Rb * K + C) * 2u; }
    const size_t kstep = (size_t)(BK * 2);
    const size_t hstep = (size_t)HALF * K * 2;
    const size_t tstep = 2 * hstep;
    const unsigned ldsw = (unsigned)wid * 1024u;
    const int aoff = lds_byte(wr * 64 + fr, fq * 8), boff = lds_byte(wc * 32 + fr, fq * 8);
#define PG8_SA(b, h) (((b) * 2 + (h)) * HTB)
#define PG8_SB(b, h) ((4 + (b) * 2 + (h)) * HTB)
#define PG8_STAGE(bufoff, gbase, voff) do { _Pragma("unroll") for (int _i = 0; _i < 2; ++_i) \
        __builtin_amdgcn_global_load_lds((const unsigned*)((const char*)(gbase) + (voff)[_i]), (LAS unsigned*)(lds + (bufoff) + ldsw + _i * 8192), 16, 0, 0); } while (0)
#define PG8_LDA(dst, b, h) do { _Pragma("unroll") for (int m = 0; m < 4; ++m) _Pragma("unroll") for (int k = 0; k < 2; ++k) dst[m][k] = *(const LAS bf16x8*)(lds + PG8_SA(b, h) + aoff + m * 2048 + k * 1024); } while (0)
#define PG8_LDB(dst, b, h) do { _Pragma("unroll") for (int n = 0; n < 2; ++n) _Pragma("unroll") for (int k = 0; k < 2; ++k) dst[n][k] = *(const LAS bf16x8*)(lds + PG8_SB(b, h) + boff + n * 2048 + k * 1024); } while (0)
#define PG8_MMA(ai, bj, At, Bt) do { __builtin_amdgcn_s_setprio(1); _Pragma("unroll") for (int m = 0; m < 4; ++m) _Pragma("unroll") for (int n = 0; n < 2; ++n) _Pragma("unroll") for (int k = 0; k < 2; ++k) \
        acc[ai][bj][m][n] = __builtin_amdgcn_mfma_f32_16x16x32_bf16(Bt[n][k], At[m][k], acc[ai][bj][m][n], 0, 0, 0); __builtin_amdgcn_s_setprio(0); } while (0)
#define PG8_WAIT_V(n) asm volatile("s_waitcnt vmcnt(" #n ")" ::: "memory")
#define PG8_WAIT_L(n) asm volatile("s_waitcnt lgkmcnt(" #n ")" ::: "memory")
#define PG8_BAR __builtin_amdgcn_s_barrier()
#define PG8_SCHED __builtin_amdgcn_sched_barrier(0)
    Unit cur, nxt; int ui = 0;
    if (!S.next(0, cur)) return;
    f32x4 acc[2][2][4][2];
#pragma unroll
    for (int a = 0; a < 2; ++a)
#pragma unroll
        for (int b = 0; b < 2; ++b)
#pragma unroll
            for (int m = 0; m < 4; ++m)
#pragma unroll
                for (int n = 0; n < 2; ++n) acc[a][b][m][n] = (f32x4){0.f, 0.f, 0.f, 0.f};
    bf16x8 At[4][2], B0[2][2], B1[2][2];
    const char* cA = (const char*)(cur.g ? g.A1 : g.A0) + (size_t)cur.pm * tstep; const char* cB = (const char*)(cur.g ? g.B1 : g.B0) + (size_t)cur.pn * tstep;
    PG8_STAGE(PG8_SB(0, 0), cB, voffB); PG8_STAGE(PG8_SB(0, 1), cB + hstep, voffB); PG8_STAGE(PG8_SA(0, 0), cA, voffA); PG8_STAGE(PG8_SA(0, 1), cA + hstep, voffA);
    if (wr == 1) PG8_BAR;
    PG8_WAIT_V(2); PG8_BAR;
    PG8_STAGE(PG8_SB(1, 0), cB + kstep, voffB); PG8_STAGE(PG8_SA(1, 0), cA + kstep, voffA); PG8_STAGE(PG8_SB(1, 1), cB + hstep + kstep, voffB);
    PG8_WAIT_V(6); PG8_BAR;
    for (;;) {
        const bool has_next = S.next(ui + 1, nxt);
        const char* nA = has_next ? (const char*)(nxt.g ? g.A1 : g.A0) + (size_t)nxt.pm * tstep : cA; const char* nB = has_next ? (const char*)(nxt.g ? g.B1 : g.B0) + (size_t)nxt.pn * tstep : cB;
        for (int t = 0; t < nt; t += 2) {
            const bool last = (t == nt - 2);
            const char* a1 = cA + (size_t)(t + 1) * kstep;
            const char* a2 = last ? nA : cA + (size_t)(t + 2) * kstep; const char* b2 = last ? nB : cB + (size_t)(t + 2) * kstep;
            const char* a3 = a2 + kstep; const char* b3 = b2 + kstep;
            PG8_LDB(B0, 0, 0); PG8_LDB(B1, 0, 1); PG8_SCHED; PG8_LDA(At, 0, 0); PG8_STAGE(PG8_SA(1, 1), a1 + hstep, voffA);
            PG8_WAIT_V(8); PG8_WAIT_L(0); PG8_BAR; PG8_MMA(0, 0, At, B0); PG8_MMA(0, 1, At, B1); PG8_BAR; PG8_SCHED;
            PG8_LDA(At, 0, 1); PG8_STAGE(PG8_SB(0, 0), b2, voffB); PG8_STAGE(PG8_SB(0, 1), b2 + hstep, voffB); PG8_STAGE(PG8_SA(0, 0), a2, voffA);
            PG8_WAIT_V(8); PG8_WAIT_L(0); PG8_BAR; PG8_MMA(1, 0, At, B0); PG8_MMA(1, 1, At, B1); PG8_BAR; PG8_SCHED;
            PG8_LDB(B0, 1, 0); PG8_LDB(B1, 1, 1); PG8_SCHED; PG8_LDA(At, 1, 0); PG8_STAGE(PG8_SA(0, 1), a2 + hstep, voffA);
            PG8_WAIT_V(8); PG8_WAIT_L(0); PG8_BAR; PG8_MMA(0, 0, At, B0); PG8_MMA(0, 1, At, B1); PG8_BAR; PG8_SCHED;
            PG8_LDA(At, 1, 1); PG8_STAGE(PG8_SB(1, 0), b3, voffB); PG8_STAGE(PG8_SB(1, 1), b3 + hstep, voffB); PG8_STAGE(PG8_SA(1, 0), a3, voffA);
            PG8_WAIT_V(8); PG8_WAIT_L(0); PG8_BAR; PG8_MMA(1, 0, At, B0); PG8_MMA(1, 1, At, B1); PG8_BAR; PG8_SCHED;
        }
        if (wr == 0) PG8_BAR;
        E(acc, cur, wr, wc, fr, fq);
        if (!has_next) break;
        if (!(Epi::CHAIN && cur.g == 0))
#pragma unroll
        for (int a = 0; a < 2; ++a)
#pragma unroll
            for (int b = 0; b < 2; ++b)
#pragma unroll
                for (int m = 0; m < 4; ++m)
#pragma unroll
                    for (int n = 0; n < 2; ++n) acc[a][b][m][n] = (f32x4){0.f, 0.f, 0.f, 0.f};
        cur = nxt; cA = nA; cB = nB; ++ui;
        if (wr == 1) PG8_BAR;
    }
    PG8_WAIT_V(0);
    PG8_BAR;
#undef PG8_SA
#undef PG8_SB
#undef PG8_STAGE
#undef PG8_LDA
#undef PG8_LDB
#undef PG8_MMA
#undef PG8_WAIT_V
#undef PG8_WAIT_L
#undef PG8_BAR
#undef PG8_SCHED
}
}

constexpr size_t MiB = 1u << 20;
constexpr size_t WS_CTL = 0;
constexpr size_t WS_WIN = 2 * MiB, WS_WPW = 13 * MiB, WS_WO = 15 * MiB, WS_WOUT = 17 * MiB, WS_WQ = 19 * MiB, WS_SK = 23 * MiB;
constexpr size_t WS_EU = 24 * MiB, WS_EV = 40 * MiB, WS_ESC = 56 * MiB;
constexpr size_t WS_XN = 88 * MiB, WS_U = 152 * MiB;
constexpr size_t WS_MG = 88 * MiB, WS_XG2 = 152 * MiB;
constexpr size_t WS_G = 216 * MiB;
constexpr size_t WS_QP = 216 * MiB;
constexpr size_t WS_Q = 344 * MiB, WS_K = 408 * MiB, WS_V = 424 * MiB;
constexpr size_t WS_IDX = 344 * MiB, WS_GATE = 360 * MiB;
constexpr size_t WS_CA = 440 * MiB;
constexpr size_t WS_END = 504 * MiB;
constexpr int LDS_BYTES = 147456;
constexpr int MISC_OFF = 131072 + 8192;
constexpr int CW_BAR = 4096;
constexpr size_t CTL_ZERO_BYTES = 65536;

struct Args { const float* in[17]; float* out; unsigned char* ws; int ph_lo, ph_hi; };

struct EpiInProj {
    static constexpr bool PERM = true, CHAIN = false;
    bf16 *U, *Q, *K, *V, *G;
    __device__ __forceinline__ void operator()(f32x4 (&acc)[2][2][4][2], const pg8::Unit& u, int wr, int wc, int fr, int fq) const {
        const int row0 = u.pm * 256 + wr * 64 + fr; const int cw = wc * 32 + 8 * fq;
        if (u.pn < 8) {
#pragma unroll
            for (int ai = 0; ai < 2; ++ai)
#pragma unroll
                for (int m = 0; m < 4; ++m) { const size_t row = (size_t)(row0 + ai * 128 + m * 16);
                    f32x4 a0 = acc[ai][0][m][0], a1 = acc[ai][0][m][1], b0 = acc[ai][1][m][0], b1 = acc[ai][1][m][1];
                    v4u w; w.x = pk2(a0[0] * sigmoidf_(b0[0]), a0[1] * sigmoidf_(b0[1])); w.y = pk2(a0[2] * sigmoidf_(b0[2]), a0[3] * sigmoidf_(b0[3]));
                    w.z = pk2(a1[0] * sigmoidf_(b1[0]), a1[1] * sigmoidf_(b1[1])); w.w = pk2(a1[2] * sigmoidf_(b1[2]), a1[3] * sigmoidf_(b1[3]));
                    *(v4u*)(U + row * 1024 + u.pn * 128 + cw) = w; }
        } else if (u.pn >= 14) {
            const int p = u.pn - 14; unsigned char* G8 = (unsigned char*)G;
#pragma unroll
            for (int ai = 0; ai < 2; ++ai)
#pragma unroll
                for (int m = 0; m < 4; ++m) { unsigned char* rowp = G8 + (size_t)(row0 + ai * 128 + m * 16) * 2048 + (size_t)(p * 128 + cw) * 2;
                    v4u w = {0u, 0u, 0u, 0u};
#pragma unroll
                    for (int j = 0; j < 4; ++j) { w.x = __builtin_amdgcn_cvt_pk_u8_f32(sigmoidf_(acc[ai][0][m][0][j]) * 255.0f, j, w.x); w.y = __builtin_amdgcn_cvt_pk_u8_f32(sigmoidf_(acc[ai][0][m][1][j]) * 255.0f, j, w.y);
                        w.z = __builtin_amdgcn_cvt_pk_u8_f32(sigmoidf_(acc[ai][1][m][0][j]) * 255.0f, j, w.z); w.w = __builtin_amdgcn_cvt_pk_u8_f32(sigmoidf_(acc[ai][1][m][1][j]) * 255.0f, j, w.w); }
                    *(v4u*)rowp = w; }
        } else {
            bf16* base; int ld, col0; float sc = 1.0f;
            if (u.pn < 12) { base = Q; ld = 1024; col0 = (u.pn - 8) * 256; sc = QSCALE; }
            else if (u.pn == 12) { base = K; ld = 256; col0 = 0; }
            else { base = V; ld = 256; col0 = 0; }
#pragma unroll
            for (int ai = 0; ai < 2; ++ai)
#pragma unroll
                for (int m = 0; m < 4; ++m) { bf16* rowp = base + (size_t)(row0 + ai * 128 + m * 16) * ld + col0 + cw;
#pragma unroll
                    for (int bj = 0; bj < 2; ++bj) { f32x4 v0 = acc[ai][bj][m][0] * sc, v1 = acc[ai][bj][m][1] * sc;
                        v4u w; w.x = pk2(v0[0], v0[1]); w.y = pk2(v0[2], v0[3]); w.z = pk2(v1[0], v1[1]); w.w = pk2(v1[2], v1[3]);
                        *(v4u*)(rowp + bj * 128) = w; } }
        }
    }
};
struct EpiMerge {
    static constexpr bool PERM = true, CHAIN = true;
    const bf16* G; bf16* MG;
    __device__ __forceinline__ void operator()(f32x4 (&acc)[2][2][4][2], const pg8::Unit& u, int wr, int wc, int fr, int fq) const {
        const int row0 = u.pm * 256 + wr * 64 + fr; const int col0 = u.pn * 256 + wc * 32 + 8 * fq;
        const unsigned char* G8 = (const unsigned char*)G;
#pragma unroll
        for (int ai = 0; ai < 2; ++ai) { const size_t row = (size_t)(row0 + ai * 128);
            const unsigned char* gp = G8 + row * 2048 + (size_t)col0 * 2; bf16* mp = MG + row * 1024 + col0;
            v4u gw[4][2];
#pragma unroll
            for (int m = 0; m < 4; ++m)
#pragma unroll
                for (int bj = 0; bj < 2; ++bj) gw[m][bj] = *(const v4u*)(gp + (size_t)(m * 16) * 2048 + bj * 256);
#pragma unroll
            for (int m = 0; m < 4; ++m)
#pragma unroll
                for (int bj = 0; bj < 2; ++bj) { const v4u g4 = gw[m][bj]; f32x4 v0 = acc[ai][bj][m][0], v1 = acc[ai][bj][m][1];
                    float fb[8];
#pragma unroll
                    for (int j = 0; j < 4; ++j) { fb[j] = fmaxf((float)((g4.z >> (8 * j)) & 0xffu), 1.0f); fb[4 + j] = fmaxf((float)((g4.w >> (8 * j)) & 0xffu), 1.0f); }
                    if (u.g) {
#pragma unroll
                        for (int j = 0; j < 4; ++j) { v0[j] *= fb[j] * (1.0f / 255.0f); v1[j] *= fb[4 + j] * (1.0f / 255.0f); }
                        v4u w; w.x = pk2(v0[0], v0[1]); w.y = pk2(v0[2], v0[3]); w.z = pk2(v1[0], v1[1]); w.w = pk2(v1[2], v1[3]); *(v4u*)(mp + (size_t)(m * 16) * 1024 + bj * 128) = w;
                    } else {
#pragma unroll
                        for (int j = 0; j < 4; ++j) { v0[j] *= (float)((g4.x >> (8 * j)) & 0xffu) * __builtin_amdgcn_rcpf(fb[j]); v1[j] *= (float)((g4.y >> (8 * j)) & 0xffu) * __builtin_amdgcn_rcpf(fb[4 + j]); }
                        acc[ai][bj][m][0] = v0; acc[ai][bj][m][1] = v1; } } }
    }
};
struct EpiResid {
    static constexpr bool PERM = true, CHAIN = false;
    const float* X; bf16* XG; float* SSQ;
    __device__ __forceinline__ void operator()(f32x4 (&acc)[2][2][4][2], const pg8::Unit& u, int wr, int wc, int fr, int fq) const {
        const int row0 = u.pm * 256 + wr * 64 + fr; const int col0 = u.pn * 256 + wc * 32 + 8 * fq;
#pragma unroll
        for (int ai = 0; ai < 2; ++ai) {
            f32x4 xv[4][2][2];
#pragma unroll
            for (int m = 0; m < 4; ++m) { const size_t off = (size_t)(row0 + ai * 128 + m * 16) * 1024 + col0;
#pragma unroll
                for (int bj = 0; bj < 2; ++bj)
#pragma unroll
                    for (int n = 0; n < 2; ++n) xv[m][bj][n] = *(const f32x4*)(X + off + bj * 128 + n * 4); }
#pragma unroll
            for (int m = 0; m < 4; ++m) { const int row = row0 + ai * 128 + m * 16; const size_t off = (size_t)row * 1024 + col0; float ss = 0.f;
#pragma unroll
                for (int bj = 0; bj < 2; ++bj) { const f32x4 x0 = xv[m][bj][0] + acc[ai][bj][m][0], x1 = xv[m][bj][1] + acc[ai][bj][m][1];
                    ss += ((x0[0] * x0[0] + x0[1] * x0[1]) + (x0[2] * x0[2] + x0[3] * x0[3])) + ((x1[0] * x1[0] + x1[1] * x1[1]) + (x1[2] * x1[2] + x1[3] * x1[3]));
                    v4u w; w.x = pk2(x0[0], x0[1]); w.y = pk2(x0[2], x0[3]); w.z = pk2(x1[0], x1[1]); w.w = pk2(x1[2], x1[3]); *(v4u*)(XG + off + bj * 128) = w; }
                ss += __shfl_xor(ss, 16); ss += __shfl_xor(ss, 32);
                if (fq == 0) atomicAdd(SSQ + row, ss); }
        }
    }
};
struct EpiBf16Rs {
    static constexpr bool PERM = true, CHAIN = false;
    bf16* O; const float* SSQ;
    __device__ __forceinline__ void operator()(f32x4 (&acc)[2][2][4][2], const pg8::Unit& u, int wr, int wc, int fr, int fq) const {
        const int row0 = u.pm * 256 + wr * 64 + fr;
        float ssq[2][4];
#pragma unroll
        for (int ai = 0; ai < 2; ++ai)
#pragma unroll
            for (int m = 0; m < 4; ++m) ssq[ai][m] = SSQ[row0 + ai * 128 + m * 16];
        const int sidx = 2 * wc + (fq >> 1), hh = fq & 1;
#pragma unroll
        for (int ai = 0; ai < 2; ++ai)
#pragma unroll
            for (int m = 0; m < 4; ++m) { const int row = row0 + ai * 128 + m * 16; const int tile = row >> 5, r32 = row & 31;
                const float rs = 1.0f / sqrtf(ssq[ai][m] * (1.f / 1024.f) + EPS);
#pragma unroll
                for (int bj = 0; bj < 2; ++bj) { const f32x4 v0 = acc[ai][bj][m][0] * rs, v1 = acc[ai][bj][m][1] * rs;
                    v4u w; w.x = pk2(v0[0], v0[1]); w.y = pk2(v0[2], v0[3]); w.z = pk2(v1[0], v1[1]); w.w = pk2(v1[2], v1[3]);
                    *(v4u*)(O + ((((size_t)(tile * 8 + u.pn) * 2 + bj) * 8 + sidx) * 64 + r32 + 32 * hh) * 8) = w; } }
    }
};

__device__ __forceinline__ void p0_transpose_item(const float* W, int K, int N, bf16* WT, int dst0, LAS float* scr, int kb, int nb, int lane, const float* kscale = nullptr) {
    const int k0 = 64 * kb, n0 = 32 * nb;
#pragma unroll 8
    for (int i = 0; i < 32; ++i) { const int kk = 2 * i + (lane >> 5); float wv_ = W[(size_t)(k0 + kk) * N + n0 + (lane & 31)]; if (kscale) wv_ *= kscale[k0 + kk]; scr[kk * 33 + (lane & 31)] = wv_; }
    asm volatile("s_waitcnt lgkmcnt(0)" ::: "memory");
    const int c = lane & 7;
#pragma unroll
    for (int j = 0; j < 4; ++j) { const int n = (lane >> 3) + 8 * j; const LAS float* s = scr + (8 * c) * 33 + n;
        v4u o; o.x = pk2(s[0 * 33], s[1 * 33]); o.y = pk2(s[2 * 33], s[3 * 33]); o.z = pk2(s[4 * 33], s[5 * 33]); o.w = pk2(s[6 * 33], s[7 * 33]);
        *(v4u*)(WT + (size_t)(dst0 + n) * K + k0 + 8 * c) = o; }
    asm volatile("s_waitcnt lgkmcnt(0)" ::: "memory");
}
__device__ __forceinline__ int glu_row(int n0) {
    if (n0 < 1024) return 256 * (n0 >> 7) + (n0 & 127);
    if (n0 < 2048) { const int n1 = n0 - 1024; return 256 * (n1 >> 7) + 128 + (n1 & 127); }
    if (n0 < 3584) return n0;
    if (n0 < 4608) { const int n1 = n0 - 3584; return 3584 + 256 * (n1 >> 7) + (n1 & 127); }
    { const int n1 = n0 - 4608; return 3584 + 256 * (n1 >> 7) + 128 + (n1 & 127); }
}
__device__ __forceinline__ void cvt_stream(const float* src, bf16* dst, size_t n, size_t gtid, size_t gthreads) {
    for (size_t i = gtid * 8; i < n; i += gthreads * 8) {
        const f32x4 a = *(const f32x4*)(src + i), b = *(const f32x4*)(src + i + 4);
        v4u o; o.x = pk2(a[0], a[1]); o.y = pk2(a[2], a[3]); o.z = pk2(b[0], b[1]); o.w = pk2(b[2], b[3]);
        *(v4u*)(dst + i) = o; }
}
typedef float v16f __attribute__((ext_vector_type(16)));
typedef float v32f __attribute__((ext_vector_type(32)));
typedef unsigned v6u __attribute__((ext_vector_type(6)));
typedef __bf16 v32bf __attribute__((ext_vector_type(32)));
constexpr int E6ROW = 768;
__device__ __forceinline__ void rows_to_fp6(const float* x2rows, unsigned char* o2rows, float* inv_scale2, int lane, const float* cscale, LAS float* scr) {
    const int c = lane & 31, hf = lane >> 5;
    { f32x4 t[8];
#pragma unroll
      for (int i = 0; i < 8; ++i) t[i] = *(const f32x4*)(x2rows + i * 256 + lane * 4);
#pragma unroll
      for (int i = 0; i < 8; ++i) { const int e = i * 256 + lane * 4; *(LAS f32x4*)((LAS unsigned char*)scr + (e >> 5) * 144 + (e & 31) * 4) = t[i]; }
      asm volatile("s_waitcnt lgkmcnt(0)" ::: "memory"); }
    const LAS f32x4* xr = (const LAS f32x4*)((LAS unsigned char*)scr + lane * 144);
    v16f a, b; float am = 0.f;
#pragma unroll
    for (int j = 0; j < 4; ++j) { f32x4 u = xr[j], w = xr[4 + j];
        if (cscale) { u = u * *(const f32x4*)(cscale + c * 32 + 4 * j); w = w * *(const f32x4*)(cscale + c * 32 + 16 + 4 * j); }
#pragma unroll
        for (int k = 0; k < 4; ++k) { am = fmaxf(am, fmaxf(fabsf(u[k]), fabsf(w[k]))); }
        a[2 * j] = u[0]; b[2 * j] = u[1]; a[2 * j + 1] = u[2]; b[2 * j + 1] = u[3];
        a[8 + 2 * j] = w[0]; b[8 + 2 * j] = w[1]; a[8 + 2 * j + 1] = w[2]; b[8 + 2 * j + 1] = w[3]; }
#pragma unroll
    for (int o = 1; o < 32; o <<= 1) am = fmaxf(am, __shfl_xor(am, o));
    am = fmaxf(am, 1e-30f);
    const float sc = 7.5f / am;
    a = a * sc; b = b * sc;
    const v6u d = __builtin_amdgcn_cvt_scalef32_2xpk16_fp6_f32(a, b, 1.0f);
    unsigned char* ob = o2rows + (size_t)hf * E6ROW + c * 24;
    *(v2u*)(ob) = (v2u){d[0], d[1]}; *(v2u*)(ob + 8) = (v2u){d[2], d[3]}; *(v2u*)(ob + 16) = (v2u){d[4], d[5]};
    if (c == 0) inv_scale2[hf] = am * (1.0f / 7.5f);
    asm volatile("s_waitcnt lgkmcnt(0)" ::: "memory");
}
__device__ __forceinline__ void rms_row_to_bf16(const float* xrow, const float* g, bf16* orow, int lane) {
    const f32x4* xr = (const f32x4*)xrow + lane; const f32x4* gr = (const f32x4*)g + lane;
    f32x4 v[4]; float s = 0.f;
#pragma unroll
    for (int j = 0; j < 4; ++j) { v[j] = xr[64 * j]; s += (v[j][0] * v[j][0] + v[j][1] * v[j][1]) + (v[j][2] * v[j][2] + v[j][3] * v[j][3]); }
    const float rs = 1.0f / sqrtf(wave_sum(s) * (1.f / 1024.f) + EPS);
    v2u* o8 = (v2u*)orow + lane;
#pragma unroll
    for (int j = 0; j < 4; ++j) { const f32x4 gg = gr[64 * j]; v2u o; o.x = pk2(v[j][0] * rs * gg[0], v[j][1] * rs * gg[1]); o.y = pk2(v[j][2] * rs * gg[2], v[j][3] * rs * gg[3]); o8[64 * j] = o; }
}

__device__ __forceinline__ void conv_phase(LAS unsigned char* lds, const bf16* U, bf16* CA, const float* dw_w, const float* dw_b, const float* ln_g, const float* ln_b, int vcu, int G) {
    const int tid = opaque_tid(), lane = tid & 63, wave = tid >> 6;
    const int c0 = 2 * tid;
    constexpr int TT = 32, ROWS = TT + 2 * CPAD, TILE_B = ROWS * 2048;
    f32x2 wv[CK];
#pragma unroll
    for (int j = 0; j < CK; ++j) wv[j] = *(const f32x2*)(dw_w + j * 1024 + c0);
    const f32x2 bi = *(const f32x2*)(dw_b + c0), lg = *(const f32x2*)(ln_g + c0), lb = *(const f32x2*)(ln_b + c0);
    LAS float* red = (LAS float*)(lds + TILE_B);
    LAS float* stat = red + 512;
    const LAS unsigned char* xb = lds + c0 * 2;
    for (int item = vcu; item < BATCH * (SEQ / TT); item += G) {
        const int b = item / (SEQ / TT), t0 = (item % (SEQ / TT)) * TT;
#pragma unroll
        for (int hb = 0; hb < 2; ++hb) {
            v4u val[8];
#pragma unroll
            for (int it = 0; it < 8; ++it) { const int i = tid + (hb * 8 + it) * NTHREADS; const int row = i >> 7, ch = i & 127, tt = t0 - CPAD + row; const bool ok = (i < ROWS * 128) && (tt >= 0) && (tt < SEQ);
                val[it] = *(const v4u*)(U + ((size_t)b * SEQ + (ok ? tt : t0)) * 1024 + ch * 8); if (!ok) val[it] = (v4u){0u, 0u, 0u, 0u}; }
#pragma unroll
            for (int it = 0; it < 8; ++it) { const int i = tid + (hb * 8 + it) * NTHREADS; const int row = i >> 7, ch = i & 127; if (i < ROWS * 128) *(LAS v4u*)(lds + row * 2048 + ch * 16) = val[it]; }
        }
        __syncthreads();
#pragma unroll 1
        for (int rd = 0; rd < 2; ++rd) {
            const LAS unsigned char* xr = xb + rd * 16 * 2048;
            float ac0[16], ac1[16];
#pragma unroll
            for (int t = 0; t < 16; ++t) { ac0[t] = bi[0]; ac1[t] = bi[1]; }
#pragma clang loop unroll(full)
            for (int r = 0; r < 16 + 2 * CPAD; ++r) {
                const unsigned raw = *(const LAS unsigned*)(xr + r * 2048); const float x0 = bflo(raw), x1 = bfhi(raw);
#pragma clang loop unroll(full)
                for (int j = 0; j < CK; ++j) { const int t = r - j; if (t >= 0 && t < 16) { fmac_s(ac0[t], wv[j][0], x0); fmac_s(ac1[t], wv[j][1], x1); } }
            }
            float v[32];
#pragma unroll
            for (int t = 0; t < 16; ++t) { v[2 * t] = ac0[t] + ac1[t]; v[2 * t + 1] = ac0[t] * ac0[t] + ac1[t] * ac1[t]; }
#pragma unroll
            for (int o = 32, n = 16; n >= 1; o >>= 1, n >>= 1) { const bool hi = (lane & o) != 0;
#pragma unroll
                for (int k = 0; k < n; ++k) { const float a = v[k], bb = v[k + n]; const float send = hi ? a : bb, keep = hi ? bb : a; v[k] = keep + __shfl_xor(send, o); } }
            const float rr = v[0] + __shfl_xor(v[0], 1);
            if ((lane & 1) == 0) red[wave * 32 + (lane >> 1)] = rr;
            __syncthreads();
            if (tid < 16) { float s1 = 0.f, s2 = 0.f;
#pragma unroll
                for (int w = 0; w < 8; ++w) { s1 += red[w * 32 + 2 * tid]; s2 += red[w * 32 + 2 * tid + 1]; }
                const float mean = s1 * (1.f / 1024.f); const float var = s2 * (1.f / 1024.f) - mean * mean;
                stat[2 * tid] = mean; stat[2 * tid + 1] = 1.0f / sqrtf(var + EPS); }
            __syncthreads();
            bf16* Cb = CA + ((size_t)b * SEQ + t0 + 16 * rd) * 1024 + c0;
#pragma unroll
            for (int t = 0; t < 16; ++t) { const float mean = stat[2 * t], rstd = stat[2 * t + 1];
                float y0 = (ac0[t] - mean) * rstd * lg[0] + lb[0], y1 = (ac1[t] - mean) * rstd * lg[1] + lb[1];
                y0 = y0 * sigmoidf_(y0); y1 = y1 * sigmoidf_(y1);
                *(unsigned*)(Cb + (size_t)t * 1024) = pk2(y0, y1); }
            __syncthreads();
        }
    }
}

namespace att {
typedef short bf16x8 __attribute__((ext_vector_type(8)));
typedef short s16x4 __attribute__((ext_vector_type(4)));
typedef float f32x16 __attribute__((ext_vector_type(16)));
constexpr int KP = 144, SPAN = 320, VOFF = SPAN * KP, WSTG = 2 * SPAN * KP;
__device__ __forceinline__ s16x4 vtr(const LAS unsigned char* p) { return __builtin_bit_cast(s16x4, __builtin_amdgcn_ds_read_tr16_b64_v4i16((LAS s16x4*)p)); }
__device__ __forceinline__ void attn_phase(LAS unsigned char* lds, const bf16* Q, const bf16* K, const bf16* V, bf16* AO, const float* sink, int vcu, int G) {
    const int tid = opaque_tid(), lane = tid & 63, wave = __builtin_amdgcn_readfirstlane(tid >> 6), r32 = lane & 31, hh = lane >> 5;
    v4u kreg[5], vreg[5];
#define ATT_STAGE_LOAD(UNIT) do { const int qb_ = (UNIT) % (SEQ / 64), kvh_ = ((UNIT) / (SEQ / 64)) % NKV, b_ = (UNIT) / ((SEQ / 64) * NKV); const int t0_ = qb_ * 64, s0_ = t0_ - WIN; \
        _Pragma("unroll") for (int it = 0; it < 5; ++it) { const int i = tid + it * NTHREADS; const int row = i >> 3, ch = i & 7, sp = s0_ + row; const bool ok = (sp >= 0) && (sp < SEQ); \
            const size_t go = ((size_t)b_ * SEQ + (ok ? sp : t0_)) * KVD + kvh_ * 64 + ch * 8; kreg[it] = *(const v4u*)(K + go); vreg[it] = *(const v4u*)(V + go); } } while (0)
    if (vcu < BATCH * NKV * (SEQ / 64)) ATT_STAGE_LOAD(vcu);
    for (int unit = vcu; unit < BATCH * NKV * (SEQ / 64); unit += G) {
        const int qb = unit % (SEQ / 64), kvh = (unit / (SEQ / 64)) % NKV, b = unit / ((SEQ / 64) * NKV);
        const int t0 = qb * 64;
#pragma unroll
        for (int it = 0; it < 5; ++it) { const int i = tid + it * NTHREADS; const int row = i >> 3, ch = i & 7;
            *(LAS v4u*)(lds + row * KP + ch * 16) = kreg[it]; *(LAS v4u*)(lds + VOFF + row * KP + ch * 16) = vreg[it]; }
        if (unit + G < BATCH * NKV * (SEQ / 64)) ATT_STAGE_LOAD(unit + G);
        __syncthreads();
        {
            const int head = kvh * 4 + (wave >> 1), qoff = (wave & 1) * 32, q0 = t0 + qoff;
            const float slope2 = exp2f(-0.5f * (float)(head + 1)) * LOG2E, sink2 = sink[head] * LOG2E;
            LAS unsigned char* stg = lds + WSTG + wave * (32 * KP);
            const size_t qbase = ((size_t)b * SEQ + q0) * 1024 + head * 64;
#pragma unroll
            for (int i = 0; i < 4; ++i) { const int id = i * 64 + lane, row = id >> 3, ch = id & 7; *(LAS v4u*)(stg + row * KP + ch * 16) = *(const v4u*)(Q + qbase + (size_t)row * 1024 + ch * 8); }
            bf16x8 qf[4];
#pragma unroll
            for (int s = 0; s < 4; ++s) qf[s] = *(const LAS bf16x8*)(stg + r32 * KP + (2 * s + hh) * 16);
            float m = sink2, l = (hh == 0) ? 1.0f : 0.0f;
            f32x16 O0, O1, negm;
#pragma unroll
            for (int r = 0; r < 16; ++r) { O0[r] = 0.f; O1[r] = 0.f; negm[r] = -sink2; }
            const int q4 = (lane & 15) >> 2, p4 = lane & 3, g16 = (lane >> 4) & 1;
#pragma unroll 1
            for (int it = 0; it < 9; ++it) {
                const int j = (it & 1) ? 4 - ((it + 1) >> 1) : 4 + (it >> 1);
                const int kt0 = q0 - WIN + 32 * j;
                if (kt0 < 0 || kt0 >= SEQ) continue;
                const int lrow0 = qoff + 32 * j;
                f32x16 sa = negm;
#pragma unroll
                for (int s = 0; s < 4; ++s) { const bf16x8 kf = *(const LAS bf16x8*)(lds + (lrow0 + r32) * KP + 32 * s + 16 * hh); sa = __builtin_amdgcn_mfma_f32_32x32x16_bf16(kf, qf[s], sa, 0, 0, 0); }
                const float cf = (float)(WIN - 32 * j + r32 - 4 * hh);
                if (j == 0 || j == 8) {
#pragma unroll
                    for (int r = 0; r < 16; ++r) { const float d = cf - (float)((r & 3) + 8 * (r >> 2)); float v = fmaf(-slope2, fabsf(d), sa[r]); v = (fabsf(d) > (float)WIN) ? -1e30f : v; sa[r] = v; }
                } else {
#pragma unroll
                    for (int r = 0; r < 16; ++r) { const float d = cf - (float)((r & 3) + 8 * (r >> 2)); sa[r] = fmaf(-slope2, fabsf(d), sa[r]); }
                }
                float tmax = fmaxf(fmaxf(sa[0], sa[1]), sa[2]);
#pragma unroll
                for (int r = 3; r < 15; r += 2) tmax = fmaxf(fmaxf(tmax, sa[r]), sa[r + 1]);
                tmax = fmaxf(tmax, sa[15]);
                if (__any(tmax > 16.0f)) {
                    tmax = fmaxf(tmax, __shfl_xor(tmax, 32));
                    const float dl = fmaxf(tmax, 0.f), alpha = __builtin_amdgcn_exp2f(-dl); m += dl; l *= alpha;
#pragma unroll
                    for (int r = 0; r < 16; ++r) { O0[r] *= alpha; O1[r] *= alpha; sa[r] -= dl; negm[r] = -m; }
                }
                float ls0 = 0.f, ls1 = 0.f;
#pragma unroll
                for (int r = 0; r < 16; r += 2) { sa[r] = __builtin_amdgcn_exp2f(sa[r]); sa[r + 1] = __builtin_amdgcn_exp2f(sa[r + 1]); ls0 += sa[r]; ls1 += sa[r + 1]; }
                l += ls0 + ls1;
                v4u pw0, pw1;
                pw0.x = pk2(sa[0], sa[1]); pw0.y = pk2(sa[2], sa[3]); pw0.z = pk2(sa[4], sa[5]); pw0.w = pk2(sa[6], sa[7]);
                pw1.x = pk2(sa[8], sa[9]); pw1.y = pk2(sa[10], sa[11]); pw1.z = pk2(sa[12], sa[13]); pw1.w = pk2(sa[14], sa[15]);
                const bf16x8 pb0 = __builtin_bit_cast(bf16x8, pw0), pb1 = __builtin_bit_cast(bf16x8, pw1);
                const LAS unsigned char* vb = lds + VOFF + (lrow0 + 4 * hh + q4) * KP + (16 * g16 + 4 * p4) * 2;
#pragma unroll
                for (int s2 = 0; s2 < 2; ++s2) {
                    const s16x4 a0l = vtr(vb + (16 * s2) * KP), a0h = vtr(vb + (16 * s2 + 8) * KP);
                    const s16x4 a1l = vtr(vb + (16 * s2) * KP + 64), a1h = vtr(vb + (16 * s2 + 8) * KP + 64);
                    const bf16x8 A0 = (bf16x8){a0l[0], a0l[1], a0l[2], a0l[3], a0h[0], a0h[1], a0h[2], a0h[3]};
                    const bf16x8 A1 = (bf16x8){a1l[0], a1l[1], a1l[2], a1l[3], a1h[0], a1h[1], a1h[2], a1h[3]};
                    O0 = __builtin_amdgcn_mfma_f32_32x32x16_bf16(A0, s2 ? pb1 : pb0, O0, 0, 0, 0);
                    O1 = __builtin_amdgcn_mfma_f32_32x32x16_bf16(A1, s2 ? pb1 : pb0, O1, 0, 0, 0);
                }
            }
            const float inv = 1.0f / (l + __shfl_xor(l, 32));
#pragma unroll
            for (int g4 = 0; g4 < 4; ++g4) { v2u w0, w1;
                w0.x = pk2(O0[4 * g4] * inv, O0[4 * g4 + 1] * inv); w0.y = pk2(O0[4 * g4 + 2] * inv, O0[4 * g4 + 3] * inv);
                w1.x = pk2(O1[4 * g4] * inv, O1[4 * g4 + 1] * inv); w1.y = pk2(O1[4 * g4 + 2] * inv, O1[4 * g4 + 3] * inv);
                *(LAS v2u*)(stg + r32 * KP + (8 * g4 + 4 * hh) * 2) = w0; *(LAS v2u*)(stg + r32 * KP + (32 + 8 * g4 + 4 * hh) * 2) = w1; }
#pragma unroll
            for (int i = 0; i < 4; ++i) { const int id = i * 64 + lane, row = id >> 3, ch = id & 7; *(v4u*)(AO + qbase + (size_t)row * 1024 + ch * 8) = *(const LAS v4u*)(stg + row * KP + ch * 16); }
        }
        __syncthreads();
    }
}
#undef ATT_STAGE_LOAD
}

namespace tk {
typedef short bf16x8 __attribute__((ext_vector_type(8)));
typedef float f32x16 __attribute__((ext_vector_type(16)));
constexpr int SKP = 272;
#define TK_CAND50(X) X(0,0,0) X(1,0,1) X(2,0,2) X(3,0,3) X(4,0,4) X(5,0,5) X(6,0,6) X(7,0,7) X(8,0,8) X(9,0,9) X(10,0,10) X(11,0,11) X(12,0,12) X(13,0,13) X(14,0,14) X(15,0,15) X(16,1,0) X(17,1,1) X(18,1,2) X(19,1,3) X(20,1,4) X(21,1,5) X(22,1,6) X(23,1,7) X(24,2,0) X(25,2,1) X(26,2,2) X(27,2,3) X(28,2,4) X(29,3,0) X(30,3,1) X(31,3,2) X(32,3,3) X(33,4,0) X(34,4,1) X(35,4,2) X(36,5,0) X(37,5,1) X(38,6,0) X(39,6,1) X(40,7,0) X(41,7,1) X(42,8,0) X(43,9,0) X(44,10,0) X(45,11,0) X(46,12,0) X(47,13,0) X(48,14,0) X(49,15,0)
#define TK_PAIR25(X) X(0,0,0,2,1) X(1,0,1,2,2) X(2,0,2,2,3) X(3,0,3,2,4) X(4,0,4,3,0) X(5,0,5,3,1) X(6,0,6,3,2) X(7,0,7,3,3) X(8,0,8,4,0) X(9,0,9,4,1) X(10,0,10,4,2) X(11,0,11,5,0) X(12,0,12,5,1) X(13,0,13,6,0) X(14,0,14,6,1) X(15,0,15,7,0) X(16,1,0,7,1) X(17,1,1,8,0) X(18,1,2,9,0) X(19,1,3,10,0) X(20,1,4,11,0) X(21,1,5,12,0) X(22,1,6,13,0) X(23,1,7,14,0) X(24,2,0,15,0)
template <int OFF> __device__ __forceinline__ void sort16(float (&v)[64]) {
#pragma unroll
    for (int k = 2; k <= 16; k <<= 1)
#pragma unroll
        for (int j = k >> 1; j > 0; j >>= 1)
#pragma unroll
            for (int i = 0; i < 16; ++i) { const int l = i ^ j; if (l > i) { const float a = v[OFF + i], b = v[OFF + l]; const float hi = fmaxf(a, b), lo = fminf(a, b);
                if ((i & k) == 0) { v[OFF + i] = hi; v[OFF + l] = lo; } else { v[OFF + i] = lo; v[OFF + l] = hi; } } }
}
template <int OFF> __device__ __forceinline__ void merge16(float (&v)[64]) {
#pragma unroll
    for (int j = 8; j > 0; j >>= 1)
#pragma unroll
        for (int i = 0; i < 16; ++i) { const int l = i ^ j; if (l > i) { const float a = v[OFF + i], b = v[OFF + l]; v[OFF + i] = fmaxf(a, b); v[OFF + l] = fminf(a, b); } }
}
template <int A, int B> __device__ __forceinline__ void top16_merge(float (&v)[64]) {
#pragma unroll
    for (int i = 0; i < 16; ++i) v[A + i] = fmaxf(v[A + i], v[B + 15 - i]);
    merge16<A>(v);
}
__device__ __forceinline__ void top16_of_64(float (&v)[64]) {
    sort16<0>(v); sort16<16>(v); sort16<32>(v); sort16<48>(v);
    top16_merge<0, 16>(v); top16_merge<32, 48>(v); top16_merge<0, 32>(v);
}
__device__ __forceinline__ void topk_phase(LAS unsigned char* lds, const bf16* QP, const bf16* SKb, int* IDX, float* GATE, int vcu, int G) {
    const int tid = opaque_tid(), lane = tid & 63, wave = __builtin_amdgcn_readfirstlane(tid >> 6), r32 = lane & 31, hh = lane >> 5;
    for (int i = tid; i < 256 * 16; i += NTHREADS) { const int row = i >> 4, ch = i & 15; *(LAS v4u*)(lds + row * SKP + ch * 16) = *(const v4u*)(SKb + row * 128 + ch * 8); }
    __syncthreads();
    for (int unit = vcu * NWAVES + wave; unit < (M / 32) * PHD; unit += G * NWAVES) {
        const int tile = unit >> 3, h = unit & 7; const int tok = tile * 32 + r32;
        float L[2][16];
#pragma unroll
        for (int p = 0; p < 2; ++p) {
            bf16x8 qf[8];
#pragma unroll
            for (int sidx = 0; sidx < 8; ++sidx) qf[sidx] = *(const bf16x8*)(QP + ((((size_t)(tile * 8 + h) * 2 + p) * 8 + sidx) * 64 + lane) * 8);
            float v[64];
#define TK_KT(kt) { f32x16 acc; \
                _Pragma("unroll") for (int r = 0; r < 16; ++r) acc[r] = 0.f; \
                _Pragma("unroll") for (int sidx = 0; sidx < 8; ++sidx) { const bf16x8 kf = *(const LAS bf16x8*)(lds + (p * 128 + 32 * kt + r32) * SKP + 32 * sidx + 16 * hh); acc = __builtin_amdgcn_mfma_f32_32x32x16_bf16(kf, qf[sidx], acc, 0, 0, 0); } \
                _Pragma("unroll") for (int r = 0; r < 16; ++r) { const unsigned kidx = (unsigned)(32 * kt + (r & 3) + 8 * (r >> 2)); v[16 * kt + r] = __uint_as_float(((__float_as_uint(acc[r]) & 0xffffff80u) | (unsigned)(hh << 2)) | kidx); } \
                sort16<16 * kt>(v); __builtin_amdgcn_sched_barrier(0); }
            TK_KT(0) TK_KT(1) top16_merge<0, 16>(v); __builtin_amdgcn_sched_barrier(0);
            TK_KT(2) TK_KT(3) top16_merge<32, 48>(v); __builtin_amdgcn_sched_barrier(0);
            top16_merge<0, 32>(v); __builtin_amdgcn_sched_barrier(0);
#undef TK_KT
            float t[16];
#pragma unroll
            for (int i = 0; i < 16; ++i) t[i] = __shfl_xor(v[15 - i], 32);
#pragma unroll
            for (int i = 0; i < 16; ++i) v[i] = fmaxf(v[i], t[i]);
            merge16<0>(v);
#pragma unroll
            for (int i = 0; i < 16; ++i) L[p][i] = v[i];
        }
        float sm[25];
#define X(c, i0, j0, i1, j1) { const float s0 = L[0][i0] + L[1][j0], s1 = L[0][i1] + L[1][j1]; sm[c] = hh ? s1 : s0; }
        TK_PAIR25(X)
#undef X
        float v[64];
#pragma unroll
        for (int c = 0; c < 25; ++c) v[c] = sm[c];
#pragma unroll
        for (int c = 25; c < 32; ++c) v[c] = -3.0e38f;
        sort16<0>(v); sort16<16>(v); top16_merge<0, 16>(v);
        float T;
        { float t[16];
#pragma unroll
          for (int i = 0; i < 16; ++i) t[i] = __shfl_xor(v[15 - i], 32);
#pragma unroll
          for (int i = 0; i < 16; ++i) t[i] = fmaxf(v[i], t[i]);
          T = fminf(fminf(t[0], t[1]), t[2]);
#pragma unroll
          for (int i = 3; i < 15; i += 2) T = fminf(fminf(T, t[i]), t[i + 1]);
          T = fminf(T, t[15]); }
        const float smax = L[0][0] + L[1][0];
        unsigned ia[16], ib[16];
#pragma unroll
        for (int i = 0; i < 16; ++i) { ia[i] = (__float_as_uint(L[0][i]) & 127u) << 7; ib[i] = __float_as_uint(L[1][i]) & 127u; }
        float pe[25]; float den = 0.f; int cnt = 0;
#pragma unroll
        for (int c = 0; c < 25; ++c) { const bool sel = sm[c] >= T; const float e = __builtin_amdgcn_exp2f((sm[c] - smax) * LOG2E); pe[c] = e; den += sel ? e : 0.f; cnt += sel ? 1 : 0; }
        den += __shfl_xor(den, 32);
        const int ocnt = __shfl_xor(cnt, 32);
        int pos = hh ? ocnt : 0;
        const float inv = 1.0f / den;
        const size_t ob = (size_t)tok * 128 + h * 16;
#define X(c, i0, j0, i1, j1) { const unsigned e0 = ia[i0] + ib[j0], e1 = ia[i1] + ib[j1]; const unsigned em = hh ? e1 : e0; \
            const bool sel = sm[c] >= T; \
            if (sel && pos < 16) { GATE[ob + pos] = pe[c] * inv; IDX[ob + pos] = (int)em; } \
            pos += sel ? 1 : 0; }
        TK_PAIR25(X)
#undef X
    }
}
}

__device__ __forceinline__ float dot2bf(unsigned a, unsigned b, float c) { return __builtin_amdgcn_fdot2_f32_bf16(__builtin_bit_cast(bf16x2_t, a), __builtin_bit_cast(bf16x2_t, b), c, false); }
__device__ __forceinline__ float gelu_erf(float x) { return 0.5f * x * (1.0f + erff(x * 0.70710678118654752f)); }
__device__ __forceinline__ void gather_phase(const bf16* XG2, const float* SSQ, const unsigned char* EU, const unsigned char* EV, const float* SU, const float* SV, const int* IDX, const float* GATE, float* WGT, const float* fg, float* OUT, int vcu, int G) {
    const int tid = opaque_tid(), lane = tid & 63, wave = tid >> 6, c32 = lane & 31, hf = lane >> 5;
    const int emap = 16 * (lane & 3) + 2 * ((lane >> 2) & 7) + hf;
    const unsigned loff = (unsigned)c32 * 24u;
    struct __attribute__((packed, aligned(4))) U6 { unsigned d[6]; };
    for (int tok = vcu * NWAVES + wave; tok < M; tok += G * NWAVES) {
        unsigned hq[16];
        { const v4u* hp = (const v4u*)(XG2 + (size_t)tok * 1024 + c32 * 32);
#pragma unroll
          for (int j = 0; j < 4; ++j) { const v4u w = hp[j]; hq[4 * j] = w.x; hq[4 * j + 1] = w.y; hq[4 * j + 2] = w.z; hq[4 * j + 3] = w.w; } }
        const float rs2 = 1.0f / sqrtf(SSQ[tok] * (1.f / 1024.f) + EPS);
        int idxl[2];
#pragma unroll
        for (int blk = 0; blk < 2; ++blk) {
            idxl[blk] = IDX[(size_t)tok * 128 + blk * 64 + emap];
            const float gate = GATE[(size_t)tok * 128 + blk * 64 + emap];
            const float isu = SU[idxl[blk]] * rs2, isv = SV[idxl[blk]];
            float dots = 0.f;
#pragma unroll
            for (int grp = 0; grp < 4; ++grp) {
                U6 ur[8];
#pragma unroll
                for (int i = 0; i < 8; ++i) { const int ia = __builtin_amdgcn_readlane(idxl[blk], 4 * i + grp), ib = __builtin_amdgcn_readlane(idxl[blk], 32 + 4 * i + grp);
                    ur[i] = *(const U6*)(EU + (size_t)(hf ? ib : ia) * E6ROW + loff); }
                float pp[8];
#pragma unroll
                for (int i = 0; i < 8; ++i) { const v6u d = {ur[i].d[0], ur[i].d[1], ur[i].d[2], ur[i].d[3], ur[i].d[4], ur[i].d[5]};
                    const v32bf rb = __builtin_amdgcn_cvt_scalef32_pk32_bf16_fp6(d, 1.0f);
                    typedef unsigned v16u __attribute__((ext_vector_type(16)));
                    const v16u rw = __builtin_bit_cast(v16u, rb);
                    float a0 = 0.f, a1 = 0.f;
#pragma unroll
                    for (int j = 0; j < 8; ++j) { a0 = dot2bf(rw[2 * j], hq[2 * j], a0); a1 = dot2bf(rw[2 * j + 1], hq[2 * j + 1], a1); }
                    pp[i] = a0 + a1; }
#pragma unroll
                for (int o = 16, n = 4; n >= 1; o >>= 1, n >>= 1) { const bool hi = (lane & o) != 0;
#pragma unroll
                    for (int k = 0; k < n; ++k) { const float a = pp[k], b = pp[k + n]; const float send = hi ? a : b, keep = hi ? b : a; pp[k] = keep + __shfl_xor(send, o); } }
                float r = pp[0]; r += __shfl_xor(r, 2); r += __shfl_xor(r, 1);
                dots = ((lane & 3) == grp) ? r : dots;
            }
            WGT[(size_t)tok * 128 + blk * 64 + emap] = gate * gelu_erf(dots * isu) * isv;
        }
    }
    for (int tok = vcu * NWAVES + wave; tok < M; tok += G * NWAVES) {
        int idxl[2]; float wl[2];
#pragma unroll
        for (int blk = 0; blk < 2; ++blk) { idxl[blk] = IDX[(size_t)tok * 128 + blk * 64 + emap]; wl[blk] = WGT[(size_t)tok * 128 + blk * 64 + emap]; }
        v32f acc;
#pragma unroll
        for (int k = 0; k < 32; ++k) acc[k] = 0.f;
#pragma unroll
        for (int blk = 0; blk < 2; ++blk) {
#pragma unroll 1
            for (int bt = 0; bt < 4; ++bt) {
                U6 vr[8];
#pragma unroll
                for (int i = 0; i < 8; ++i) { const int pr = bt * 8 + i; const int ia = __builtin_amdgcn_readlane(idxl[blk], pr), ib = __builtin_amdgcn_readlane(idxl[blk], 32 + pr);
                    vr[i] = *(const U6*)(EV + (size_t)(hf ? ib : ia) * E6ROW + loff); }
#pragma unroll
                for (int i = 0; i < 8; ++i) { const int pr = bt * 8 + i;
                    const int wa = __builtin_amdgcn_readlane((int)__float_as_uint(wl[blk]), pr), wb = __builtin_amdgcn_readlane((int)__float_as_uint(wl[blk]), 32 + pr);
                    const float w = __uint_as_float((unsigned)(hf ? wb : wa));
                    const v6u d = {vr[i].d[0], vr[i].d[1], vr[i].d[2], vr[i].d[3], vr[i].d[4], vr[i].d[5]};
                    const v32f rv = __builtin_amdgcn_cvt_scalef32_pk32_f32_fp6(d, 1.0f);
                    acc = acc + rv * w; }
            }
        }
        float o16[16];
#pragma unroll
        for (int k = 0; k < 16; ++k) { const float lo = acc[k], hi = acc[16 + k]; const float mine = hf ? hi : lo, other = hf ? lo : hi; o16[k] = mine + __shfl_xor(other, 32); }
        const size_t co = (size_t)tok * 1024 + c32 * 32 + hf * 16;
        float* orow = OUT + co; float ss = 0.f; f32x4 x2[4];
        { const v4u* xp = (const v4u*)(XG2 + co); const v4u w0 = xp[0], w1 = xp[1];
          x2[0] = (f32x4){bflo(w0.x) + o16[0], bfhi(w0.x) + o16[1], bflo(w0.y) + o16[2], bfhi(w0.y) + o16[3]};
          x2[1] = (f32x4){bflo(w0.z) + o16[4], bfhi(w0.z) + o16[5], bflo(w0.w) + o16[6], bfhi(w0.w) + o16[7]};
          x2[2] = (f32x4){bflo(w1.x) + o16[8], bfhi(w1.x) + o16[9], bflo(w1.y) + o16[10], bfhi(w1.y) + o16[11]};
          x2[3] = (f32x4){bflo(w1.z) + o16[12], bfhi(w1.z) + o16[13], bflo(w1.w) + o16[14], bfhi(w1.w) + o16[15]}; }
#pragma unroll
        for (int j = 0; j < 4; ++j) ss += (x2[j][0] * x2[j][0] + x2[j][1] * x2[j][1]) + (x2[j][2] * x2[j][2] + x2[j][3] * x2[j][3]);
        const float rs = 1.0f / sqrtf(wave_sum(ss) * (1.f / 1024.f) + EPS);
#pragma unroll
        for (int j = 0; j < 4; ++j) { const f32x4 g4 = *(const f32x4*)(fg + c32 * 32 + hf * 16 + 4 * j); *(f32x4*)(orow + 4 * j) = x2[j] * rs * g4; }
    }
}

#define RLX_AGENT __ATOMIC_RELAXED, __HIP_MEMORY_SCOPE_AGENT
#define XB_TMO      128
#define XB_XCNT(j)  (256  + 64 * (j))
#define XB_XSUB(j)  (1280 + 64 * (j))
#define XB_XGEN(j)  (2304 + 64 * (j))
#define XB_TOP      3328
#define XB_TOPGEN   3392
#define XCD_BAR_WORDS 3456
#define XB_SPIN_CAP (1u << 18)

__device__ __forceinline__ unsigned xb_ld(unsigned* p)              { return __hip_atomic_load(p, __ATOMIC_RELAXED, __HIP_MEMORY_SCOPE_AGENT); }
__device__ __forceinline__ unsigned xb_add(unsigned* p, unsigned v) { return __hip_atomic_fetch_add(p, v, __ATOMIC_RELAXED, __HIP_MEMORY_SCOPE_AGENT); }
__device__ __forceinline__ unsigned xb_xcc_id() { return (unsigned)__builtin_amdgcn_s_getreg((3 << 11) | 20) & 0xFu; }
#define XB_SPIN(cond, bar) do { unsigned _sp = 0; while (cond) { __builtin_amdgcn_s_sleep(1); \
    if ((++_sp & 255u) == 0u) { if (xb_ld(&(bar)[XB_TMO])) break; if (_sp > XB_SPIN_CAP) { atomicAdd(&(bar)[XB_TMO], 1u); break; } } } } while (0)

struct XcdBarrier {
    unsigned* bar; unsigned x;
    volatile LAS unsigned* st;
};

__device__ __forceinline__ XcdBarrier xcd_barrier_post(unsigned* bar, volatile LAS unsigned* st) {
    XcdBarrier b; b.bar = bar; b.x = xb_xcc_id(); b.st = st;
    if (threadIdx.x == 0) (void)xb_add(&bar[XB_XCNT(b.x)], 1u);
    return b;
}
__device__ __forceinline__ void xcd_barrier_complete(unsigned* bar, unsigned x, unsigned& nloc, unsigned& nx) {
    const unsigned G = gridDim.x * gridDim.y * gridDim.z;
    unsigned sum, cnt, mine, sp = 0u;
    for (;;) {
        sum = 0u; cnt = 0u; mine = 0u;
#pragma unroll
        for (unsigned j = 0; j < 16; ++j) { const unsigned c = xb_ld(&bar[XB_XCNT(j)]); sum += c; cnt += (c > 0u) ? 1u : 0u; mine = (j == x) ? c : mine; }
        if (sum == G) break;
        __builtin_amdgcn_s_sleep(1);
        if ((++sp & 255u) == 0u) { if (xb_ld(&bar[XB_TMO])) break; if (sp > XB_SPIN_CAP) { atomicAdd(&bar[XB_TMO], 1u); break; } }
    }
    nloc = mine > 0u ? mine : 1u; nx = cnt > 0u ? cnt : 1u;
}

__device__ __forceinline__ void xcd_barrier(const XcdBarrier& b) {
    asm volatile("s_waitcnt vmcnt(0)" ::: "memory");
    __syncthreads();
    if (threadIdx.x == 0) {
        unsigned* bar = b.bar;
        __builtin_amdgcn_s_waitcnt(0);
        unsigned nloc = b.st[0], nx = b.st[1];
        if (nloc == 0u) { xcd_barrier_complete(bar, b.x, nloc, nx); b.st[0] = nloc; b.st[1] = nx; }
        const unsigned old = xb_add(&bar[XB_XSUB(b.x)], 1u);
        const unsigned gen = old / nloc;
        if (old + 1u == (gen + 1u) * nloc) {
            __builtin_amdgcn_fence(__ATOMIC_RELEASE, "agent");
            asm volatile("s_waitcnt vmcnt(0)" ::: "memory");
            const unsigned og = xb_add(&bar[XB_TOP], 1u);
            const unsigned tg = og / nx;
            if (og + 1u == (tg + 1u) * nx) xb_add(&bar[XB_TOPGEN], 1u);
            else XB_SPIN(xb_ld(&bar[XB_TOPGEN]) == tg, bar);
            __builtin_amdgcn_fence(__ATOMIC_ACQUIRE, "agent");
            xb_add(&bar[XB_XGEN(b.x)], 1u);
            asm volatile("s_waitcnt vmcnt(0)" ::: "memory");
        } else {
            XB_SPIN(xb_ld(&bar[XB_XGEN(b.x)]) == gen, bar);
            __builtin_amdgcn_fence(__ATOMIC_ACQUIRE, "agent");
            asm volatile("s_waitcnt vmcnt(0)" ::: "memory");
        }
    }
    __syncthreads();
}


__global__ void __launch_bounds__(NTHREADS, 2) fwd_kernel(Args args) {
    extern __shared__ __attribute__((aligned(16))) unsigned char lds[];
    const int tid = threadIdx.x, lane = tid & 63, wave = __builtin_amdgcn_readfirstlane(tid >> 6);
    const int G = gridDim.x, bx = blockIdx.x;
    const int vcu = (G % 8 == 0) ? (bx % 8) * (G / 8) + bx / 8 : bx;
    unsigned char* ws = args.ws;
    const float* x = args.in[0];
    bf16* WinT = (bf16*)(ws + WS_WIN); bf16* WpwT = (bf16*)(ws + WS_WPW); bf16* WoT = (bf16*)(ws + WS_WO); bf16* WoutT = (bf16*)(ws + WS_WOUT); bf16* WqT = (bf16*)(ws + WS_WQ);
    unsigned char* EU = ws + WS_EU; unsigned char* EV = ws + WS_EV; float* SU = (float*)(ws + WS_ESC); float* SV = SU + NEXP; float* SSQ = SV + NEXP; bf16* SKb = (bf16*)(ws + WS_SK);
    bf16* XN = (bf16*)(ws + WS_XN); bf16* Ub = (bf16*)(ws + WS_U); bf16* MG = (bf16*)(ws + WS_MG); bf16* XG2 = (bf16*)(ws + WS_XG2);
    bf16* Gt = (bf16*)(ws + WS_G); bf16* QP = (bf16*)(ws + WS_QP);
    bf16* Qb = (bf16*)(ws + WS_Q); bf16* Kb = (bf16*)(ws + WS_K); bf16* Vb = (bf16*)(ws + WS_V);
    int* IDX = (int*)(ws + WS_IDX); float* GATE = (float*)(ws + WS_GATE);
    bf16* CA = (bf16*)(ws + WS_CA);
    LAS unsigned char* lds3 = (LAS unsigned char*)lds;
    const int lo = args.ph_lo, hi = args.ph_hi;
    volatile LAS unsigned* MISC = (volatile LAS unsigned*)(lds3 + MISC_OFF);
    if (tid < 32) MISC[tid] = 0u;
    __syncthreads();
    XcdBarrier bar_; bar_.bar = (unsigned*)(ws + WS_CTL) + CW_BAR; bar_.x = 0; bar_.st = nullptr;
    if (hi - lo > 1) bar_ = xcd_barrier_post((unsigned*)(ws + WS_CTL) + CW_BAR, MISC + 8);
#define SEAM(k) do { if (IN(k) && IN((k) + 1)) xcd_barrier(bar_); } while (0)
#ifdef ONLY_PHASE
#define IN(k) ((k) == ONLY_PHASE && lo <= (k) && (k) < hi)
#else
#define IN(k) (lo <= (k) && (k) < hi)
#endif

    if (IN(0)) {
        LAS float* scr = (LAS float*)(lds3 + wave * 16384);
        const int gw = vcu * NWAVES + wave, NGW = G * NWAVES;
        constexpr int I_IN = 16 * (IN_DIM / 32), I_SQ = 16 * 32, I_Q = 16 * 64;
        constexpr int NITEMS = I_IN + 3 * I_SQ + I_Q;
        for (int it = gw; it < NITEMS; it += NGW) {
            int r = it;
            if (r < I_IN) { const int nblk = IN_DIM / 32, kb = r / nblk, nb = r % nblk; p0_transpose_item(args.in[2], D, IN_DIM, WinT, glu_row(32 * nb), scr, kb, nb, lane); continue; } r -= I_IN;
            if (r < I_SQ) { p0_transpose_item(args.in[7], D, D, WpwT, 32 * (r % 32), scr, r / 32, r % 32, lane); continue; } r -= I_SQ;
            if (r < I_SQ) { p0_transpose_item(args.in[9], D, D, WoT, 32 * (r % 32), scr, r / 32, r % 32, lane); continue; } r -= I_SQ;
            if (r < I_SQ) { p0_transpose_item(args.in[10], D, D, WoutT, 32 * (r % 32), scr, r / 32, r % 32, lane); continue; } r -= I_SQ;
            p0_transpose_item(args.in[12], D, 2048, WqT, 32 * (r % 64), scr, r / 64, r % 64, lane, args.in[11]);
        }
        const size_t gt = (size_t)vcu * NTHREADS + tid, ngt = (size_t)G * NTHREADS;
        for (size_t i = gt; i < (size_t)M; i += ngt) SSQ[i] = 0.f;
        cvt_stream(args.in[13], SKb, (size_t)2 * NKEYS * PHALF, gt, ngt);
        for (int r = gw; r < NEXP; r += NGW) { const int tb = r >= NEXP / 2, e = 2 * (r - tb * (NEXP / 2)); rows_to_fp6(args.in[14 + tb] + (size_t)e * D, (tb ? EV : EU) + (size_t)e * E6ROW, (tb ? SV : SU) + e, lane, tb ? nullptr : args.in[11], scr); }
        for (int m = gw; m < M; m += 4 * NGW) {
            f32x4 v[4][4]; float ssr[4];
#pragma unroll
            for (int r = 0; r < 4; ++r) { const f32x4* xr = (const f32x4*)(x + (size_t)(m + r * NGW) * D) + lane;
#pragma unroll
                for (int j = 0; j < 4; ++j) v[r][j] = xr[64 * j]; }
#pragma unroll
            for (int r = 0; r < 4; ++r) { float q = 0.f;
#pragma unroll
                for (int j = 0; j < 4; ++j) q += (v[r][j][0] * v[r][j][0] + v[r][j][1] * v[r][j][1]) + (v[r][j][2] * v[r][j][2] + v[r][j][3] * v[r][j][3]);
                ssr[r] = q; }
#pragma unroll
            for (int o = 1; o < 64; o <<= 1) {
#pragma unroll
                for (int r = 0; r < 4; ++r) ssr[r] += __shfl_xor(ssr[r], o); }
#pragma unroll
            for (int r = 0; r < 4; ++r) { const float rs = 1.0f / sqrtf(ssr[r] * (1.f / 1024.f) + EPS); v2u* o8 = (v2u*)(XN + (size_t)(m + r * NGW) * D) + lane;
#pragma unroll
                for (int j = 0; j < 4; ++j) { const f32x4 gg = ((const f32x4*)args.in[1])[lane + 64 * j]; v2u o; o.x = pk2(v[r][j][0] * rs * gg[0], v[r][j][1] * rs * gg[1]); o.y = pk2(v[r][j][2] * rs * gg[2], v[r][j][3] * rs * gg[3]); o8[64 * j] = o; } }
        }
    }
    SEAM(0);
    if (IN(1)) {
        pg8::Gemm g{XN, WinT, XN, WinT, M, IN_DIM, D}; pg8::StaticOrder S; S.init(M, IN_DIM, G, bx, 1);
        EpiInProj E{Ub, Qb, Kb, Vb, Gt};
        pg8::gemm_phase<EpiInProj>(lds3, g, S, E);
    }
    SEAM(1);
    if (IN(2)) {
        conv_phase(lds3, Ub, CA, args.in[3], args.in[4], args.in[5], args.in[6], vcu, G);
        __syncthreads();
        att::attn_phase(lds3, Qb, Kb, Vb, Qb, args.in[8], vcu, G);
    }
    SEAM(2);
    if (IN(3)) {
        pg8::Gemm g{CA, WpwT, Qb, WoT, M, D, D}; pg8::StaticOrder S; S.init(M, D, G, bx, 2);
        EpiMerge E{Gt, MG};
        pg8::gemm_phase<EpiMerge>(lds3, g, S, E);
    }
    SEAM(3);
    if (IN(4)) {
        pg8::Gemm g{MG, WoutT, MG, WoutT, M, D, D}; pg8::StaticOrder S; S.init(M, D, G, bx, 1);
        EpiResid E{x, XG2, SSQ};
        pg8::gemm_phase<EpiResid>(lds3, g, S, E);
    }
    SEAM(4);
    if (IN(5)) {
        pg8::Gemm g{XG2, WqT, XG2, WqT, M, 2048, D}; pg8::StaticOrder S; S.init(M, 2048, G, bx, 1);
        EpiBf16Rs E{QP, SSQ};
        pg8::gemm_phase<EpiBf16Rs>(lds3, g, S, E);
    }
    SEAM(5);
    if (IN(6)) tk::topk_phase(lds3, QP, SKb, IDX, GATE, vcu, G);
    SEAM(6);
    if (IN(7)) gather_phase(XG2, SSQ, EU, EV, SU, SV, IDX, GATE, GATE, args.in[16], args.out, vcu, G);
#undef IN
#undef SEAM
}

extern "C" void kernel_launch(void* const* d_in, const int* in_sizes, int n_in, void* d_out, int out_size, void* d_ws, size_t ws_size, hipStream_t stream) {
    static int grid = 0;
    if (grid == 0) {
        if (n_in != 17 || in_sizes[0] != M * D || out_size != M * D || ws_size < WS_END) { fprintf(stderr, "kernel_launch: unexpected shapes (n_in %d, in0 %d, out %d, ws %zu)\n", n_in, n_in > 0 ? in_sizes[0] : -1, out_size, ws_size); grid = -1; return; }
        int dev = 0, cus = 0;
        if (hipGetDevice(&dev) != hipSuccess || hipDeviceGetAttribute(&cus, hipDeviceAttributeMultiprocessorCount, dev) != hipSuccess) { grid = -1; return; }
        if (hipFuncSetAttribute((const void*)fwd_kernel, hipFuncAttributeMaxDynamicSharedMemorySize, LDS_BYTES) != hipSuccess) { fprintf(stderr, "kernel_launch: hipFuncSetAttribute failed\n"); grid = -1; return; }
        int per_cu = 0;
        if (hipOccupancyMaxActiveBlocksPerMultiprocessor(&per_cu, (const void*)fwd_kernel, NTHREADS, LDS_BYTES) != hipSuccess || per_cu < 1) { fprintf(stderr, "kernel_launch: occupancy query says %d\n", per_cu); }
        (void)hipGetLastError();
        grid = cus;
    }
    if (grid < 0) return;
    Args a{};
    for (int i = 0; i < 17; ++i) a.in[i] = (const float*)d_in[i];
    a.out = (float*)d_out; a.ws = (unsigned char*)d_ws;
    if (MK_N_LAUNCHES == 1) {
        a.ph_lo = 0; a.ph_hi = 8;
        if (hipMemsetAsync((char*)d_ws + WS_CTL, 0, CTL_ZERO_BYTES, stream) != hipSuccess) { fprintf(stderr, "kernel_launch: memset failed\n"); return; }
        hipLaunchKernelGGL(fwd_kernel, dim3(grid), dim3(NTHREADS), LDS_BYTES, stream, a);
    } else {
        for (int p = 0; p < 8; ++p) {
            a.ph_lo = p; a.ph_hi = p + 1;
            hipLaunchKernelGGL(fwd_kernel, dim3(grid), dim3(NTHREADS), LDS_BYTES, stream, a);
        }
    }
}
```

```cpp
#include <hip/hip_runtime.h>
#include <cstdio>
#include <cstdint>

#ifndef MK_N_LAUNCHES
#define MK_N_LAUNCHES 1
#endif

constexpr int BATCH = 16, SEQ = 2048, D = 1024, M = BATCH * SEQ;
constexpr int CK = 31, CPAD = 15;
constexpr int NH = 16, NKV = 4, HD = 64, KVD = 256, WIN = 128;
constexpr int IN_DIM = 5632;
constexpr int PHD = 8, PKD = 256, PHALF = 128, NKEYS = 128, NEXP = 16384, TOPK = 16;
constexpr float EPS = 1e-6f;
constexpr int NWAVES = 8, NTHREADS = 512;
constexpr float LOG2E = 1.4426950408889634f, QSCALE = 0.125f * 1.4426950408889634f;

typedef unsigned short bf16;
typedef unsigned v4u __attribute__((ext_vector_type(4)));
typedef unsigned v2u __attribute__((ext_vector_type(2)));
typedef float f32x4 __attribute__((ext_vector_type(4)));
typedef float f32x2 __attribute__((ext_vector_type(2)));
typedef __bf16 bf16x2_t __attribute__((ext_vector_type(2)));
#define LAS __attribute__((address_space(3)))

__device__ __forceinline__ int opaque_tid() { int t = threadIdx.x; asm volatile("" : "+v"(t)); return t; }
__device__ __forceinline__ void fmac_s(float& acc, float a, float b) { asm volatile("v_fmac_f32 %0, %1, %2" : "+v"(acc) : "v"(a), "v"(b)); }
__device__ __forceinline__ void mul_s(float& x, float a) { asm volatile("v_mul_f32 %0, %0, %1" : "+v"(x) : "v"(a)); }
__device__ __forceinline__ unsigned pk2(float lo, float hi) { f32x2 v = {lo, hi}; bf16x2_t b = __builtin_convertvector(v, bf16x2_t); return __builtin_bit_cast(unsigned, b); }
__device__ __forceinline__ float bflo(unsigned u) { return __uint_as_float(u << 16); }
__device__ __forceinline__ float bfhi(unsigned u) { return __uint_as_float(u & 0xffff0000u); }
__device__ __forceinline__ float sigmoidf_(float x) { return __builtin_amdgcn_rcpf(1.0f + __builtin_amdgcn_exp2f(x * -1.4426950408889634f)); }
__device__ __forceinline__ float wave_sum(float v) {
#pragma unroll
    for (int o = 1; o < 64; o <<= 1) v += __shfl_xor(v, o);
    return v;
}

namespace pg8 {
typedef unsigned short bf16_t;
typedef short bf16x8 __attribute__((ext_vector_type(8)));
constexpr int BM = 256, BK = 64, HALF = 128, HTB = HALF * BK * 2, STAGE_BYTES = 8 * HTB, NXCD = 8, WGM = 8;

__host__ __device__ __forceinline__ int lds_byte(int r, int c) { const int st = (r >> 4) * 2 + (c >> 5), rr = r & 15, cc = c & 31, ob = rr * 64 + cc * 2; return st * 1024 + (ob ^ (((ob >> 9) & 1) << 5)); }
__host__ __device__ __forceinline__ void stage_rc(int b, int& R, int& C) { const int st = b / 1024, sb = b % 1024, swz = sb ^ (((sb >> 9) & 1) << 5); R = (st >> 1) * 16 + swz / 64; C = (st & 1) * 32 + (swz % 64) / 2; }
__host__ __device__ __forceinline__ int perm32(int rho) { const int n = rho >> 4, i = rho & 15; return 8 * (i >> 2) + 4 * n + (i & 3); }

struct Unit { int pm, pn, g; };
struct Gemm { const bf16_t* A0; const bf16_t* B0; const bf16_t* A1; const bf16_t* B1; int M, N, K; };

struct StaticOrder {
    int nM, nN, nwg, G, c, per;
    __host__ __device__ void init(int M_, int N_, int G_, int c_, int per_) { nM = M_ / BM; nN = N_ / BM; nwg = nM * nN; G = G_; c = c_; per = per_; }
    __host__ __device__ bool next(int i, Unit& u) const {
        const int ti = i / per; u.g = i % per;
        const long L = (long)ti * G + c; if (L >= nwg) return false;
        int wgid = (int)L; { const int q = nwg / NXCD, r = nwg % NXCD, xcd = wgid % NXCD, off = wgid / NXCD; wgid = (xcd < r ? xcd * (q + 1) : r * (q + 1) + (xcd - r) * q) + off; }
        const int nig = WGM * nN, gid = wgid / nig, fm = gid * WGM, gsz = (nM - fm) < WGM ? (nM - fm) : WGM;
        u.pm = fm + ((wgid % nig) % gsz); u.pn = (wgid % nig) / gsz; return true;
    }
};

template <class Epi>
__device__ __forceinline__ void gemm_phase(LAS unsigned char* lds, const Gemm g, const StaticOrder& S, const Epi& E) {
    const int tid = opaque_tid(), wid = __builtin_amdgcn_readfirstlane(tid >> 6), lane = tid & 63, wr = wid >> 2, wc = wid & 3, fr = lane & 15, fq = lane >> 4;
    const int K = g.K, nt = K / BK;
    unsigned voffA[2], voffB[2];
#pragma unroll
    for (int i = 0; i < 2; ++i) { int R, C; stage_rc(tid * 16 + i * 8192, R, C); const int Rb = Epi::PERM ? ((R & ~31) + perm32(R & 31)) : R;
        voffA[i] = (unsigned)(R * K + C) * 2u; voffB[i] = (unsigned)(Rb * K + C) * 2u; }
    const size_t kstep = (size_t)(BK * 2);
    const size_t hstep = (size_t)HALF * K * 2;
    const size_t tstep = 2 * hstep;
    const unsigned ldsw = (unsigned)wid * 1024u;
    const int aoff = lds_byte(wr * 64 + fr, fq * 8), boff = lds_byte(wc * 32 + fr, fq * 8);
#define PG8_SA(b, h) (((b) * 2 + (h)) * HTB)
#define PG8_SB(b, h) ((4 + (b) * 2 + (h)) * HTB)
#define PG8_STAGE(bufoff, gbase, voff) do { _Pragma("unroll") for (int _i = 0; _i < 2; ++_i) \
        __builtin_amdgcn_global_load_lds((const unsigned*)((const char*)(gbase) + (voff)[_i]), (LAS unsigned*)(lds + (bufoff) + ldsw + _i * 8192), 16, 0, 0); } while (0)
#define PG8_LDA(dst, b, h) do { _Pragma("unroll") for (int m = 0; m < 4; ++m) _Pragma("unroll") for (int k = 0; k < 2; ++k) dst[m][k] = *(const LAS bf16x8*)(lds + PG8_SA(b, h) + aoff + m * 2048 + k * 1024); } while (0)
#define PG8_LDB(dst, b, h) do { _Pragma("unroll") for (int n = 0; n < 2; ++n) _Pragma("unroll") for (int k = 0; k < 2; ++k) dst[n][k] = *(const LAS bf16x8*)(lds + PG8_SB(b, h) + boff + n * 2048 + k * 1024); } while (0)
#define PG8_MMA(ai, bj, At, Bt) do { __builtin_amdgcn_s_setprio(1); _Pragma("unroll") for (int m = 0; m < 4; ++m) _Pragma("unroll") for (int n = 0; n < 2; ++n) _Pragma("unroll") for (int k = 0; k < 2; ++k) \
        acc[ai][bj][m][n] = __builtin_amdgcn_mfma_f32_16x16x32_bf16(Bt[n][k], At[m][k], acc[ai][bj][m][n], 0, 0, 0); __builtin_amdgcn_s_setprio(0); } while (0)
#define PG8_WAIT_V(n) asm volatile("s_waitcnt vmcnt(" #n ")" ::: "memory")
#define PG8_WAIT_L(n) asm volatile("s_waitcnt lgkmcnt(" #n ")" ::: "memory")
#define PG8_BAR __builtin_amdgcn_s_barrier()
#define PG8_SCHED __builtin_amdgcn_sched_barrier(0)
    Unit cur, nxt; int ui = 0;
    if (!S.next(0, cur)) return;
    f32x4 acc[2][2][4][2];
#pragma unroll
    for (int a = 0; a < 2; ++a)
#pragma unroll
        for (int b = 0; b < 2; ++b)
#pragma unroll
            for (int m = 0; m < 4; ++m)
#pragma unroll
                for (int n = 0; n < 2; ++n) acc[a][b][m][n] = (f32x4){0.f, 0.f, 0.f, 0.f};
    bf16x8 At[4][2], B0[2][2], B1[2][2];
    const char* cA = (const char*)(cur.g ? g.A1 : g.A0) + (size_t)cur.pm * tstep; const char* cB = (const char*)(cur.g ? g.B1 : g.B0) + (size_t)cur.pn * tstep;
    PG8_STAGE(PG8_SB(0, 0), cB, voffB); PG8_STAGE(PG8_SB(0, 1), cB + hstep, voffB); PG8_STAGE(PG8_SA(0, 0), cA, voffA); PG8_STAGE(PG8_SA(0, 1), cA + hstep, voffA);
    if (wr == 1) PG8_BAR;
    PG8_WAIT_V(2); PG8_BAR;
    PG8_STAGE(PG8_SB(1, 0), cB + kstep, voffB); PG8_STAGE(PG8_SA(1, 0), cA + kstep, voffA); PG8_STAGE(PG8_SB(1, 1), cB + hstep + kstep, voffB);
    PG8_WAIT_V(6); PG8_BAR;
    for (;;) {
        const bool has_next = S.next(ui + 1, nxt);
        const char* nA = has_next ? (const char*)(nxt.g ? g.A1 : g.A0) + (size_t)nxt.pm * tstep : cA; const char* nB = has_next ? (const char*)(nxt.g ? g.B1 : g.B0) + (size_t)nxt.pn * tstep : cB;
        for (int t = 0; t < nt; t += 2) {
            const bool last = (t == nt - 2);
            const char* a1 = cA + (size_t)(t + 1) * kstep;
            const char* a2 = last ? nA : cA + (size_t)(t + 2) * kstep; const char* b2 = last ? nB : cB + (size_t)(t + 2) * kstep;
            const char* a3 = a2 + kstep; const char* b3 = b2 + kstep;
            PG8_LDB(B0, 0, 0); PG8_LDB(B1, 0, 1); PG8_SCHED; PG8_LDA(At, 0, 0); PG8_STAGE(PG8_SA(1, 1), a1 + hstep, voffA);
            PG8_WAIT_V(8); PG8_WAIT_L(0); PG8_BAR; PG8_MMA(0, 0, At, B0); PG8_MMA(0, 1, At, B1); PG8_BAR; PG8_SCHED;
            PG8_LDA(At, 0, 1); PG8_STAGE(PG8_SB(0, 0), b2, voffB); PG8_STAGE(PG8_SB(0, 1), b2 + hstep, voffB); PG8_STAGE(PG8_SA(0, 0), a2, voffA);
            PG8_WAIT_V(8); PG8_WAIT_L(0); PG8_BAR; PG8_MMA(1, 0, At, B0); PG8_MMA(1, 1, At, B1); PG8_BAR; PG8_SCHED;
            PG8_LDB(B0, 1, 0); PG8_LDB(B1, 1, 1); PG8_SCHED; PG8_LDA(At, 1, 0); PG8_STAGE(PG8_SA(0, 1), a2 + hstep, voffA);
            PG8_WAIT_V(8); PG8_WAIT_L(0); PG8_BAR; PG8_MMA(0, 0, At, B0); PG8_MMA(0, 1, At, B1); PG8_BAR; PG8_SCHED;
            PG8_LDA(At, 1, 1); PG8_STAGE(PG8_SB(1, 0), b3, voffB); PG8_STAGE(PG8_SB(1, 1), b3 + hstep, voffB); PG8_STAGE(PG8_SA(1, 0), a3, voffA);
            PG8_WAIT_V(8); PG8_WAIT_L(0); PG8_BAR; PG8_MMA(1, 0, At, B0); PG8_MMA(1, 1, At, B1); PG8_BAR; PG8_SCHED;
        }
        if (wr == 0) PG8_BAR;
        E(acc, cur, wr, wc, fr, fq);
        if (!has_next) break;
        if (!(Epi::CHAIN && cur.g == 0))
#pragma unroll
        for (int a = 0; a < 2; ++a)
#pragma unroll
            for (int b = 0; b < 2; ++b)
#pragma unroll
                for (int m = 0; m < 4; ++m)
#pragma unroll
                    for (int n = 0; n < 2; ++n) acc[a][b][m][n] = (f32x4){0.f, 0.f, 0.f, 0.f};
        cur = nxt; cA = nA; cB = nB; ++ui;
        if (wr == 1) PG8_BAR;
    }
    PG8_WAIT_V(0);
    PG8_BAR;
#undef PG8_SA
#undef PG8_SB
#undef PG8_STAGE
#undef PG8_LDA
#undef PG8_LDB
#undef PG8_MMA
#undef PG8_WAIT_V
#undef PG8_WAIT_L
#undef PG8_BAR
#undef PG8_SCHED
}
}

constexpr size_t MiB = 1u << 20;
constexpr size_t WS_CTL = 0;
constexpr size_t WS_WIN = 2 * MiB, WS_WPW = 13 * MiB, WS_WO = 15 * MiB, WS_WOUT = 17 * MiB, WS_WQ = 19 * MiB, WS_SK = 23 * MiB;
constexpr size_t WS_EU = 24 * MiB, WS_EV = 40 * MiB, WS_ESC = 56 * MiB;
constexpr size_t WS_XN = 88 * MiB, WS_U = 152 * MiB;
constexpr size_t WS_MG = 88 * MiB, WS_XG2 = 152 * MiB;
constexpr size_t WS_G = 216 * MiB;
constexpr size_t WS_QP = 216 * MiB;
constexpr size_t WS_Q = 344 * MiB, WS_K = 408 * MiB, WS_V = 424 * MiB;
constexpr size_t WS_IDX = 344 * MiB, WS_GATE = 360 * MiB;
constexpr size_t WS_CA = 440 * MiB;
constexpr size_t WS_END = 504 * MiB;
constexpr int LDS_BYTES = 147456;
constexpr int MISC_OFF = 131072 + 8192;
constexpr int CW_BAR = 4096;
constexpr size_t CTL_ZERO_BYTES = 65536;

struct Args { const float* in[17]; float* out; unsigned char* ws; int ph_lo, ph_hi; };

struct EpiInProj {
    static constexpr bool PERM = true, CHAIN = false;
    bf16 *U, *Q, *K, *V, *G;
    __device__ __forceinline__ void operator()(f32x4 (&acc)[2][2][4][2], const pg8::Unit& u, int wr, int wc, int fr, int fq) const {
        const int row0 = u.pm * 256 + wr * 64 + fr; const int cw = wc * 32 + 8 * fq;
        if (u.pn < 8) {
#pragma unroll
            for (int ai = 0; ai < 2; ++ai)
#pragma unroll
                for (int m = 0; m < 4; ++m) { const size_t row = (size_t)(row0 + ai * 128 + m * 16);
                    f32x4 a0 = acc[ai][0][m][0], a1 = acc[ai][0][m][1], b0 = acc[ai][1][m][0], b1 = acc[ai][1][m][1];
                    v4u w; w.x = pk2(a0[0] * sigmoidf_(b0[0]), a0[1] * sigmoidf_(b0[1])); w.y = pk2(a0[2] * sigmoidf_(b0[2]), a0[3] * sigmoidf_(b0[3]));
                    w.z = pk2(a1[0] * sigmoidf_(b1[0]), a1[1] * sigmoidf_(b1[1])); w.w = pk2(a1[2] * sigmoidf_(b1[2]), a1[3] * sigmoidf_(b1[3]));
                    *(v4u*)(U + row * 1024 + u.pn * 128 + cw) = w; }
        } else if (u.pn >= 14) {
            const int p = u.pn - 14; unsigned char* G8 = (unsigned char*)G;
#pragma unroll
            for (int ai = 0; ai < 2; ++ai)
#pragma unroll
                for (int m = 0; m < 4; ++m) { unsigned char* rowp = G8 + (size_t)(row0 + ai * 128 + m * 16) * 2048 + (size_t)(p * 128 + cw) * 2;
                    v4u w = {0u, 0u, 0u, 0u};
#pragma unroll
                    for (int j = 0; j < 4; ++j) { w.x = __builtin_amdgcn_cvt_pk_u8_f32(sigmoidf_(acc[ai][0][m][0][j]) * 255.0f, j, w.x); w.y = __builtin_amdgcn_cvt_pk_u8_f32(sigmoidf_(acc[ai][0][m][1][j]) * 255.0f, j, w.y);
                        w.z = __builtin_amdgcn_cvt_pk_u8_f32(sigmoidf_(acc[ai][1][m][0][j]) * 255.0f, j, w.z); w.w = __builtin_amdgcn_cvt_pk_u8_f32(sigmoidf_(acc[ai][1][m][1][j]) * 255.0f, j, w.w); }
                    *(v4u*)rowp = w; }
        } else {
            bf16* base; int ld, col0; float sc = 1.0f;
            if (u.pn < 12) { base = Q; ld = 1024; col0 = (u.pn - 8) * 256; sc = QSCALE; }
            else if (u.pn == 12) { base = K; ld = 256; col0 = 0; }
            else { base = V; ld = 256; col0 = 0; }
#pragma unroll
            for (int ai = 0; ai < 2; ++ai)
#pragma unroll
                for (int m = 0; m < 4; ++m) { bf16* rowp = base + (size_t)(row0 + ai * 128 + m * 16) * ld + col0 + cw;
#pragma unroll
                    for (int bj = 0; bj < 2; ++bj) { f32x4 v0 = acc[ai][bj][m][0] * sc, v1 = acc[ai][bj][m][1] * sc;
                        v4u w; w.x = pk2(v0[0], v0[1]); w.y = pk2(v0[2], v0[3]); w.z = pk2(v1[0], v1[1]); w.w = pk2(v1[2], v1[3]);
                        *(v4u*)(rowp + bj * 128) = w; } }
        }
    }
};
struct EpiMerge {
    static constexpr bool PERM = true, CHAIN = true;
    const bf16* G; bf16* MG;
    __device__ __forceinline__ void operator()(f32x4 (&acc)[2][2][4][2], const pg8::Unit& u, int wr, int wc, int fr, int fq) const {
        const int row0 = u.pm * 256 + wr * 64 + fr; const int col0 = u.pn * 256 + wc * 32 + 8 * fq;
        const unsigned char* G8 = (const unsigned char*)G;
#pragma unroll
        for (int ai = 0; ai < 2; ++ai) { const size_t row = (size_t)(row0 + ai * 128);
            const unsigned char* gp = G8 + row * 2048 + (size_t)col0 * 2; bf16* mp = MG + row * 1024 + col0;
            v4u gw[4][2];
#pragma unroll
            for (int m = 0; m < 4; ++m)
#pragma unroll
                for (int bj = 0; bj < 2; ++bj) gw[m][bj] = *(const v4u*)(gp + (size_t)(m * 16) * 2048 + bj * 256);
#pragma unroll
            for (int m = 0; m < 4; ++m)
#pragma unroll
                for (int bj = 0; bj < 2; ++bj) { const v4u g4 = gw[m][bj]; f32x4 v0 = acc[ai][bj][m][0], v1 = acc[ai][bj][m][1];
                    float fb[8];
#pragma unroll
                    for (int j = 0; j < 4; ++j) { fb[j] = fmaxf((float)((g4.z >> (8 * j)) & 0xffu), 1.0f); fb[4 + j] = fmaxf((float)((g4.w >> (8 * j)) & 0xffu), 1.0f); }
                    if (u.g) {
#pragma unroll
                        for (int j = 0; j < 4; ++j) { v0[j] *= fb[j] * (1.0f / 255.0f); v1[j] *= fb[4 + j] * (1.0f / 255.0f); }
                        v4u w; w.x = pk2(v0[0], v0[1]); w.y = pk2(v0[2], v0[3]); w.z = pk2(v1[0], v1[1]); w.w = pk2(v1[2], v1[3]); *(v4u*)(mp + (size_t)(m * 16) * 1024 + bj * 128) = w;
                    } else {
#pragma unroll
                        for (int j = 0; j < 4; ++j) { v0[j] *= (float)((g4.x >> (8 * j)) & 0xffu) * __builtin_amdgcn_rcpf(fb[j]); v1[j] *= (float)((g4.y >> (8 * j)) & 0xffu) * __builtin_amdgcn_rcpf(fb[4 + j]); }
                        acc[ai][bj][m][0] = v0; acc[ai][bj][m][1] = v1; } } }
    }
};
struct EpiResid {
    static constexpr bool PERM = true, CHAIN = false;
    const float* X; bf16* XG; float* SSQ;
    __device__ __forceinline__ void operator()(f32x4 (&acc)[2][2][4][2], const pg8::Unit& u, int wr, int wc, int fr, int fq) const {
        const int row0 = u.pm * 256 + wr * 64 + fr; const int col0 = u.pn * 256 + wc * 32 + 8 * fq;
#pragma unroll
        for (int ai = 0; ai < 2; ++ai) {
            f32x4 xv[4][2][2];
#pragma unroll
            for (int m = 0; m < 4; ++m) { const size_t off = (size_t)(row0 + ai * 128 + m * 16) * 1024 + col0;
#pragma unroll
                for (int bj = 0; bj < 2; ++bj)
#pragma unroll
                    for (int n = 0; n < 2; ++n) xv[m][bj][n] = *(const f32x4*)(X + off + bj * 128 + n * 4); }
#pragma unroll
            for (int m = 0; m < 4; ++m) { const int row = row0 + ai * 128 + m * 16; const size_t off = (size_t)row * 1024 + col0; float ss = 0.f;
#pragma unroll
                for (int bj = 0; bj < 2; ++bj) { const f32x4 x0 = xv[m][bj][0] + acc[ai][bj][m][0], x1 = xv[m][bj][1] + acc[ai][bj][m][1];
                    ss += ((x0[0] * x0[0] + x0[1] * x0[1]) + (x0[2] * x0[2] + x0[3] * x0[3])) + ((x1[0] * x1[0] + x1[1] * x1[1]) + (x1[2] * x1[2] + x1[3] * x1[3]));
                    v4u w; w.x = pk2(x0[0], x0[1]); w.y = pk2(x0[2], x0[3]); w.z = pk2(x1[0], x1[1]); w.w = pk2(x1[2], x1[3]); *(v4u*)(XG + off + bj * 128) = w; }
                ss += __shfl_xor(ss, 16); ss += __shfl_xor(ss, 32);
                if (fq == 0) atomicAdd(SSQ + row, ss); }
        }
    }
};
struct EpiBf16Rs {
    static constexpr bool PERM = true, CHAIN = false;
    bf16* O; const float* SSQ;
    __device__ __forceinline__ void operator()(f32x4 (&acc)[2][2][4][2], const pg8::Unit& u, int wr, int wc, int fr, int fq) const {
        const int row0 = u.pm * 256 + wr * 64 + fr;
        float ssq[2][4];
#pragma unroll
        for (int ai = 0; ai < 2; ++ai)
#pragma unroll
            for (int m = 0; m < 4; ++m) ssq[ai][m] = SSQ[row0 + ai * 128 + m * 16];
        const int sidx = 2 * wc + (fq >> 1), hh = fq & 1;
#pragma unroll
        for (int ai = 0; ai < 2; ++ai)
#pragma unroll
            for (int m = 0; m < 4; ++m) { const int row = row0 + ai * 128 + m * 16; const int tile = row >> 5, r32 = row & 31;
                const float rs = 1.0f / sqrtf(ssq[ai][m] * (1.f / 1024.f) + EPS);
#pragma unroll
                for (int bj = 0; bj < 2; ++bj) { const f32x4 v0 = acc[ai][bj][m][0] * rs, v1 = acc[ai][bj][m][1] * rs;
                    v4u w; w.x = pk2(v0[0], v0[1]); w.y = pk2(v0[2], v0[3]); w.z = pk2(v1[0], v1[1]); w.w = pk2(v1[2], v1[3]);
                    *(v4u*)(O + ((((size_t)(tile * 8 + u.pn) * 2 + bj) * 8 + sidx) * 64 + r32 + 32 * hh) * 8) = w; } }
    }
};

__device__ __forceinline__ void p0_transpose_item(const float* W, int K, int N, bf16* WT, int dst0, LAS float* scr, int kb, int nb, int lane, const float* kscale = nullptr) {
    const int k0 = 64 * kb, n0 = 32 * nb;
#pragma unroll 8
    for (int i = 0; i < 32; ++i) { const int kk = 2 * i + (lane >> 5); float wv_ = W[(size_t)(k0 + kk) * N + n0 + (lane & 31)]; if (kscale) wv_ *= kscale[k0 + kk]; scr[kk * 33 + (lane & 31)] = wv_; }
    asm volatile("s_waitcnt lgkmcnt(0)" ::: "memory");
    const int c = lane & 7;
#pragma unroll
    for (int j = 0; j < 4; ++j) { const int n = (lane >> 3) + 8 * j; const LAS float* s = scr + (8 * c) * 33 + n;
        v4u o; o.x = pk2(s[0 * 33], s[1 * 33]); o.y = pk2(s[2 * 33], s[3 * 33]); o.z = pk2(s[4 * 33], s[5 * 33]); o.w = pk2(s[6 * 33], s[7 * 33]);
        *(v4u*)(WT + (size_t)(dst0 + n) * K + k0 + 8 * c) = o; }
    asm volatile("s_waitcnt lgkmcnt(0)" ::: "memory");
}
__device__ __forceinline__ int glu_row(int n0) {
    if (n0 < 1024) return 256 * (n0 >> 7) + (n0 & 127);
    if (n0 < 2048) { const int n1 = n0 - 1024; return 256 * (n1 >> 7) + 128 + (n1 & 127); }
    if (n0 < 3584) return n0;
    if (n0 < 4608) { const int n1 = n0 - 3584; return 3584 + 256 * (n1 >> 7) + (n1 & 127); }
    { const int n1 = n0 - 4608; return 3584 + 256 * (n1 >> 7) + 128 + (n1 & 127); }
}
__device__ __forceinline__ void cvt_stream(const float* src, bf16* dst, size_t n, size_t gtid, size_t gthreads) {
    for (size_t i = gtid * 8; i < n; i += gthreads * 8) {
        const f32x4 a = *(const f32x4*)(src + i), b = *(const f32x4*)(src + i + 4);
        v4u o; o.x = pk2(a[0], a[1]); o.y = pk2(a[2], a[3]); o.z = pk2(b[0], b[1]); o.w = pk2(b[2], b[3]);
        *(v4u*)(dst + i) = o; }
}
typedef float v16f __attribute__((ext_vector_type(16)));
typedef float v32f __attribute__((ext_vector_type(32)));
typedef unsigned v6u __attribute__((ext_vector_type(6)));
typedef __bf16 v32bf __attribute__((ext_vector_type(32)));
constexpr int E6ROW = 768;
__device__ __forceinline__ void rows_to_fp6(const float* x2rows, unsigned char* o2rows, float* inv_scale2, int lane, const float* cscale, LAS float* scr) {
    const int c = lane & 31, hf = lane >> 5;
    { f32x4 t[8];
#pragma unroll
      for (int i = 0; i < 8; ++i) t[i] = *(const f32x4*)(x2rows + i * 256 + lane * 4);
#pragma unroll
      for (int i = 0; i < 8; ++i) { const int e = i * 256 + lane * 4; *(LAS f32x4*)((LAS unsigned char*)scr + (e >> 5) * 144 + (e & 31) * 4) = t[i]; }
      asm volatile("s_waitcnt lgkmcnt(0)" ::: "memory"); }
    const LAS f32x4* xr = (const LAS f32x4*)((LAS unsigned char*)scr + lane * 144);
    v16f a, b; float am = 0.f;
#pragma unroll
    for (int j = 0; j < 4; ++j) { f32x4 u = xr[j], w = xr[4 + j];
        if (cscale) { u = u * *(const f32x4*)(cscale + c * 32 + 4 * j); w = w * *(const f32x4*)(cscale + c * 32 + 16 + 4 * j); }
#pragma unroll
        for (int k = 0; k < 4; ++k) { am = fmaxf(am, fmaxf(fabsf(u[k]), fabsf(w[k]))); }
        a[2 * j] = u[0]; b[2 * j] = u[1]; a[2 * j + 1] = u[2]; b[2 * j + 1] = u[3];
        a[8 + 2 * j] = w[0]; b[8 + 2 * j] = w[1]; a[8 + 2 * j + 1] = w[2]; b[8 + 2 * j + 1] = w[3]; }
#pragma unroll
    for (int o = 1; o < 32; o <<= 1) am = fmaxf(am, __shfl_xor(am, o));
    am = fmaxf(am, 1e-30f);
    const float sc = 7.5f / am;
    a = a * sc; b = b * sc;
    const v6u d = __builtin_amdgcn_cvt_scalef32_2xpk16_fp6_f32(a, b, 1.0f);
    unsigned char* ob = o2rows + (size_t)hf * E6ROW + c * 24;
    *(v2u*)(ob) = (v2u){d[0], d[1]}; *(v2u*)(ob + 8) = (v2u){d[2], d[3]}; *(v2u*)(ob + 16) = (v2u){d[4], d[5]};
    if (c == 0) inv_scale2[hf] = am * (1.0f / 7.5f);
    asm volatile("s_waitcnt lgkmcnt(0)" ::: "memory");
}
__device__ __forceinline__ void rms_row_to_bf16(const float* xrow, const float* g, bf16* orow, int lane) {
    const f32x4* xr = (const f32x4*)xrow + lane; const f32x4* gr = (const f32x4*)g + lane;
    f32x4 v[4]; float s = 0.f;
#pragma unroll
    for (int j = 0; j < 4; ++j) { v[j] = xr[64 * j]; s += (v[j][0] * v[j][0] + v[j][1] * v[j][1]) + (v[j][2] * v[j][2] + v[j][3] * v[j][3]); }
    const float rs = 1.0f / sqrtf(wave_sum(s) * (1.f / 1024.f) + EPS);
    v2u* o8 = (v2u*)orow + lane;
#pragma unroll
    for (int j = 0; j < 4; ++j) { const f32x4 gg = gr[64 * j]; v2u o; o.x = pk2(v[j][0] * rs * gg[0], v[j][1] * rs * gg[1]); o.y = pk2(v[j][2] * rs * gg[2], v[j][3] * rs * gg[3]); o8[64 * j] = o; }
}

__device__ __forceinline__ void conv_phase(LAS unsigned char* lds, const bf16* U, bf16* CA, const float* dw_w, const float* dw_b, const float* ln_g, const float* ln_b, int vcu, int G) {
    const int tid = opaque_tid(), lane = tid & 63, wave = tid >> 6;
    const int c0 = 2 * tid;
    constexpr int TT = 32, ROWS = TT + 2 * CPAD, TILE_B = ROWS * 2048;
    f32x2 wv[CK];
#pragma unroll
    for (int j = 0; j < CK; ++j) wv[j] = *(const f32x2*)(dw_w + j * 1024 + c0);
    const f32x2 bi = *(const f32x2*)(dw_b + c0), lg = *(const f32x2*)(ln_g + c0), lb = *(const f32x2*)(ln_b + c0);
    LAS float* red = (LAS float*)(lds + TILE_B);
    LAS float* stat = red + 512;
    const LAS unsigned char* xb = lds + c0 * 2;
    for (int item = vcu; item < BATCH * (SEQ / TT); item += G) {
        const int b = item / (SEQ / TT), t0 = (item % (SEQ / TT)) * TT;
#pragma unroll
        for (int hb = 0; hb < 2; ++hb) {
            v4u val[8];
#pragma unroll
            for (int it = 0; it < 8; ++it) { const int i = tid + (hb * 8 + it) * NTHREADS; const int row = i >> 7, ch = i & 127, tt = t0 - CPAD + row; const bool ok = (i < ROWS * 128) && (tt >= 0) && (tt < SEQ);
                val[it] = *(const v4u*)(U + ((size_t)b * SEQ + (ok ? tt : t0)) * 1024 + ch * 8); if (!ok) val[it] = (v4u){0u, 0u, 0u, 0u}; }
#pragma unroll
            for (int it = 0; it < 8; ++it) { const int i = tid + (hb * 8 + it) * NTHREADS; const int row = i >> 7, ch = i & 127; if (i < ROWS * 128) *(LAS v4u*)(lds + row * 2048 + ch * 16) = val[it]; }
        }
        __syncthreads();
#pragma unroll 1
        for (int rd = 0; rd < 2; ++rd) {
            const LAS unsigned char* xr = xb + rd * 16 * 2048;
            float ac0[16], ac1[16];
#pragma unroll
            for (int t = 0; t < 16; ++t) { ac0[t] = bi[0]; ac1[t] = bi[1]; }
#pragma clang loop unroll(full)
            for (int r = 0; r < 16 + 2 * CPAD; ++r) {
                const unsigned raw = *(const LAS unsigned*)(xr + r * 2048); const float x0 = bflo(raw), x1 = bfhi(raw);
#pragma clang loop unroll(full)
                for (int j = 0; j < CK; ++j) { const int t = r - j; if (t >= 0 && t < 16) { fmac_s(ac0[t], wv[j][0], x0); fmac_s(ac1[t], wv[j][1], x1); } }
            }
            float v[32];
#pragma unroll
            for (int t = 0; t < 16; ++t) { v[2 * t] = ac0[t] + ac1[t]; v[2 * t + 1] = ac0[t] * ac0[t] + ac1[t] * ac1[t]; }
#pragma unroll
            for (int o = 32, n = 16; n >= 1; o >>= 1, n >>= 1) { const bool hi = (lane & o) != 0;
#pragma unroll
                for (int k = 0; k < n; ++k) { const float a = v[k], bb = v[k + n]; const float send = hi ? a : bb, keep = hi ? bb : a; v[k] = keep + __shfl_xor(send, o); } }
            const float rr = v[0] + __shfl_xor(v[0], 1);
            if ((lane & 1) == 0) red[wave * 32 + (lane >> 1)] = rr;
            __syncthreads();
            if (tid < 16) { float s1 = 0.f, s2 = 0.f;
#pragma unroll
                for (int w = 0; w < 8; ++w) { s1 += red[w * 32 + 2 * tid]; s2 += red[w * 32 + 2 * tid + 1]; }
                const float mean = s1 * (1.f / 1024.f); const float var = s2 * (1.f / 1024.f) - mean * mean;
                stat[2 * tid] = mean; stat[2 * tid + 1] = 1.0f / sqrtf(var + EPS); }
            __syncthreads();
            bf16* Cb = CA + ((size_t)b * SEQ + t0 + 16 * rd) * 1024 + c0;
#pragma unroll
            for (int t = 0; t < 16; ++t) { const float mean = stat[2 * t], rstd = stat[2 * t + 1];
                float y0 = (ac0[t] - mean) * rstd * lg[0] + lb[0], y1 = (ac1[t] - mean) * rstd * lg[1] + lb[1];
                y0 = y0 * sigmoidf_(y0); y1 = y1 * sigmoidf_(y1);
                *(unsigned*)(Cb + (size_t)t * 1024) = pk2(y0, y1); }
            __syncthreads();
        }
    }
}

namespace att {
typedef short bf16x8 __attribute__((ext_vector_type(8)));
typedef short s16x4 __attribute__((ext_vector_type(4)));
typedef float f32x16 __attribute__((ext_vector_type(16)));
constexpr int KP = 144, SPAN = 320, VOFF = SPAN * KP, WSTG = 2 * SPAN * KP;
__device__ __forceinline__ s16x4 vtr(const LAS unsigned char* p) { return __builtin_bit_cast(s16x4, __builtin_amdgcn_ds_read_tr16_b64_v4i16((LAS s16x4*)p)); }
__device__ __forceinline__ void attn_phase(LAS unsigned char* lds, const bf16* Q, const bf16* K, const bf16* V, bf16* AO, const float* sink, int vcu, int G) {
    const int tid = opaque_tid(), lane = tid & 63, wave = __builtin_amdgcn_readfirstlane(tid >> 6), r32 = lane & 31, hh = lane >> 5;
    v4u kreg[5], vreg[5];
#define ATT_STAGE_LOAD(UNIT) do { const int qb_ = (UNIT) % (SEQ / 64), kvh_ = ((UNIT) / (SEQ / 64)) % NKV, b_ = (UNIT) / ((SEQ / 64) * NKV); const int t0_ = qb_ * 64, s0_ = t0_ - WIN; \
        _Pragma("unroll") for (int it = 0; it < 5; ++it) { const int i = tid + it * NTHREADS; const int row = i >> 3, ch = i & 7, sp = s0_ + row; const bool ok = (sp >= 0) && (sp < SEQ); \
            const size_t go = ((size_t)b_ * SEQ + (ok ? sp : t0_)) * KVD + kvh_ * 64 + ch * 8; kreg[it] = *(const v4u*)(K + go); vreg[it] = *(const v4u*)(V + go); } } while (0)
    if (vcu < BATCH * NKV * (SEQ / 64)) ATT_STAGE_LOAD(vcu);
    for (int unit = vcu; unit < BATCH * NKV * (SEQ / 64); unit += G) {
        const int qb = unit % (SEQ / 64), kvh = (unit / (SEQ / 64)) % NKV, b = unit / ((SEQ / 64) * NKV);
        const int t0 = qb * 64;
#pragma unroll
        for (int it = 0; it < 5; ++it) { const int i = tid + it * NTHREADS; const int row = i >> 3, ch = i & 7;
            *(LAS v4u*)(lds + row * KP + ch * 16) = kreg[it]; *(LAS v4u*)(lds + VOFF + row * KP + ch * 16) = vreg[it]; }
        if (unit + G < BATCH * NKV * (SEQ / 64)) ATT_STAGE_LOAD(unit + G);
        __syncthreads();
        {
            const int head = kvh * 4 + (wave >> 1), qoff = (wave & 1) * 32, q0 = t0 + qoff;
            const float slope2 = exp2f(-0.5f * (float)(head + 1)) * LOG2E, sink2 = sink[head] * LOG2E;
            LAS unsigned char* stg = lds + WSTG + wave * (32 * KP);
            const size_t qbase = ((size_t)b * SEQ + q0) * 1024 + head * 64;
#pragma unroll
            for (int i = 0; i < 4; ++i) { const int id = i * 64 + lane, row = id >> 3, ch = id & 7; *(LAS v4u*)(stg + row * KP + ch * 16) = *(const v4u*)(Q + qbase + (size_t)row * 1024 + ch * 8); }
            bf16x8 qf[4];
#pragma unroll
            for (int s = 0; s < 4; ++s) qf[s] = *(const LAS bf16x8*)(stg + r32 * KP + (2 * s + hh) * 16);
            float m = sink2, l = (hh == 0) ? 1.0f : 0.0f;
            f32x16 O0, O1, negm;
#pragma unroll
            for (int r = 0; r < 16; ++r) { O0[r] = 0.f; O1[r] = 0.f; negm[r] = -sink2; }
            const int q4 = (lane & 15) >> 2, p4 = lane & 3, g16 = (lane >> 4) & 1;
#pragma unroll 1
            for (int it = 0; it < 9; ++it) {
                const int j = (it & 1) ? 4 - ((it + 1) >> 1) : 4 + (it >> 1);
                const int kt0 = q0 - WIN + 32 * j;
                if (kt0 < 0 || kt0 >= SEQ) continue;
                const int lrow0 = qoff + 32 * j;
                f32x16 sa = negm;
#pragma unroll
                for (int s = 0; s < 4; ++s) { const bf16x8 kf = *(const LAS bf16x8*)(lds + (lrow0 + r32) * KP + 32 * s + 16 * hh); sa = __builtin_amdgcn_mfma_f32_32x32x16_bf16(kf, qf[s], sa, 0, 0, 0); }
                const float cf = (float)(WIN - 32 * j + r32 - 4 * hh);
                if (j == 0 || j == 8) {
#pragma unroll
                    for (int r = 0; r < 16; ++r) { const float d = cf - (float)((r & 3) + 8 * (r >> 2)); float v = fmaf(-slope2, fabsf(d), sa[r]); v = (fabsf(d) > (float)WIN) ? -1e30f : v; sa[r] = v; }
                } else {
#pragma unroll
                    for (int r = 0; r < 16; ++r) { const float d = cf - (float)((r & 3) + 8 * (r >> 2)); sa[r] = fmaf(-slope2, fabsf(d), sa[r]); }
                }
                float tmax = fmaxf(fmaxf(sa[0], sa[1]), sa[2]);
#pragma unroll
                for (int r = 3; r < 15; r += 2) tmax = fmaxf(fmaxf(tmax, sa[r]), sa[r + 1]);
                tmax = fmaxf(tmax, sa[15]);
                if (__any(tmax > 16.0f)) {
                    tmax = fmaxf(tmax, __shfl_xor(tmax, 32));
                    const float dl = fmaxf(tmax, 0.f), alpha = __builtin_amdgcn_exp2f(-dl); m += dl; l *= alpha;
#pragma unroll
                    for (int r = 0; r < 16; ++r) { O0[r] *= alpha; O1[r] *= alpha; sa[r] -= dl; negm[r] = -m; }
                }
                float ls0 = 0.f, ls1 = 0.f;
#pragma unroll
                for (int r = 0; r < 16; r += 2) { sa[r] = __builtin_amdgcn_exp2f(sa[r]); sa[r + 1] = __builtin_amdgcn_exp2f(sa[r + 1]); ls0 += sa[r]; ls1 += sa[r + 1]; }
                l += ls0 + ls1;
                v4u pw0, pw1;
                pw0.x = pk2(sa[0], sa[1]); pw0.y = pk2(sa[2], sa[3]); pw0.z = pk2(sa[4], sa[5]); pw0.w = pk2(sa[6], sa[7]);
                pw1.x = pk2(sa[8], sa[9]); pw1.y = pk2(sa[10], sa[11]); pw1.z = pk2(sa[12], sa[13]); pw1.w = pk2(sa[14], sa[15]);
                const bf16x8 pb0 = __builtin_bit_cast(bf16x8, pw0), pb1 = __builtin_bit_cast(bf16x8, pw1);
                const LAS unsigned char* vb = lds + VOFF + (lrow0 + 4 * hh + q4) * KP + (16 * g16 + 4 * p4) * 2;
#pragma unroll
                for (int s2 = 0; s2 < 2; ++s2) {
                    const s16x4 a0l = vtr(vb + (16 * s2) * KP), a0h = vtr(vb + (16 * s2 + 8) * KP);
                    const s16x4 a1l = vtr(vb + (16 * s2) * KP + 64), a1h = vtr(vb + (16 * s2 + 8) * KP + 64);
                    const bf16x8 A0 = (bf16x8){a0l[0], a0l[1], a0l[2], a0l[3], a0h[0], a0h[1], a0h[2], a0h[3]};
                    const bf16x8 A1 = (bf16x8){a1l[0], a1l[1], a1l[2], a1l[3], a1h[0], a1h[1], a1h[2], a1h[3]};
                    O0 = __builtin_amdgcn_mfma_f32_32x32x16_bf16(A0, s2 ? pb1 : pb0, O0, 0, 0, 0);
                    O1 = __builtin_amdgcn_mfma_f32_32x32x16_bf16(A1, s2 ? pb1 : pb0, O1, 0, 0, 0);
                }
            }
            const float inv = 1.0f / (l + __shfl_xor(l, 32));
#pragma unroll
            for (int g4 = 0; g4 < 4; ++g4) { v2u w0, w1;
                w0.x = pk2(O0[4 * g4] * inv, O0[4 * g4 + 1] * inv); w0.y = pk2(O0[4 * g4 + 2] * inv, O0[4 * g4 + 3] * inv);
                w1.x = pk2(O1[4 * g4] * inv, O1[4 * g4 + 1] * inv); w1.y = pk2(O1[4 * g4 + 2] * inv, O1[4 * g4 + 3] * inv);
                *(LAS v2u*)(stg + r32 * KP + (8 * g4 + 4 * hh) * 2) = w0; *(LAS v2u*)(stg + r32 * KP + (32 + 8 * g4 + 4 * hh) * 2) = w1; }
#pragma unroll
            for (int i = 0; i < 4; ++i) { const int id = i * 64 + lane, row = id >> 3, ch = id & 7; *(v4u*)(AO + qbase + (size_t)row * 1024 + ch * 8) = *(const LAS v4u*)(stg + row * KP + ch * 16); }
        }
        __syncthreads();
    }
}
#undef ATT_STAGE_LOAD
}

namespace tk {
typedef short bf16x8 __attribute__((ext_vector_type(8)));
typedef float f32x16 __attribute__((ext_vector_type(16)));
constexpr int SKP = 272;
#define TK_CAND50(X) X(0,0,0) X(1,0,1) X(2,0,2) X(3,0,3) X(4,0,4) X(5,0,5) X(6,0,6) X(7,0,7) X(8,0,8) X(9,0,9) X(10,0,10) X(11,0,11) X(12,0,12) X(13,0,13) X(14,0,14) X(15,0,15) X(16,1,0) X(17,1,1) X(18,1,2) X(19,1,3) X(20,1,4) X(21,1,5) X(22,1,6) X(23,1,7) X(24,2,0) X(25,2,1) X(26,2,2) X(27,2,3) X(28,2,4) X(29,3,0) X(30,3,1) X(31,3,2) X(32,3,3) X(33,4,0) X(34,4,1) X(35,4,2) X(36,5,0) X(37,5,1) X(38,6,0) X(39,6,1) X(40,7,0) X(41,7,1) X(42,8,0) X(43,9,0) X(44,10,0) X(45,11,0) X(46,12,0) X(47,13,0) X(48,14,0) X(49,15,0)
#define TK_PAIR25(X) X(0,0,0,2,1) X(1,0,1,2,2) X(2,0,2,2,3) X(3,0,3,2,4) X(4,0,4,3,0) X(5,0,5,3,1) X(6,0,6,3,2) X(7,0,7,3,3) X(8,0,8,4,0) X(9,0,9,4,1) X(10,0,10,4,2) X(11,0,11,5,0) X(12,0,12,5,1) X(13,0,13,6,0) X(14,0,14,6,1) X(15,0,15,7,0) X(16,1,0,7,1) X(17,1,1,8,0) X(18,1,2,9,0) X(19,1,3,10,0) X(20,1,4,11,0) X(21,1,5,12,0) X(22,1,6,13,0) X(23,1,7,14,0) X(24,2,0,15,0)
template <int OFF> __device__ __forceinline__ void sort16(float (&v)[64]) {
#pragma unroll
    for (int k = 2; k <= 16; k <<= 1)
#pragma unroll
        for (int j = k >> 1; j > 0; j >>= 1)
#pragma unroll
            for (int i = 0; i < 16; ++i) { const int l = i ^ j; if (l > i) { const float a = v[OFF + i], b = v[OFF + l]; const float hi = fmaxf(a, b), lo = fminf(a, b);
                if ((i & k) == 0) { v[OFF + i] = hi; v[OFF + l] = lo; } else { v[OFF + i] = lo; v[OFF + l] = hi; } } }
}
template <int OFF> __device__ __forceinline__ void merge16(float (&v)[64]) {
#pragma unroll
    for (int j = 8; j > 0; j >>= 1)
#pragma unroll
        for (int i = 0; i < 16; ++i) { const int l = i ^ j; if (l > i) { const float a = v[OFF + i], b = v[OFF + l]; v[OFF + i] = fmaxf(a, b); v[OFF + l] = fminf(a, b); } }
}
template <int A, int B> __device__ __forceinline__ void top16_merge(float (&v)[64]) {
#pragma unroll
    for (int i = 0; i < 16; ++i) v[A + i] = fmaxf(v[A + i], v[B + 15 - i]);
    merge16<A>(v);
}
__device__ __forceinline__ void top16_of_64(float (&v)[64]) {
    sort16<0>(v); sort16<16>(v); sort16<32>(v); sort16<48>(v);
    top16_merge<0, 16>(v); top16_merge<32, 48>(v); top16_merge<0, 32>(v);
}
__device__ __forceinline__ void topk_phase(LAS unsigned char* lds, const bf16* QP, const bf16* SKb, int* IDX, float* GATE, int vcu, int G) {
    const int tid = opaque_tid(), lane = tid & 63, wave = __builtin_amdgcn_readfirstlane(tid >> 6), r32 = lane & 31, hh = lane >> 5;
    for (int i = tid; i < 256 * 16; i += NTHREADS) { const int row = i >> 4, ch = i & 15; *(LAS v4u*)(lds + row * SKP + ch * 16) = *(const v4u*)(SKb + row * 128 + ch * 8); }
    __syncthreads();
    for (int unit = vcu * NWAVES + wave; unit < (M / 32) * PHD; unit += G * NWAVES) {
        const int tile = unit >> 3, h = unit & 7; const int tok = tile * 32 + r32;
        float L[2][16];
#pragma unroll
        for (int p = 0; p < 2; ++p) {
            bf16x8 qf[8];
#pragma unroll
            for (int sidx = 0; sidx < 8; ++sidx) qf[sidx] = *(const bf16x8*)(QP + ((((size_t)(tile * 8 + h) * 2 + p) * 8 + sidx) * 64 + lane) * 8);
            float v[64];
#define TK_KT(kt) { f32x16 acc; \
                _Pragma("unroll") for (int r = 0; r < 16; ++r) acc[r] = 0.f; \
                _Pragma("unroll") for (int sidx = 0; sidx < 8; ++sidx) { const bf16x8 kf = *(const LAS bf16x8*)(lds + (p * 128 + 32 * kt + r32) * SKP + 32 * sidx + 16 * hh); acc = __builtin_amdgcn_mfma_f32_32x32x16_bf16(kf, qf[sidx], acc, 0, 0, 0); } \
                _Pragma("unroll") for (int r = 0; r < 16; ++r) { const unsigned kidx = (unsigned)(32 * kt + (r & 3) + 8 * (r >> 2)); v[16 * kt + r] = __uint_as_float(((__float_as_uint(acc[r]) & 0xffffff80u) | (unsigned)(hh << 2)) | kidx); } \
                sort16<16 * kt>(v); __builtin_amdgcn_sched_barrier(0); }
            TK_KT(0) TK_KT(1) top16_merge<0, 16>(v); __builtin_amdgcn_sched_barrier(0);
            TK_KT(2) TK_KT(3) top16_merge<32, 48>(v); __builtin_amdgcn_sched_barrier(0);
            top16_merge<0, 32>(v); __builtin_amdgcn_sched_barrier(0);
#undef TK_KT
            float t[16];
#pragma unroll
            for (int i = 0; i < 16; ++i) t[i] = __shfl_xor(v[15 - i], 32);
#pragma unroll
            for (int i = 0; i < 16; ++i) v[i] = fmaxf(v[i], t[i]);
            merge16<0>(v);
#pragma unroll
            for (int i = 0; i < 16; ++i) L[p][i] = v[i];
        }
        float sm[25];
#define X(c, i0, j0, i1, j1) { const float s0 = L[0][i0] + L[1][j0], s1 = L[0][i1] + L[1][j1]; sm[c] = hh ? s1 : s0; }
        TK_PAIR25(X)
#undef X
        float v[64];
#pragma unroll
        for (int c = 0; c < 25; ++c) v[c] = sm[c];
#pragma unroll
        for (int c = 25; c < 32; ++c) v[c] = -3.0e38f;
        sort16<0>(v); sort16<16>(v); top16_merge<0, 16>(v);
        float T;
        { float t[16];
#pragma unroll
          for (int i = 0; i < 16; ++i) t[i] = __shfl_xor(v[15 - i], 32);
#pragma unroll
          for (int i = 0; i < 16; ++i) t[i] = fmaxf(v[i], t[i]);
          T = fminf(fminf(t[0], t[1]), t[2]);
#pragma unroll
          for (int i = 3; i < 15; i += 2) T = fminf(fminf(T, t[i]), t[i + 1]);
          T = fminf(T, t[15]); }
        const float smax = L[0][0] + L[1][0];
        unsigned ia[16], ib[16];
#pragma unroll
        for (int i = 0; i < 16; ++i) { ia[i] = (__float_as_uint(L[0][i]) & 127u) << 7; ib[i] = __float_as_uint(L[1][i]) & 127u; }
        float pe[25]; float den = 0.f; int cnt = 0;
#pragma unroll
        for (int c = 0; c < 25; ++c) { const bool sel = sm[c] >= T; const float e = __builtin_amdgcn_exp2f((sm[c] - smax) * LOG2E); pe[c] = e; den += sel ? e : 0.f; cnt += sel ? 1 : 0; }
        den += __shfl_xor(den, 32);
        const int ocnt = __shfl_xor(cnt, 32);
        int pos = hh ? ocnt : 0;
        const float inv = 1.0f / den;
        LAS float* lg = (LAS float*)(lds + 256 * SKP + wave * 4096); LAS int* li = (LAS int*)(lg + 512);
#define X(c, i0, j0, i1, j1) { const unsigned e0 = ia[i0] + ib[j0], e1 = ia[i1] + ib[j1]; const unsigned em = hh ? e1 : e0; \
            const bool sel = sm[c] >= T; \
            if (sel && pos < 16) { lg[r32 * 16 + pos] = pe[c] * inv; li[r32 * 16 + pos] = (int)em; } \
            pos += sel ? 1 : 0; }
        TK_PAIR25(X)
#undef X
        asm volatile("s_waitcnt lgkmcnt(0)" ::: "memory");
#pragma unroll
        for (int rr = 0; rr < 2; ++rr) { const int tl = rr * 16 + (lane >> 2), pg = lane & 3; const size_t ob = (size_t)(tile * 32 + tl) * 128 + h * 16 + 4 * pg;
            *(f32x4*)(GATE + ob) = *(const LAS f32x4*)(lg + tl * 16 + 4 * pg); *(v4u*)(IDX + ob) = *(const LAS v4u*)(li + tl * 16 + 4 * pg); }
        asm volatile("s_waitcnt lgkmcnt(0)" ::: "memory");
    }
}
}

__device__ __forceinline__ float dot2bf(unsigned a, unsigned b, float c) { return __builtin_amdgcn_fdot2_f32_bf16(__builtin_bit_cast(bf16x2_t, a), __builtin_bit_cast(bf16x2_t, b), c, false); }
__device__ __forceinline__ float gelu_erf(float x) { return 0.5f * x * (1.0f + erff(x * 0.70710678118654752f)); }
__device__ __forceinline__ void gather_phase(const bf16* XG2, const float* SSQ, const unsigned char* EU, const unsigned char* EV, const float* SU, const float* SV, const int* IDX, const float* GATE, float* WGT, const float* fg, float* OUT, int vcu, int G) {
    const int tid = opaque_tid(), lane = tid & 63, wave = tid >> 6, c32 = lane & 31, hf = lane >> 5;
    const int emap = 16 * (lane & 3) + 2 * ((lane >> 2) & 7) + hf;
    const unsigned loff = (unsigned)c32 * 24u;
    struct __attribute__((packed, aligned(4))) U6 { unsigned d[6]; };
    for (int tok = vcu * NWAVES + wave; tok < M; tok += G * NWAVES) {
        unsigned hq[16];
        { const v4u* hp = (const v4u*)(XG2 + (size_t)tok * 1024 + c32 * 32);
#pragma unroll
          for (int j = 0; j < 4; ++j) { const v4u w = hp[j]; hq[4 * j] = w.x; hq[4 * j + 1] = w.y; hq[4 * j + 2] = w.z; hq[4 * j + 3] = w.w; } }
        const float rs2 = 1.0f / sqrtf(SSQ[tok] * (1.f / 1024.f) + EPS);
        int idxl[2];
#pragma unroll
        for (int blk = 0; blk < 2; ++blk) {
            idxl[blk] = IDX[(size_t)tok * 128 + blk * 64 + emap];
            const float gate = GATE[(size_t)tok * 128 + blk * 64 + emap];
            const float isu = SU[idxl[blk]] * rs2, isv = SV[idxl[blk]];
            float dots = 0.f;
#pragma unroll
            for (int grp = 0; grp < 4; ++grp) {
                U6 ur[8];
#pragma unroll
                for (int i = 0; i < 8; ++i) { const int ia = __builtin_amdgcn_readlane(idxl[blk], 4 * i + grp), ib = __builtin_amdgcn_readlane(idxl[blk], 32 + 4 * i + grp);
                    ur[i] = *(const U6*)(EU + (size_t)(hf ? ib : ia) * E6ROW + loff); }
                float pp[8];
#pragma unroll
                for (int i = 0; i < 8; ++i) { const v6u d = {ur[i].d[0], ur[i].d[1], ur[i].d[2], ur[i].d[3], ur[i].d[4], ur[i].d[5]};
                    const v32bf rb = __builtin_amdgcn_cvt_scalef32_pk32_bf16_fp6(d, 1.0f);
                    typedef unsigned v16u __attribute__((ext_vector_type(16)));
                    const v16u rw = __builtin_bit_cast(v16u, rb);
                    float a0 = 0.f, a1 = 0.f;
#pragma unroll
                    for (int j = 0; j < 8; ++j) { a0 = dot2bf(rw[2 * j], hq[2 * j], a0); a1 = dot2bf(rw[2 * j + 1], hq[2 * j + 1], a1); }
                    pp[i] = a0 + a1; }
#pragma unroll
                for (int o = 16, n = 4; n >= 1; o >>= 1, n >>= 1) { const bool hi = (lane & o) != 0;
#pragma unroll
                    for (int k = 0; k < n; ++k) { const float a = pp[k], b = pp[k + n]; const float send = hi ? a : b, keep = hi ? b : a; pp[k] = keep + __shfl_xor(send, o); } }
                float r = pp[0]; r += __shfl_xor(r, 2); r += __shfl_xor(r, 1);
                dots = ((lane & 3) == grp) ? r : dots;
            }
            WGT[(size_t)tok * 128 + blk * 64 + emap] = gate * gelu_erf(dots * isu) * isv;
        }
    }
    for (int tok = vcu * NWAVES + wave; tok < M; tok += G * NWAVES) {
        int idxl[2]; float wl[2];
#pragma unroll
        for (int blk = 0; blk < 2; ++blk) { idxl[blk] = IDX[(size_t)tok * 128 + blk * 64 + emap]; wl[blk] = WGT[(size_t)tok * 128 + blk * 64 + emap]; }
        v32f acc;
#pragma unroll
        for (int k = 0; k < 32; ++k) acc[k] = 0.f;
#pragma unroll
        for (int blk = 0; blk < 2; ++blk) {
#pragma unroll 1
            for (int bt = 0; bt < 4; ++bt) {
                U6 vr[8];
#pragma unroll
                for (int i = 0; i < 8; ++i) { const int pr = bt * 8 + i; const int ia = __builtin_amdgcn_readlane(idxl[blk], pr), ib = __builtin_amdgcn_readlane(idxl[blk], 32 + pr);
                    vr[i] = *(const U6*)(EV + (size_t)(hf ? ib : ia) * E6ROW + loff); }
#pragma unroll
                for (int i = 0; i < 8; ++i) { const int pr = bt * 8 + i;
                    const int wa = __builtin_amdgcn_readlane((int)__float_as_uint(wl[blk]), pr), wb = __builtin_amdgcn_readlane((int)__float_as_uint(wl[blk]), 32 + pr);
                    const float w = __uint_as_float((unsigned)(hf ? wb : wa));
                    const v6u d = {vr[i].d[0], vr[i].d[1], vr[i].d[2], vr[i].d[3], vr[i].d[4], vr[i].d[5]};
                    const v32f rv = __builtin_amdgcn_cvt_scalef32_pk32_f32_fp6(d, 1.0f);
                    acc = acc + rv * w; }
            }
        }
        float o16[16];
#pragma unroll
        for (int k = 0; k < 16; ++k) { const float lo = acc[k], hi = acc[16 + k]; const float mine = hf ? hi : lo, other = hf ? lo : hi; o16[k] = mine + __shfl_xor(other, 32); }
        const size_t co = (size_t)tok * 1024 + c32 * 32 + hf * 16;
        float* orow = OUT + co; float ss = 0.f; f32x4 x2[4];
        { const v4u* xp = (const v4u*)(XG2 + co); const v4u w0 = xp[0], w1 = xp[1];
          x2[0] = (f32x4){bflo(w0.x) + o16[0], bfhi(w0.x) + o16[1], bflo(w0.y) + o16[2], bfhi(w0.y) + o16[3]};
          x2[1] = (f32x4){bflo(w0.z) + o16[4], bfhi(w0.z) + o16[5], bflo(w0.w) + o16[6], bfhi(w0.w) + o16[7]};
          x2[2] = (f32x4){bflo(w1.x) + o16[8], bfhi(w1.x) + o16[9], bflo(w1.y) + o16[10], bfhi(w1.y) + o16[11]};
          x2[3] = (f32x4){bflo(w1.z) + o16[12], bfhi(w1.z) + o16[13], bflo(w1.w) + o16[14], bfhi(w1.w) + o16[15]}; }
#pragma unroll
        for (int j = 0; j < 4; ++j) ss += (x2[j][0] * x2[j][0] + x2[j][1] * x2[j][1]) + (x2[j][2] * x2[j][2] + x2[j][3] * x2[j][3]);
        const float rs = 1.0f / sqrtf(wave_sum(ss) * (1.f / 1024.f) + EPS);
#pragma unroll
        for (int j = 0; j < 4; ++j) { const f32x4 g4 = *(const f32x4*)(fg + c32 * 32 + hf * 16 + 4 * j); *(f32x4*)(orow + 4 * j) = x2[j] * rs * g4; }
    }
}

#define RLX_AGENT __ATOMIC_RELAXED, __HIP_MEMORY_SCOPE_AGENT
#define XB_TMO      128
#define XB_XCNT(j)  (256  + 64 * (j))
#define XB_XSUB(j)  (1280 + 64 * (j))
#define XB_XGEN(j)  (2304 + 64 * (j))
#define XB_TOP      3328
#define XB_TOPGEN   3392
#define XCD_BAR_WORDS 3456
#define XB_SPIN_CAP (1u << 18)

__device__ __forceinline__ unsigned xb_ld(unsigned* p)              { return __hip_atomic_load(p, __ATOMIC_RELAXED, __HIP_MEMORY_SCOPE_AGENT); }
__device__ __forceinline__ unsigned xb_add(unsigned* p, unsigned v) { return __hip_atomic_fetch_add(p, v, __ATOMIC_RELAXED, __HIP_MEMORY_SCOPE_AGENT); }
__device__ __forceinline__ unsigned xb_xcc_id() { return (unsigned)__builtin_amdgcn_s_getreg((3 << 11) | 20) & 0xFu; }
#define XB_SPIN(cond, bar) do { unsigned _sp = 0; while (cond) { __builtin_amdgcn_s_sleep(1); \
    if ((++_sp & 255u) == 0u) { if (xb_ld(&(bar)[XB_TMO])) break; if (_sp > XB_SPIN_CAP) { atomicAdd(&(bar)[XB_TMO], 1u); break; } } } } while (0)

struct XcdBarrier {
    unsigned* bar; unsigned x;
    volatile LAS unsigned* st;
};

__device__ __forceinline__ XcdBarrier xcd_barrier_post(unsigned* bar, volatile LAS unsigned* st) {
    XcdBarrier b; b.bar = bar; b.x = xb_xcc_id(); b.st = st;
    if (threadIdx.x == 0) (void)xb_add(&bar[XB_XCNT(b.x)], 1u);
    return b;
}
__device__ __forceinline__ void xcd_barrier_complete(unsigned* bar, unsigned x, unsigned& nloc, unsigned& nx) {
    const unsigned G = gridDim.x * gridDim.y * gridDim.z;
    unsigned sum, cnt, mine, sp = 0u;
    for (;;) {
        sum = 0u; cnt = 0u; mine = 0u;
#pragma unroll
        for (unsigned j = 0; j < 16; ++j) { const unsigned c = xb_ld(&bar[XB_XCNT(j)]); sum += c; cnt += (c > 0u) ? 1u : 0u; mine = (j == x) ? c : mine; }
        if (sum == G) break;
        __builtin_amdgcn_s_sleep(1);
        if ((++sp & 255u) == 0u) { if (xb_ld(&bar[XB_TMO])) break; if (sp > XB_SPIN_CAP) { atomicAdd(&bar[XB_TMO], 1u); break; } }
    }
    nloc = mine > 0u ? mine : 1u; nx = cnt > 0u ? cnt : 1u;
}

__device__ __forceinline__ void xcd_barrier(const XcdBarrier& b) {
    asm volatile("s_waitcnt vmcnt(0)" ::: "memory");
    __syncthreads();
    if (threadIdx.x == 0) {
        unsigned* bar = b.bar;
        __builtin_amdgcn_s_waitcnt(0);
        unsigned nloc = b.st[0], nx = b.st[1];
        if (nloc == 0u) { xcd_barrier_complete(bar, b.x, nloc, nx); b.st[0] = nloc; b.st[1] = nx; }
        const unsigned old = xb_add(&bar[XB_XSUB(b.x)], 1u);
        const unsigned gen = old / nloc;
        if (old + 1u == (gen + 1u) * nloc) {
            __builtin_amdgcn_fence(__ATOMIC_RELEASE, "agent");
            asm volatile("s_waitcnt vmcnt(0)" ::: "memory");
            const unsigned og = xb_add(&bar[XB_TOP], 1u);
            const unsigned tg = og / nx;
            if (og + 1u == (tg + 1u) * nx) xb_add(&bar[XB_TOPGEN], 1u);
            else XB_SPIN(xb_ld(&bar[XB_TOPGEN]) == tg, bar);
            __builtin_amdgcn_fence(__ATOMIC_ACQUIRE, "agent");
            xb_add(&bar[XB_XGEN(b.x)], 1u);
            asm volatile("s_waitcnt vmcnt(0)" ::: "memory");
        } else {
            XB_SPIN(xb_ld(&bar[XB_XGEN(b.x)]) == gen, bar);
            __builtin_amdgcn_fence(__ATOMIC_ACQUIRE, "agent");
            asm volatile("s_waitcnt vmcnt(0)" ::: "memory");
        }
    }
    __syncthreads();
}


__global__ void __launch_bounds__(NTHREADS, 2) fwd_kernel(Args args) {
    extern __shared__ __attribute__((aligned(16))) unsigned char lds[];
    const int tid = threadIdx.x, lane = tid & 63, wave = __builtin_amdgcn_readfirstlane(tid >> 6);
    const int G = gridDim.x, bx = blockIdx.x;
    const int vcu = (G % 8 == 0) ? (bx % 8) * (G / 8) + bx / 8 : bx;
    unsigned char* ws = args.ws;
    const float* x = args.in[0];
    bf16* WinT = (bf16*)(ws + WS_WIN); bf16* WpwT = (bf16*)(ws + WS_WPW); bf16* WoT = (bf16*)(ws + WS_WO); bf16* WoutT = (bf16*)(ws + WS_WOUT); bf16* WqT = (bf16*)(ws + WS_WQ);
    unsigned char* EU = ws + WS_EU; unsigned char* EV = ws + WS_EV; float* SU = (float*)(ws + WS_ESC); float* SV = SU + NEXP; float* SSQ = SV + NEXP; bf16* SKb = (bf16*)(ws + WS_SK);
    bf16* XN = (bf16*)(ws + WS_XN); bf16* Ub = (bf16*)(ws + WS_U); bf16* MG = (bf16*)(ws + WS_MG); bf16* XG2 = (bf16*)(ws + WS_XG2);
    bf16* Gt = (bf16*)(ws + WS_G); bf16* QP = (bf16*)(ws + WS_QP);
    bf16* Qb = (bf16*)(ws + WS_Q); bf16* Kb = (bf16*)(ws + WS_K); bf16* Vb = (bf16*)(ws + WS_V);
    int* IDX = (int*)(ws + WS_IDX); float* GATE = (float*)(ws + WS_GATE);
    bf16* CA = (bf16*)(ws + WS_CA);
    LAS unsigned char* lds3 = (LAS unsigned char*)lds;
    const int lo = args.ph_lo, hi = args.ph_hi;
    volatile LAS unsigned* MISC = (volatile LAS unsigned*)(lds3 + MISC_OFF);
    if (tid < 32) MISC[tid] = 0u;
    __syncthreads();
    XcdBarrier bar_; bar_.bar = (unsigned*)(ws + WS_CTL) + CW_BAR; bar_.x = 0; bar_.st = nullptr;
    if (hi - lo > 1) bar_ = xcd_barrier_post((unsigned*)(ws + WS_CTL) + CW_BAR, MISC + 8);
#define SEAM(k) do { if (IN(k) && IN((k) + 1)) xcd_barrier(bar_); } while (0)
#ifdef ONLY_PHASE
#define IN(k) ((k) == ONLY_PHASE && lo <= (k) && (k) < hi)
#else
#define IN(k) (lo <= (k) && (k) < hi)
#endif

    if (IN(0)) {
        LAS float* scr = (LAS float*)(lds3 + wave * 16384);
        const int gw = vcu * NWAVES + wave, NGW = G * NWAVES;
        constexpr int I_IN = 16 * (IN_DIM / 32), I_SQ = 16 * 32, I_Q = 16 * 64;
        constexpr int NITEMS = I_IN + 3 * I_SQ + I_Q;
        for (int it = gw; it < NITEMS; it += NGW) {
            int r = it;
            if (r < I_IN) { const int nblk = IN_DIM / 32, kb = r / nblk, nb = r % nblk; p0_transpose_item(args.in[2], D, IN_DIM, WinT, glu_row(32 * nb), scr, kb, nb, lane); continue; } r -= I_IN;
            if (r < I_SQ) { p0_transpose_item(args.in[7], D, D, WpwT, 32 * (r % 32), scr, r / 32, r % 32, lane); continue; } r -= I_SQ;
            if (r < I_SQ) { p0_transpose_item(args.in[9], D, D, WoT, 32 * (r % 32), scr, r / 32, r % 32, lane); continue; } r -= I_SQ;
            if (r < I_SQ) { p0_transpose_item(args.in[10], D, D, WoutT, 32 * (r % 32), scr, r / 32, r % 32, lane); continue; } r -= I_SQ;
            p0_transpose_item(args.in[12], D, 2048, WqT, 32 * (r % 64), scr, r / 64, r % 64, lane, args.in[11]);
        }
        const size_t gt = (size_t)vcu * NTHREADS + tid, ngt = (size_t)G * NTHREADS;
        for (size_t i = gt; i < (size_t)M; i += ngt) SSQ[i] = 0.f;
        cvt_stream(args.in[13], SKb, (size_t)2 * NKEYS * PHALF, gt, ngt);
        for (int r = gw; r < NEXP; r += NGW) { const int tb = r >= NEXP / 2, e = 2 * (r - tb * (NEXP / 2)); rows_to_fp6(args.in[14 + tb] + (size_t)e * D, (tb ? EV : EU) + (size_t)e * E6ROW, (tb ? SV : SU) + e, lane, tb ? nullptr : args.in[11], scr); }
        for (int m = gw; m < M; m += 4 * NGW) {
            f32x4 v[4][4]; float ssr[4];
#pragma unroll
            for (int r = 0; r < 4; ++r) { const f32x4* xr = (const f32x4*)(x + (size_t)(m + r * NGW) * D) + lane;
#pragma unroll
                for (int j = 0; j < 4; ++j) v[r][j] = xr[64 * j]; }
#pragma unroll
            for (int r = 0; r < 4; ++r) { float q = 0.f;
#pragma unroll
                for (int j = 0; j < 4; ++j) q += (v[r][j][0] * v[r][j][0] + v[r][j][1] * v[r][j][1]) + (v[r][j][2] * v[r][j][2] + v[r][j][3] * v[r][j][3]);
                ssr[r] = q; }
#pragma unroll
            for (int o = 1; o < 64; o <<= 1) {
#pragma unroll
                for (int r = 0; r < 4; ++r) ssr[r] += __shfl_xor(ssr[r], o); }
#pragma unroll
            for (int r = 0; r < 4; ++r) { const float rs = 1.0f / sqrtf(ssr[r] * (1.f / 1024.f) + EPS); v2u* o8 = (v2u*)(XN + (size_t)(m + r * NGW) * D) + lane;
#pragma unroll
                for (int j = 0; j < 4; ++j) { const f32x4 gg = ((const f32x4*)args.in[1])[lane + 64 * j]; v2u o; o.x = pk2(v[r][j][0] * rs * gg[0], v[r][j][1] * rs * gg[1]); o.y = pk2(v[r][j][2] * rs * gg[2], v[r][j][3] * rs * gg[3]); o8[64 * j] = o; } }
        }
    }
    SEAM(0);
    if (IN(1)) {
        pg8::Gemm g{XN, WinT, XN, WinT, M, IN_DIM, D}; pg8::StaticOrder S; S.init(M, IN_DIM, G, bx, 1);
        EpiInProj E{Ub, Qb, Kb, Vb, Gt};
        pg8::gemm_phase<EpiInProj>(lds3, g, S, E);
    }
    SEAM(1);
    if (IN(2)) {
        conv_phase(lds3, Ub, CA, args.in[3], args.in[4], args.in[5], args.in[6], vcu, G);
        __syncthreads();
        att::attn_phase(lds3, Qb, Kb, Vb, Qb, args.in[8], vcu, G);
    }
    SEAM(2);
    if (IN(3)) {
        pg8::Gemm g{CA, WpwT, Qb, WoT, M, D, D}; pg8::StaticOrder S; S.init(M, D, G, bx, 2);
        EpiMerge E{Gt, MG};
        pg8::gemm_phase<EpiMerge>(lds3, g, S, E);
    }
    SEAM(3);
    if (IN(4)) {
        pg8::Gemm g{MG, WoutT, MG, WoutT, M, D, D}; pg8::StaticOrder S; S.init(M, D, G, bx, 1);
        EpiResid E{x, XG2, SSQ};
        pg8::gemm_phase<EpiResid>(lds3, g, S, E);
    }
    SEAM(4);
    if (IN(5)) {
        pg8::Gemm g{XG2, WqT, XG2, WqT, M, 2048, D}; pg8::StaticOrder S; S.init(M, 2048, G, bx, 1);
        EpiBf16Rs E{QP, SSQ};
        pg8::gemm_phase<EpiBf16Rs>(lds3, g, S, E);
    }
    SEAM(5);
    if (IN(6)) tk::topk_phase(lds3, QP, SKb, IDX, GATE, vcu, G);
    SEAM(6);
    if (IN(7)) gather_phase(XG2, SSQ, EU, EV, SU, SV, IDX, GATE, GATE, args.in[16], args.out, vcu, G);
#undef IN
#undef SEAM
}

extern "C" void kernel_launch(void* const* d_in, const int* in_sizes, int n_in, void* d_out, int out_size, void* d_ws, size_t ws_size, hipStream_t stream) {
    static int grid = 0;
    if (grid == 0) {
        if (n_in != 17 || in_sizes[0] != M * D || out_size != M * D || ws_size < WS_END) { fprintf(stderr, "kernel_launch: unexpected shapes (n_in %d, in0 %d, out %d, ws %zu)\n", n_in, n_in > 0 ? in_sizes[0] : -1, out_size, ws_size); grid = -1; return; }
        int dev = 0, cus = 0;
        if (hipGetDevice(&dev) != hipSuccess || hipDeviceGetAttribute(&cus, hipDeviceAttributeMultiprocessorCount, dev) != hipSuccess) { grid = -1; return; }
        if (hipFuncSetAttribute((const void*)fwd_kernel, hipFuncAttributeMaxDynamicSharedMemorySize, LDS_BYTES) != hipSuccess) { fprintf(stderr, "kernel_launch: hipFuncSetAttribute failed\n"); grid = -1; return; }
        int per_cu = 0;
        if (hipOccupancyMaxActiveBlocksPerMultiprocessor(&per_cu, (const void*)fwd_kernel, NTHREADS, LDS_BYTES) != hipSuccess || per_cu < 1) { fprintf(stderr, "kernel_launch: occupancy query says %d\n", per_cu); }
        (void)hipGetLastError();
        grid = cus;
    }
    if (grid < 0) return;
    Args a{};
    for (int i = 0; i < 17; ++i) a.in[i] = (const float*)d_in[i];
    a.out = (float*)d_out; a.ws = (unsigned char*)d_ws;
    if (MK_N_LAUNCHES == 1) {
        a.ph_lo = 0; a.ph_hi = 8;
        if (hipMemsetAsync((char*)d_ws + WS_CTL, 0, CTL_ZERO_BYTES, stream) != hipSuccess) { fprintf(stderr, "kernel_launch: memset failed\n"); return; }
        hipLaunchKernelGGL(fwd_kernel, dim3(grid), dim3(NTHREADS), LDS_BYTES, stream, a);
    } else {
        for (int p = 0; p < 8; ++p) {
            a.ph_lo = p; a.ph_hi = p + 1;
            hipLaunchKernelGGL(fwd_kernel, dim3(grid), dim3(NTHREADS), LDS_BYTES, stream, a);
        }
    }
}
```

```cpp
#include <hip/hip_runtime.h>
#include <cstdio>
#include <cstdint>

#ifndef MK_N_LAUNCHES
#define MK_N_LAUNCHES 1
#endif

constexpr int BATCH = 16, SEQ = 2048, D = 1024, M = BATCH * SEQ;
constexpr int CK = 31, CPAD = 15;
constexpr int NH = 16, NKV = 4, HD = 64, KVD = 256, WIN = 128;
constexpr int IN_DIM = 5632;
constexpr int PHD = 8, PKD = 256, PHALF = 128, NKEYS = 128, NEXP = 16384, TOPK = 16;
constexpr float EPS = 1e-6f;
constexpr int NWAVES = 8, NTHREADS = 512;
constexpr float LOG2E = 1.4426950408889634f, QSCALE = 0.125f * 1.4426950408889634f;

typedef unsigned short bf16;
typedef unsigned v4u __attribute__((ext_vector_type(4)));
typedef unsigned v2u __attribute__((ext_vector_type(2)));
typedef float f32x4 __attribute__((ext_vector_type(4)));
typedef float f32x2 __attribute__((ext_vector_type(2)));
typedef __bf16 bf16x2_t __attribute__((ext_vector_type(2)));
#define LAS __attribute__((address_space(3)))

__device__ __forceinline__ int opaque_tid() { int t = threadIdx.x; asm volatile("" : "+v"(t)); return t; }
__device__ __forceinline__ void fmac_s(float& acc, float a, float b) { asm volatile("v_fmac_f32 %0, %1, %2" : "+v"(acc) : "v"(a), "v"(b)); }
__device__ __forceinline__ void mul_s(float& x, float a) { asm volatile("v_mul_f32 %0, %0, %1" : "+v"(x) : "v"(a)); }
__device__ __forceinline__ unsigned pk2(float lo, float hi) { f32x2 v = {lo, hi}; bf16x2_t b = __builtin_convertvector(v, bf16x2_t); return __builtin_bit_cast(unsigned, b); }
__device__ __forceinline__ float bflo(unsigned u) { return __uint_as_float(u << 16); }
__device__ __forceinline__ float bfhi(unsigned u) { return __uint_as_float(u & 0xffff0000u); }
__device__ __forceinline__ float sigmoidf_(float x) { return __builtin_amdgcn_rcpf(1.0f + __builtin_amdgcn_exp2f(x * -1.4426950408889634f)); }
__device__ __forceinline__ float wave_sum(float v) {
#pragma unroll
    for (int o = 1; o < 64; o <<= 1) v += __shfl_xor(v, o);
    return v;
}

namespace pg8 {
typedef unsigned short bf16_t;
typedef short bf16x8 __attribute__((ext_vector_type(8)));
constexpr int BM = 256, BK = 64, HALF = 128, HTB = HALF * BK * 2, STAGE_BYTES = 8 * HTB, NXCD = 8, WGM = 8;

__host__ __device__ __forceinline__ int lds_byte(int r, int c) { const int st = (r >> 4) * 2 + (c >> 5), rr = r & 15, cc = c & 31, ob = rr * 64 + cc * 2; return st * 1024 + (ob ^ (((ob >> 9) & 1) << 5)); }
__host__ __device__ __forceinline__ void stage_rc(int b, int& R, int& C) { const int st = b / 1024, sb = b % 1024, swz = sb ^ (((sb >> 9) & 1) << 5); R = (st >> 1) * 16 + swz / 64; C = (st & 1) * 32 + (swz % 64) / 2; }
__host__ __device__ __forceinline__ int perm32(int rho) { const int n = rho >> 4, i = rho & 15; return 8 * (i >> 2) + 4 * n + (i & 3); }

struct Unit { int pm, pn, g; };
struct Gemm { const bf16_t* A0; const bf16_t* B0; const bf16_t* A1; const bf16_t* B1; int M, N, K; };

struct StaticOrder {
    int nM, nN, nwg, G, c, per;
    __host__ __device__ void init(int M_, int N_, int G_, int c_, int per_) { nM = M_ / BM; nN = N_ / BM; nwg = nM * nN; G = G_; c = c_; per = per_; }
    __host__ __device__ bool next(int i, Unit& u) const {
        const int ti = i / per; u.g = i % per;
        const long L = (long)ti * G + c; if (L >= nwg) return false;
        int wgid = (int)L; { const int q = nwg / NXCD, r = nwg % NXCD, xcd = wgid % NXCD, off = wgid / NXCD; wgid = (xcd < r ? xcd * (q + 1) : r * (q + 1) + (xcd - r) * q) + off; }
        const int nig = WGM * nN, gid = wgid / nig, fm = gid * WGM, gsz = (nM - fm) < WGM ? (nM - fm) : WGM;
        u.pm = fm + ((wgid % nig) % gsz); u.pn = (wgid % nig) / gsz; return true;
    }
};

template <class Epi>
__device__ __forceinline__ void gemm_phase(LAS unsigned char* lds, const Gemm g, const StaticOrder& S, const Epi& E) {
    const int tid = opaque_tid(), wid = __builtin_amdgcn_readfirstlane(tid >> 6), lane = tid & 63, wr = wid >> 2, wc = wid & 3, fr = lane & 15, fq = lane >> 4;
    const int K = g.K, nt = K / BK;
    unsigned voffA[2], voffB[2];
#pragma unroll
    for (int i = 0; i < 2; ++i) { int R, C; stage_rc(tid * 16 + i * 8192, R, C); const int Rb = Epi::PERM ? ((R & ~31) + perm32(R & 31)) : R;
        voffA[i] = (unsigned)(R * K + C) * 2u; voffB[i] = (unsigned)(Rb * K + C) * 2u; }
    const size_t kstep = (size_t)(BK * 2);
    const size_t hstep = (size_t)HALF * K * 2;
    const size_t tstep = 2 * hstep;
    const unsigned ldsw = (unsigned)wid * 1024u;
    const int aoff = lds_byte(wr * 64 + fr, fq * 8), boff = lds_byte(wc * 32 + fr, fq * 8);
#define PG8_SA(b, h) (((b) * 2 + (h)) * HTB)
#define PG8_SB(b, h) ((4 + (b) * 2 + (h)) * HTB)
#define PG8_STAGE(bufoff, gbase, voff) do { _Pragma("unroll") for (int _i = 0; _i < 2; ++_i) \
        __builtin_amdgcn_global_load_lds((const unsigned*)((const char*)(gbase) + (voff)[_i]), (LAS unsigned*)(lds + (bufoff) + ldsw + _i * 8192), 16, 0, 0); } while (0)
#define PG8_LDA(dst, b, h) do { _Pragma("unroll") for (int m = 0; m < 4; ++m) _Pragma("unroll") for (int k = 0; k < 2; ++k) dst[m][k] = *(const LAS bf16x8*)(lds + PG8_SA(b, h) + aoff + m * 2048 + k * 1024); } while (0)
#define PG8_LDB(dst, b, h) do { _Pragma("unroll") for (int n = 0; n < 2; ++n) _Pragma("unroll") for (int k = 0; k < 2; ++k) dst[n][k] = *(const LAS bf16x8*)(lds + PG8_SB(b, h) + boff + n * 2048 + k * 1024); } while (0)
#define PG8_MMA(ai, bj, At, Bt) do { __builtin_amdgcn_s_setprio(1); _Pragma("unroll") for (int m = 0; m < 4; ++m) _Pragma("unroll") for (int n = 0; n < 2; ++n) _Pragma("unroll") for (int k = 0; k < 2; ++k) \
        acc[ai][bj][m][n] = __builtin_amdgcn_mfma_f32_16x16x32_bf16(Bt[n][k], At[m][k], acc[ai][bj][m][n], 0, 0, 0); __builtin_amdgcn_s_setprio(0); } while (0)
#define PG8_WAIT_V(n) asm volatile("s_waitcnt vmcnt(" #n ")" ::: "memory")
#define PG8_WAIT_L(n) asm volatile("s_waitcnt lgkmcnt(" #n ")" ::: "memory")
#define PG8_BAR __builtin_amdgcn_s_barrier()
#define PG8_SCHED __builtin_amdgcn_sched_barrier(0)
    Unit cur, nxt; int ui = 0;
    if (!S.next(0, cur)) return;
    f32x4 acc[2][2][4][2];
#pragma unroll
    for (int a = 0; a < 2; ++a)
#pragma unroll
        for (int b = 0; b < 2; ++b)
#pragma unroll
            for (int m = 0; m < 4; ++m)
#pragma unroll
                for (int n = 0; n < 2; ++n) acc[a][b][m][n] = (f32x4){0.f, 0.f, 0.f, 0.f};
    bf16x8 At[4][2], B0[2][2], B1[2][2];
    const char* cA = (const char*)(cur.g ? g.A1 : g.A0) + (size_t)cur.pm * tstep; const char* cB = (const char*)(cur.g ? g.B1 : g.B0) + (size_t)cur.pn * tstep;
    PG8_STAGE(PG8_SB(0, 0), cB, voffB); PG8_STAGE(PG8_SB(0, 1), cB + hstep, voffB); PG8_STAGE(PG8_SA(0, 0), cA, voffA); PG8_STAGE(PG8_SA(0, 1), cA + hstep, voffA);
    if (wr == 1) PG8_BAR;
    PG8_WAIT_V(2); PG8_BAR;
    PG8_STAGE(PG8_SB(1, 0), cB + kstep, voffB); PG8_STAGE(PG8_SA(1, 0), cA + kstep, voffA); PG8_STAGE(PG8_SB(1, 1), cB + hstep + kstep, voffB);
    PG8_WAIT_V(6); PG8_BAR;
    for (;;) {
        const bool has_next = S.next(ui + 1, nxt);
        const char* nA = has_next ? (const char*)(nxt.g ? g.A1 : g.A0) + (size_t)nxt.pm * tstep : cA; const char* nB = has_next ? (const char*)(nxt.g ? g.B1 : g.B0) + (size_t)nxt.pn * tstep : cB;
        for (int t = 0; t < nt; t += 2) {
            const bool last = (t == nt - 2);
            const char* a1 = cA + (size_t)(t + 1) * kstep;
            const char* a2 = last ? nA : cA + (size_t)(t + 2) * kstep; const char* b2 = last ? nB : cB + (size_t)(t + 2) * kstep;
            const char* a3 = a2 + kstep; const char* b3 = b2 + kstep;
            PG8_LDB(B0, 0, 0); PG8_LDB(B1, 0, 1); PG8_SCHED; PG8_LDA(At, 0, 0); PG8_STAGE(PG8_SA(1, 1), a1 + hstep, voffA);
            PG8_WAIT_V(8); PG8_WAIT_L(0); PG8_BAR; PG8_MMA(0, 0, At, B0); PG8_MMA(0, 1, At, B1); PG8_BAR; PG8_SCHED;
            PG8_LDA(At, 0, 1); PG8_STAGE(PG8_SB(0, 0), b2, voffB); PG8_STAGE(PG8_SB(0, 1), b2 + hstep, voffB); PG8_STAGE(PG8_SA(0, 0), a2, voffA);
            PG8_WAIT_V(8); PG8_WAIT_L(0); PG8_BAR; PG8_MMA(1, 0, At, B0); PG8_MMA(1, 1, At, B1); PG8_BAR; PG8_SCHED;
            PG8_LDB(B0, 1, 0); PG8_LDB(B1, 1, 1); PG8_SCHED; PG8_LDA(At, 1, 0); PG8_STAGE(PG8_SA(0, 1), a2 + hstep, voffA);
            PG8_WAIT_V(8); PG8_WAIT_L(0); PG8_BAR; PG8_MMA(0, 0, At, B0); PG8_MMA(0, 1, At, B1); PG8_BAR; PG8_SCHED;
            PG8_LDA(At, 1, 1); PG8_STAGE(PG8_SB(1, 0), b3, voffB); PG8_STAGE(PG8_SB(1, 1), b3 + hstep, voffB); PG8_STAGE(PG8_SA(1, 0), a3, voffA);
            PG8_WAIT_V(8); PG8_WAIT_L(0); PG8_BAR; PG8_MMA(1, 0, At, B0); PG8_MMA(1, 1, At, B1); PG8_BAR; PG8_SCHED;
        }
        if (wr == 0) PG8_BAR;
        E(acc, cur, wr, wc, fr, fq);
        if (!has_next) break;
        if (!(Epi::CHAIN && cur.g == 0))
#pragma unroll
        for (int a = 0; a < 2; ++a)
#pragma unroll
            for (int b = 0; b < 2; ++b)
#pragma unroll
                for (int m = 0; m < 4; ++m)
#pragma unroll
                    for (int n = 0; n < 2; ++n) acc[a][b][m][n] = (f32x4){0.f, 0.f, 0.f, 0.f};
        cur = nxt; cA = nA; cB = nB; ++ui;
        if (wr == 1) PG8_BAR;
    }
    PG8_WAIT_V(0);
    PG8_BAR;
#undef PG8_SA
#undef PG8_SB
#undef PG8_STAGE
#undef PG8_LDA
#undef PG8_LDB
#undef PG8_MMA
#undef PG8_WAIT_V
#undef PG8_WAIT_L
#undef PG8_BAR
#undef PG8_SCHED
}
}

constexpr size_t MiB = 1u << 20;
constexpr size_t WS_CTL = 0;
constexpr size_t WS_WIN = 2 * MiB, WS_WPW = 13 * MiB, WS_WO = 15 * MiB, WS_WOUT = 17 * MiB, WS_WQ = 19 * MiB, WS_SK = 23 * MiB;
constexpr size_t WS_EU = 24 * MiB, WS_EV = 40 * MiB, WS_ESC = 56 * MiB;
constexpr size_t WS_XN = 88 * MiB, WS_U = 152 * MiB;
constexpr size_t WS_MG = 88 * MiB, WS_XG2 = 152 * MiB;
constexpr size_t WS_G = 216 * MiB;
constexpr size_t WS_QP = 216 * MiB;
constexpr size_t WS_Q = 344 * MiB, WS_K = 408 * MiB, WS_V = 424 * MiB;
constexpr size_t WS_IDX = 344 * MiB, WS_GATE = 360 * MiB;
constexpr size_t WS_CA = 440 * MiB;
constexpr size_t WS_END = 504 * MiB;
constexpr int LDS_BYTES = 147456;
constexpr int MISC_OFF = 131072 + 8192;
constexpr int CW_BAR = 4096;
constexpr size_t CTL_ZERO_BYTES = 65536;

struct Args { const float* in[17]; float* out; unsigned char* ws; int ph_lo, ph_hi; };

struct EpiInProj {
    static constexpr bool PERM = true, CHAIN = false;
    bf16 *U, *Q, *K, *V, *G;
    __device__ __forceinline__ void operator()(f32x4 (&acc)[2][2][4][2], const pg8::Unit& u, int wr, int wc, int fr, int fq) const {
        const int row0 = u.pm * 256 + wr * 64 + fr; const int cw = wc * 32 + 8 * fq;
        if (u.pn < 8) {
#pragma unroll
            for (int ai = 0; ai < 2; ++ai)
#pragma unroll
                for (int m = 0; m < 4; ++m) { const size_t row = (size_t)(row0 + ai * 128 + m * 16);
                    f32x4 a0 = acc[ai][0][m][0], a1 = acc[ai][0][m][1], b0 = acc[ai][1][m][0], b1 = acc[ai][1][m][1];
                    v4u w; w.x = pk2(a0[0] * sigmoidf_(b0[0]), a0[1] * sigmoidf_(b0[1])); w.y = pk2(a0[2] * sigmoidf_(b0[2]), a0[3] * sigmoidf_(b0[3]));
                    w.z = pk2(a1[0] * sigmoidf_(b1[0]), a1[1] * sigmoidf_(b1[1])); w.w = pk2(a1[2] * sigmoidf_(b1[2]), a1[3] * sigmoidf_(b1[3]));
                    *(v4u*)(U + row * 1024 + u.pn * 128 + cw) = w; }
        } else if (u.pn >= 14) {
            const int p = u.pn - 14; unsigned char* G8 = (unsigned char*)G;
#pragma unroll
            for (int ai = 0; ai < 2; ++ai)
#pragma unroll
                for (int m = 0; m < 4; ++m) { unsigned char* rowp = G8 + (size_t)(row0 + ai * 128 + m * 16) * 2048 + (size_t)(p * 128 + cw) * 2;
                    v4u w = {0u, 0u, 0u, 0u};
#pragma unroll
                    for (int j = 0; j < 4; ++j) { w.x = __builtin_amdgcn_cvt_pk_u8_f32(sigmoidf_(acc[ai][0][m][0][j]) * 255.0f, j, w.x); w.y = __builtin_amdgcn_cvt_pk_u8_f32(sigmoidf_(acc[ai][0][m][1][j]) * 255.0f, j, w.y);
                        w.z = __builtin_amdgcn_cvt_pk_u8_f32(sigmoidf_(acc[ai][1][m][0][j]) * 255.0f, j, w.z); w.w = __builtin_amdgcn_cvt_pk_u8_f32(sigmoidf_(acc[ai][1][m][1][j]) * 255.0f, j, w.w); }
                    *(v4u*)rowp = w; }
        } else {
            bf16* base; int ld, col0; float sc = 1.0f;
            if (u.pn < 12) { base = Q; ld = 1024; col0 = (u.pn - 8) * 256; sc = QSCALE; }
            else if (u.pn == 12) { base = K; ld = 256; col0 = 0; }
            else { base = V; ld = 256; col0 = 0; }
#pragma unroll
            for (int ai = 0; ai < 2; ++ai)
#pragma unroll
                for (int m = 0; m < 4; ++m) { bf16* rowp = base + (size_t)(row0 + ai * 128 + m * 16) * ld + col0 + cw;
#pragma unroll
                    for (int bj = 0; bj < 2; ++bj) { f32x4 v0 = acc[ai][bj][m][0] * sc, v1 = acc[ai][bj][m][1] * sc;
                        v4u w; w.x = pk2(v0[0], v0[1]); w.y = pk2(v0[2], v0[3]); w.z = pk2(v1[0], v1[1]); w.w = pk2(v1[2], v1[3]);
                        *(v4u*)(rowp + bj * 128) = w; } }
        }
    }
};
struct EpiMerge {
    static constexpr bool PERM = true, CHAIN = true;
    const bf16* G; bf16* MG;
    __device__ __forceinline__ void operator()(f32x4 (&acc)[2][2][4][2], const pg8::Unit& u, int wr, int wc, int fr, int fq) const {
        const int row0 = u.pm * 256 + wr * 64 + fr; const int col0 = u.pn * 256 + wc * 32 + 8 * fq;
        const unsigned char* G8 = (const unsigned char*)G;
#pragma unroll
        for (int ai = 0; ai < 2; ++ai) { const size_t row = (size_t)(row0 + ai * 128);
            const unsigned char* gp = G8 + row * 2048 + (size_t)col0 * 2; bf16* mp = MG + row * 1024 + col0;
            v4u gw[4][2];
#pragma unroll
            for (int m = 0; m < 4; ++m)
#pragma unroll
                for (int bj = 0; bj < 2; ++bj) gw[m][bj] = *(const v4u*)(gp + (size_t)(m * 16) * 2048 + bj * 256);
#pragma unroll
            for (int m = 0; m < 4; ++m)
#pragma unroll
                for (int bj = 0; bj < 2; ++bj) { const v4u g4 = gw[m][bj]; f32x4 v0 = acc[ai][bj][m][0], v1 = acc[ai][bj][m][1];
                    float fb[8];
#pragma unroll
                    for (int j = 0; j < 4; ++j) { fb[j] = fmaxf((float)((g4.z >> (8 * j)) & 0xffu), 1.0f); fb[4 + j] = fmaxf((float)((g4.w >> (8 * j)) & 0xffu), 1.0f); }
                    if (u.g) {
#pragma unroll
                        for (int j = 0; j < 4; ++j) { v0[j] *= fb[j] * (1.0f / 255.0f); v1[j] *= fb[4 + j] * (1.0f / 255.0f); }
                        v4u w; w.x = pk2(v0[0], v0[1]); w.y = pk2(v0[2], v0[3]); w.z = pk2(v1[0], v1[1]); w.w = pk2(v1[2], v1[3]); *(v4u*)(mp + (size_t)(m * 16) * 1024 + bj * 128) = w;
                    } else {
#pragma unroll
                        for (int j = 0; j < 4; ++j) { v0[j] *= (float)((g4.x >> (8 * j)) & 0xffu) * __builtin_amdgcn_rcpf(fb[j]); v1[j] *= (float)((g4.y >> (8 * j)) & 0xffu) * __builtin_amdgcn_rcpf(fb[4 + j]); }
                        acc[ai][bj][m][0] = v0; acc[ai][bj][m][1] = v1; } } }
    }
};
struct EpiResid {
    static constexpr bool PERM = true, CHAIN = false;
    const float* X; bf16* XG; float* SSQ;
    __device__ __forceinline__ void operator()(f32x4 (&acc)[2][2][4][2], const pg8::Unit& u, int wr, int wc, int fr, int fq) const {
        const int row0 = u.pm * 256 + wr * 64 + fr; const int col0 = u.pn * 256 + wc * 32 + 8 * fq;
#pragma unroll
        for (int ai = 0; ai < 2; ++ai) {
            f32x4 xv[4][2][2];
#pragma unroll
            for (int m = 0; m < 4; ++m) { const size_t off = (size_t)(row0 + ai * 128 + m * 16) * 1024 + col0;
#pragma unroll
                for (int bj = 0; bj < 2; ++bj)
#pragma unroll
                    for (int n = 0; n < 2; ++n) xv[m][bj][n] = *(const f32x4*)(X + off + bj * 128 + n * 4); }
#pragma unroll
            for (int m = 0; m < 4; ++m) { const int row = row0 + ai * 128 + m * 16; const size_t off = (size_t)row * 1024 + col0; float ss = 0.f;
#pragma unroll
                for (int bj = 0; bj < 2; ++bj) { const f32x4 x0 = xv[m][bj][0] + acc[ai][bj][m][0], x1 = xv[m][bj][1] + acc[ai][bj][m][1];
                    ss += ((x0[0] * x0[0] + x0[1] * x0[1]) + (x0[2] * x0[2] + x0[3] * x0[3])) + ((x1[0] * x1[0] + x1[1] * x1[1]) + (x1[2] * x1[2] + x1[3] * x1[3]));
                    v4u w; w.x = pk2(x0[0], x0[1]); w.y = pk2(x0[2], x0[3]); w.z = pk2(x1[0], x1[1]); w.w = pk2(x1[2], x1[3]); *(v4u*)(XG + off + bj * 128) = w; }
                ss += __shfl_xor(ss, 16); ss += __shfl_xor(ss, 32);
                if (fq == 0) atomicAdd(SSQ + row, ss); }
        }
    }
};
struct EpiBf16Rs {
    static constexpr bool PERM = true, CHAIN = false;
    bf16* O; const float* SSQ;
    __device__ __forceinline__ void operator()(f32x4 (&acc)[2][2][4][2], const pg8::Unit& u, int wr, int wc, int fr, int fq) const {
        const int row0 = u.pm * 256 + wr * 64 + fr;
        float ssq[2][4];
#pragma unroll
        for (int ai = 0; ai < 2; ++ai)
#pragma unroll
            for (int m = 0; m < 4; ++m) ssq[ai][m] = SSQ[row0 + ai * 128 + m * 16];
        const int sidx = 2 * wc + (fq >> 1), hh = fq & 1;
#pragma unroll
        for (int ai = 0; ai < 2; ++ai)
#pragma unroll
            for (int m = 0; m < 4; ++m) { const int row = row0 + ai * 128 + m * 16; const int tile = row >> 5, r32 = row & 31;
                const float rs = 1.0f / sqrtf(ssq[ai][m] * (1.f / 1024.f) + EPS);
#pragma unroll
                for (int bj = 0; bj < 2; ++bj) { const f32x4 v0 = acc[ai][bj][m][0] * rs, v1 = acc[ai][bj][m][1] * rs;
                    v4u w; w.x = pk2(v0[0], v0[1]); w.y = pk2(v0[2], v0[3]); w.z = pk2(v1[0], v1[1]); w.w = pk2(v1[2], v1[3]);
                    *(v4u*)(O + ((((size_t)(tile * 8 + u.pn) * 2 + bj) * 8 + sidx) * 64 + r32 + 32 * hh) * 8) = w; } }
    }
};

__device__ __forceinline__ void p0_transpose_item(const float* W, int K, int N, bf16* WT, int dst0, LAS float* scr, int kb, int nb, int lane, const float* kscale = nullptr) {
    const int k0 = 64 * kb, n0 = 32 * nb;
#pragma unroll 8
    for (int i = 0; i < 32; ++i) { const int kk = 2 * i + (lane >> 5); float wv_ = W[(size_t)(k0 + kk) * N + n0 + (lane & 31)]; if (kscale) wv_ *= kscale[k0 + kk]; scr[kk * 33 + (lane & 31)] = wv_; }
    asm volatile("s_waitcnt lgkmcnt(0)" ::: "memory");
    const int c = lane & 7;
#pragma unroll
    for (int j = 0; j < 4; ++j) { const int n = (lane >> 3) + 8 * j; const LAS float* s = scr + (8 * c) * 33 + n;
        v4u o; o.x = pk2(s[0 * 33], s[1 * 33]); o.y = pk2(s[2 * 33], s[3 * 33]); o.z = pk2(s[4 * 33], s[5 * 33]); o.w = pk2(s[6 * 33], s[7 * 33]);
        *(v4u*)(WT + (size_t)(dst0 + n) * K + k0 + 8 * c) = o; }
    asm volatile("s_waitcnt lgkmcnt(0)" ::: "memory");
}
__device__ __forceinline__ int glu_row(int n0) {
    if (n0 < 1024) return 256 * (n0 >> 7) + (n0 & 127);
    if (n0 < 2048) { const int n1 = n0 - 1024; return 256 * (n1 >> 7) + 128 + (n1 & 127); }
    if (n0 < 3584) return n0;
    if (n0 < 4608) { const int n1 = n0 - 3584; return 3584 + 256 * (n1 >> 7) + (n1 & 127); }
    { const int n1 = n0 - 4608; return 3584 + 256 * (n1 >> 7) + 128 + (n1 & 127); }
}
__device__ __forceinline__ void cvt_stream(const float* src, bf16* dst, size_t n, size_t gtid, size_t gthreads) {
    for (size_t i = gtid * 8; i < n; i += gthreads * 8) {
        const f32x4 a = *(const f32x4*)(src + i), b = *(const f32x4*)(src + i + 4);
        v4u o; o.x = pk2(a[0], a[1]); o.y = pk2(a[2], a[3]); o.z = pk2(b[0], b[1]); o.w = pk2(b[2], b[3]);
        *(v4u*)(dst + i) = o; }
}
typedef float v16f __attribute__((ext_vector_type(16)));
typedef float v32f __attribute__((ext_vector_type(32)));
typedef unsigned v6u __attribute__((ext_vector_type(6)));
typedef __bf16 v32bf __attribute__((ext_vector_type(32)));
constexpr int E6ROW = 768;
__device__ __forceinline__ void rows_to_fp6(const float* x2rows, unsigned char* o2rows, float* inv_scale2, int lane, const float* cscale, LAS float* scr) {
    const int c = lane & 31, hf = lane >> 5;
    { f32x4 t[8];
#pragma unroll
      for (int i = 0; i < 8; ++i) t[i] = *(const f32x4*)(x2rows + i * 256 + lane * 4);
#pragma unroll
      for (int i = 0; i < 8; ++i) { const int e = i * 256 + lane * 4; *(LAS f32x4*)((LAS unsigned char*)scr + (e >> 5) * 144 + (e & 31) * 4) = t[i]; }
      asm volatile("s_waitcnt lgkmcnt(0)" ::: "memory"); }
    const LAS f32x4* xr = (const LAS f32x4*)((LAS unsigned char*)scr + lane * 144);
    v16f a, b; float am = 0.f;
#pragma unroll
    for (int j = 0; j < 4; ++j) { f32x4 u = xr[j], w = xr[4 + j];
        if (cscale) { u = u * *(const f32x4*)(cscale + c * 32 + 4 * j); w = w * *(const f32x4*)(cscale + c * 32 + 16 + 4 * j); }
#pragma unroll
        for (int k = 0; k < 4; ++k) { am = fmaxf(am, fmaxf(fabsf(u[k]), fabsf(w[k]))); }
        a[2 * j] = u[0]; b[2 * j] = u[1]; a[2 * j + 1] = u[2]; b[2 * j + 1] = u[3];
        a[8 + 2 * j] = w[0]; b[8 + 2 * j] = w[1]; a[8 + 2 * j + 1] = w[2]; b[8 + 2 * j + 1] = w[3]; }
#pragma unroll
    for (int o = 1; o < 32; o <<= 1) am = fmaxf(am, __shfl_xor(am, o));
    am = fmaxf(am, 1e-30f);
    const float sc = 7.5f / am;
    a = a * sc; b = b * sc;
    const v6u d = __builtin_amdgcn_cvt_scalef32_2xpk16_fp6_f32(a, b, 1.0f);
    unsigned char* ob = o2rows + (size_t)hf * E6ROW + c * 24;
    *(v2u*)(ob) = (v2u){d[0], d[1]}; *(v2u*)(ob + 8) = (v2u){d[2], d[3]}; *(v2u*)(ob + 16) = (v2u){d[4], d[5]};
    if (c == 0) inv_scale2[hf] = am * (1.0f / 7.5f);
    asm volatile("s_waitcnt lgkmcnt(0)" ::: "memory");
}
__device__ __forceinline__ void rms_row_to_bf16(const float* xrow, const float* g, bf16* orow, int lane) {
    const f32x4* xr = (const f32x4*)xrow + lane; const f32x4* gr = (const f32x4*)g + lane;
    f32x4 v[4]; float s = 0.f;
#pragma unroll
    for (int j = 0; j < 4; ++j) { v[j] = xr[64 * j]; s += (v[j][0] * v[j][0] + v[j][1] * v[j][1]) + (v[j][2] * v[j][2] + v[j][3] * v[j][3]); }
    const float rs = 1.0f / sqrtf(wave_sum(s) * (1.f / 1024.f) + EPS);
    v2u* o8 = (v2u*)orow + lane;
#pragma unroll
    for (int j = 0; j < 4; ++j) { const f32x4 gg = gr[64 * j]; v2u o; o.x = pk2(v[j][0] * rs * gg[0], v[j][1] * rs * gg[1]); o.y = pk2(v[j][2] * rs * gg[2], v[j][3] * rs * gg[3]); o8[64 * j] = o; }
}

__device__ __forceinline__ void conv_phase(LAS unsigned char* lds, const bf16* U, bf16* CA, const float* dw_w, const float* dw_b, const float* ln_g, const float* ln_b, int vcu, int G) {
    const int tid = opaque_tid(), lane = tid & 63, wave = tid >> 6;
    const int c0 = 2 * tid;
    constexpr int TT = 32, ROWS = TT + 2 * CPAD, TILE_B = ROWS * 2048;
    f32x2 wv[CK];
#pragma unroll
    for (int j = 0; j < CK; ++j) wv[j] = *(const f32x2*)(dw_w + j * 1024 + c0);
    const f32x2 bi = *(const f32x2*)(dw_b + c0), lg = *(const f32x2*)(ln_g + c0), lb = *(const f32x2*)(ln_b + c0);
    LAS float* red = (LAS float*)(lds + TILE_B);
    LAS float* stat = red + 512;
    const LAS unsigned char* xb = lds + c0 * 2;
    for (int item = vcu; item < BATCH * (SEQ / TT); item += G) {
        const int b = item / (SEQ / TT), t0 = (item % (SEQ / TT)) * TT;
#pragma unroll
        for (int hb = 0; hb < 2; ++hb) {
            v4u val[8];
#pragma unroll
            for (int it = 0; it < 8; ++it) { const int i = tid + (hb * 8 + it) * NTHREADS; const int row = i >> 7, ch = i & 127, tt = t0 - CPAD + row; const bool ok = (i < ROWS * 128) && (tt >= 0) && (tt < SEQ);
                val[it] = *(const v4u*)(U + ((size_t)b * SEQ + (ok ? tt : t0)) * 1024 + ch * 8); if (!ok) val[it] = (v4u){0u, 0u, 0u, 0u}; }
#pragma unroll
            for (int it = 0; it < 8; ++it) { const int i = tid + (hb * 8 + it) * NTHREADS; const int row = i >> 7, ch = i & 127; if (i < ROWS * 128) *(LAS v4u*)(lds + row * 2048 + ch * 16) = val[it]; }
        }
        __syncthreads();
#pragma unroll 1
        for (int rd = 0; rd < 2; ++rd) {
            const LAS unsigned char* xr = xb + rd * 16 * 2048;
            float ac0[16], ac1[16];
#pragma unroll
            for (int t = 0; t < 16; ++t) { ac0[t] = bi[0]; ac1[t] = bi[1]; }
#pragma clang loop unroll(full)
            for (int r = 0; r < 16 + 2 * CPAD; ++r) {
                const unsigned raw = *(const LAS unsigned*)(xr + r * 2048); const float x0 = bflo(raw), x1 = bfhi(raw);
#pragma clang loop unroll(full)
                for (int j = 0; j < CK; ++j) { const int t = r - j; if (t >= 0 && t < 16) { fmac_s(ac0[t], wv[j][0], x0); fmac_s(ac1[t], wv[j][1], x1); } }
            }
            float v[32];
#pragma unroll
            for (int t = 0; t < 16; ++t) { v[2 * t] = ac0[t] + ac1[t]; v[2 * t + 1] = ac0[t] * ac0[t] + ac1[t] * ac1[t]; }
#pragma unroll
            for (int o = 32, n = 16; n >= 1; o >>= 1, n >>= 1) { const bool hi = (lane & o) != 0;
#pragma unroll
                for (int k = 0; k < n; ++k) { const float a = v[k], bb = v[k + n]; const float send = hi ? a : bb, keep = hi ? bb : a; v[k] = keep + __shfl_xor(send, o); } }
            const float rr = v[0] + __shfl_xor(v[0], 1);
            if ((lane & 1) == 0) red[wave * 32 + (lane >> 1)] = rr;
            __syncthreads();
            if (tid < 16) { float s1 = 0.f, s2 = 0.f;
#pragma unroll
                for (int w = 0; w < 8; ++w) { s1 += red[w * 32 + 2 * tid]; s2 += red[w * 32 + 2 * tid + 1]; }
                const float mean = s1 * (1.f / 1024.f); const float var = s2 * (1.f / 1024.f) - mean * mean;
                stat[2 * tid] = mean; stat[2 * tid + 1] = 1.0f / sqrtf(var + EPS); }
            __syncthreads();
            bf16* Cb = CA + ((size_t)b * SEQ + t0 + 16 * rd) * 1024 + c0;
#pragma unroll
            for (int t = 0; t < 16; ++t) { const float mean = stat[2 * t], rstd = stat[2 * t + 1];
                float y0 = (ac0[t] - mean) * rstd * lg[0] + lb[0], y1 = (ac1[t] - mean) * rstd * lg[1] + lb[1];
                y0 = y0 * sigmoidf_(y0); y1 = y1 * sigmoidf_(y1);
                *(unsigned*)(Cb + (size_t)t * 1024) = pk2(y0, y1); }
            __syncthreads();
        }
    }
}

namespace att {
typedef short bf16x8 __attribute__((ext_vector_type(8)));
typedef short s16x4 __attribute__((ext_vector_type(4)));
typedef float f32x16 __attribute__((ext_vector_type(16)));
constexpr int KP = 144, SPAN = 320, VOFF = SPAN * KP, WSTG = 2 * SPAN * KP;
__device__ __forceinline__ s16x4 vtr(const LAS unsigned char* p) { return __builtin_bit_cast(s16x4, __builtin_amdgcn_ds_read_tr16_b64_v4i16((LAS s16x4*)p)); }
__device__ __forceinline__ void attn_phase(LAS unsigned char* lds, const bf16* Q, const bf16* K, const bf16* V, bf16* AO, const float* sink, int vcu, int G) {
    const int tid = opaque_tid(), lane = tid & 63, wave = __builtin_amdgcn_readfirstlane(tid >> 6), r32 = lane & 31, hh = lane >> 5;
    v4u kreg[5], vreg[5];
#define ATT_STAGE_LOAD(UNIT) do { const int qb_ = (UNIT) % (SEQ / 64), kvh_ = ((UNIT) / (SEQ / 64)) % NKV, b_ = (UNIT) / ((SEQ / 64) * NKV); const int t0_ = qb_ * 64, s0_ = t0_ - WIN; \
        _Pragma("unroll") for (int it = 0; it < 5; ++it) { const int i = tid + it * NTHREADS; const int row = i >> 3, ch = i & 7, sp = s0_ + row; const bool ok = (sp >= 0) && (sp < SEQ); \
            const size_t go = ((size_t)b_ * SEQ + (ok ? sp : t0_)) * KVD + kvh_ * 64 + ch * 8; kreg[it] = *(const v4u*)(K + go); vreg[it] = *(const v4u*)(V + go); } } while (0)
    if (vcu < BATCH * NKV * (SEQ / 64)) ATT_STAGE_LOAD(vcu);
    for (int unit = vcu; unit < BATCH * NKV * (SEQ / 64); unit += G) {
        const int qb = unit % (SEQ / 64), kvh = (unit / (SEQ / 64)) % NKV, b = unit / ((SEQ / 64) * NKV);
        const int t0 = qb * 64;
#pragma unroll
        for (int it = 0; it < 5; ++it) { const int i = tid + it * NTHREADS; const int row = i >> 3, ch = i & 7;
            *(LAS v4u*)(lds + row * KP + ch * 16) = kreg[it]; *(LAS v4u*)(lds + VOFF + row * KP + ch * 16) = vreg[it]; }
        if (unit + G < BATCH * NKV * (SEQ / 64)) ATT_STAGE_LOAD(unit + G);
        __syncthreads();
        {
            const int head = kvh * 4 + (wave >> 1), qoff = (wave & 1) * 32, q0 = t0 + qoff;
            const float slope2 = exp2f(-0.5f * (float)(head + 1)) * LOG2E, sink2 = sink[head] * LOG2E;
            LAS unsigned char* stg = lds + WSTG + wave * (32 * KP);
            const size_t qbase = ((size_t)b * SEQ + q0) * 1024 + head * 64;
#pragma unroll
            for (int i = 0; i < 4; ++i) { const int id = i * 64 + lane, row = id >> 3, ch = id & 7; *(LAS v4u*)(stg + row * KP + ch * 16) = *(const v4u*)(Q + qbase + (size_t)row * 1024 + ch * 8); }
            bf16x8 qf[4];
#pragma unroll
            for (int s = 0; s < 4; ++s) qf[s] = *(const LAS bf16x8*)(stg + r32 * KP + (2 * s + hh) * 16);
            float m = sink2, l = (hh == 0) ? 1.0f : 0.0f;
            f32x16 O0, O1, negm;
#pragma unroll
            for (int r = 0; r < 16; ++r) { O0[r] = 0.f; O1[r] = 0.f; negm[r] = -sink2; }
            const int q4 = (lane & 15) >> 2, p4 = lane & 3, g16 = (lane >> 4) & 1;
#pragma unroll 1
            for (int it = 0; it < 9; ++it) {
                const int j = (it & 1) ? 4 - ((it + 1) >> 1) : 4 + (it >> 1);
                const int kt0 = q0 - WIN + 32 * j;
                if (kt0 < 0 || kt0 >= SEQ) continue;
                const int lrow0 = qoff + 32 * j;
                f32x16 sa = negm;
#pragma unroll
                for (int s = 0; s < 4; ++s) { const bf16x8 kf = *(const LAS bf16x8*)(lds + (lrow0 + r32) * KP + 32 * s + 16 * hh); sa = __builtin_amdgcn_mfma_f32_32x32x16_bf16(kf, qf[s], sa, 0, 0, 0); }
                const float cf = (float)(WIN - 32 * j + r32 - 4 * hh);
                if (j == 0 || j == 8) {
#pragma unroll
                    for (int r = 0; r < 16; ++r) { const float d = cf - (float)((r & 3) + 8 * (r >> 2)); float v = fmaf(-slope2, fabsf(d), sa[r]); v = (fabsf(d) > (float)WIN) ? -1e30f : v; sa[r] = v; }
                } else {
#pragma unroll
                    for (int r = 0; r < 16; ++r) { const float d = cf - (float)((r & 3) + 8 * (r >> 2)); sa[r] = fmaf(-slope2, fabsf(d), sa[r]); }
                }
                float tmax = fmaxf(fmaxf(sa[0], sa[1]), sa[2]);
#pragma unroll
                for (int r = 3; r < 15; r += 2) tmax = fmaxf(fmaxf(tmax, sa[r]), sa[r + 1]);
                tmax = fmaxf(tmax, sa[15]);
                if (__any(tmax > 16.0f)) {
                    tmax = fmaxf(tmax, __shfl_xor(tmax, 32));
                    const float dl = fmaxf(tmax, 0.f), alpha = __builtin_amdgcn_exp2f(-dl); m += dl; l *= alpha;
#pragma unroll
                    for (int r = 0; r < 16; ++r) { O0[r] *= alpha; O1[r] *= alpha; sa[r] -= dl; negm[r] = -m; }
                }
                float ls0 = 0.f, ls1 = 0.f;
#pragma unroll
                for (int r = 0; r < 16; r += 2) { sa[r] = __builtin_amdgcn_exp2f(sa[r]); sa[r + 1] = __builtin_amdgcn_exp2f(sa[r + 1]); ls0 += sa[r]; ls1 += sa[r + 1]; }
                l += ls0 + ls1;
                v4u pw0, pw1;
                pw0.x = pk2(sa[0], sa[1]); pw0.y = pk2(sa[2], sa[3]); pw0.z = pk2(sa[4], sa[5]); pw0.w = pk2(sa[6], sa[7]);
                pw1.x = pk2(sa[8], sa[9]); pw1.y = pk2(sa[10], sa[11]); pw1.z = pk2(sa[12], sa[13]); pw1.w = pk2(sa[14], sa[15]);
                const bf16x8 pb0 = __builtin_bit_cast(bf16x8, pw0), pb1 = __builtin_bit_cast(bf16x8, pw1);
                const LAS unsigned char* vb = lds + VOFF + (lrow0 + 4 * hh + q4) * KP + (16 * g16 + 4 * p4) * 2;
#pragma unroll
                for (int s2 = 0; s2 < 2; ++s2) {
                    const s16x4 a0l = vtr(vb + (16 * s2) * KP), a0h = vtr(vb + (16 * s2 + 8) * KP);
                    const s16x4 a1l = vtr(vb + (16 * s2) * KP + 64), a1h = vtr(vb + (16 * s2 + 8) * KP + 64);
                    const bf16x8 A0 = (bf16x8){a0l[0], a0l[1], a0l[2], a0l[3], a0h[0], a0h[1], a0h[2], a0h[3]};
                    const bf16x8 A1 = (bf16x8){a1l[0], a1l[1], a1l[2], a1l[3], a1h[0], a1h[1], a1h[2], a1h[3]};
                    O0 = __builtin_amdgcn_mfma_f32_32x32x16_bf16(A0, s2 ? pb1 : pb0, O0, 0, 0, 0);
                    O1 = __builtin_amdgcn_mfma_f32_32x32x16_bf16(A1, s2 ? pb1 : pb0, O1, 0, 0, 0);
                }
            }
            const float inv = 1.0f / (l + __shfl_xor(l, 32));
#pragma unroll
            for (int g4 = 0; g4 < 4; ++g4) { v2u w0, w1;
                w0.x = pk2(O0[4 * g4] * inv, O0[4 * g4 + 1] * inv); w0.y = pk2(O0[4 * g4 + 2] * inv, O0[4 * g4 + 3] * inv);
                w1.x = pk2(O1[4 * g4] * inv, O1[4 * g4 + 1] * inv); w1.y = pk2(O1[4 * g4 + 2] * inv, O1[4 * g4 + 3] * inv);
                *(LAS v2u*)(stg + r32 * KP + (8 * g4 + 4 * hh) * 2) = w0; *(LAS v2u*)(stg + r32 * KP + (32 + 8 * g4 + 4 * hh) * 2) = w1; }
#pragma unroll
            for (int i = 0; i < 4; ++i) { const int id = i * 64 + lane, row = id >> 3, ch = id & 7; *(v4u*)(AO + qbase + (size_t)row * 1024 + ch * 8) = *(const LAS v4u*)(stg + row * KP + ch * 16); }
        }
        __syncthreads();
    }
}
#undef ATT_STAGE_LOAD
}

namespace tk {
typedef short bf16x8 __attribute__((ext_vector_type(8)));
typedef float f32x16 __attribute__((ext_vector_type(16)));
constexpr int SKP = 272;
#define TK_CAND50(X) X(0,0,0) X(1,0,1) X(2,0,2) X(3,0,3) X(4,0,4) X(5,0,5) X(6,0,6) X(7,0,7) X(8,0,8) X(9,0,9) X(10,0,10) X(11,0,11) X(12,0,12) X(13,0,13) X(14,0,14) X(15,0,15) X(16,1,0) X(17,1,1) X(18,1,2) X(19,1,3) X(20,1,4) X(21,1,5) X(22,1,6) X(23,1,7) X(24,2,0) X(25,2,1) X(26,2,2) X(27,2,3) X(28,2,4) X(29,3,0) X(30,3,1) X(31,3,2) X(32,3,3) X(33,4,0) X(34,4,1) X(35,4,2) X(36,5,0) X(37,5,1) X(38,6,0) X(39,6,1) X(40,7,0) X(41,7,1) X(42,8,0) X(43,9,0) X(44,10,0) X(45,11,0) X(46,12,0) X(47,13,0) X(48,14,0) X(49,15,0)
#define TK_PAIR25(X) X(0,0,0,2,1) X(1,0,1,2,2) X(2,0,2,2,3) X(3,0,3,2,4) X(4,0,4,3,0) X(5,0,5,3,1) X(6,0,6,3,2) X(7,0,7,3,3) X(8,0,8,4,0) X(9,0,9,4,1) X(10,0,10,4,2) X(11,0,11,5,0) X(12,0,12,5,1) X(13,0,13,6,0) X(14,0,14,6,1) X(15,0,15,7,0) X(16,1,0,7,1) X(17,1,1,8,0) X(18,1,2,9,0) X(19,1,3,10,0) X(20,1,4,11,0) X(21,1,5,12,0) X(22,1,6,13,0) X(23,1,7,14,0) X(24,2,0,15,0)
template <int OFF> __device__ __forceinline__ void sort16(float (&v)[64]) {
#pragma unroll
    for (int k = 2; k <= 16; k <<= 1)
#pragma unroll
        for (int j = k >> 1; j > 0; j >>= 1)
#pragma unroll
            for (int i = 0; i < 16; ++i) { const int l = i ^ j; if (l > i) { const float a = v[OFF + i], b = v[OFF + l]; const float hi = fmaxf(a, b), lo = fminf(a, b);
                if ((i & k) == 0) { v[OFF + i] = hi; v[OFF + l] = lo; } else { v[OFF + i] = lo; v[OFF + l] = hi; } } }
}
template <int OFF> __device__ __forceinline__ void merge16(float (&v)[64]) {
#pragma unroll
    for (int j = 8; j > 0; j >>= 1)
#pragma unroll
        for (int i = 0; i < 16; ++i) { const int l = i ^ j; if (l > i) { const float a = v[OFF + i], b = v[OFF + l]; v[OFF + i] = fmaxf(a, b); v[OFF + l] = fminf(a, b); } }
}
template <int A, int B> __device__ __forceinline__ void top16_merge(float (&v)[64]) {
#pragma unroll
    for (int i = 0; i < 16; ++i) v[A + i] = fmaxf(v[A + i], v[B + 15 - i]);
    merge16<A>(v);
}
__device__ __forceinline__ void top16_of_64(float (&v)[64]) {
    sort16<0>(v); sort16<16>(v); sort16<32>(v); sort16<48>(v);
    top16_merge<0, 16>(v); top16_merge<32, 48>(v); top16_merge<0, 32>(v);
}
__device__ __forceinline__ void topk_phase(LAS unsigned char* lds, const bf16* QP, const bf16* SKb, int* IDX, float* GATE, int vcu, int G) {
    const int tid = opaque_tid(), lane = tid & 63, wave = __builtin_amdgcn_readfirstlane(tid >> 6), r32 = lane & 31, hh = lane >> 5;
    for (int i = tid; i < 256 * 16; i += NTHREADS) { const int row = i >> 4, ch = i & 15; *(LAS v4u*)(lds + row * SKP + ch * 16) = *(const v4u*)(SKb + row * 128 + ch * 8); }
    __syncthreads();
    for (int unit = vcu * NWAVES + wave; unit < (M / 32) * PHD; unit += G * NWAVES) {
        const int tile = unit >> 3, h = unit & 7; const int tok = tile * 32 + r32;
        float L[2][16];
#pragma unroll
        for (int p = 0; p < 2; ++p) {
            bf16x8 qf[8];
#pragma unroll
            for (int sidx = 0; sidx < 8; ++sidx) qf[sidx] = *(const bf16x8*)(QP + ((((size_t)(tile * 8 + h) * 2 + p) * 8 + sidx) * 64 + lane) * 8);
            float v[64];
#define TK_KT(kt) { f32x16 acc; \
                _Pragma("unroll") for (int r = 0; r < 16; ++r) acc[r] = 0.f; \
                _Pragma("unroll") for (int sidx = 0; sidx < 8; ++sidx) { const bf16x8 kf = *(const LAS bf16x8*)(lds + (p * 128 + 32 * kt + r32) * SKP + 32 * sidx + 16 * hh); acc = __builtin_amdgcn_mfma_f32_32x32x16_bf16(kf, qf[sidx], acc, 0, 0, 0); } \
                _Pragma("unroll") for (int r = 0; r < 16; ++r) { const unsigned kidx = (unsigned)(32 * kt + (r & 3) + 8 * (r >> 2)); v[16 * kt + r] = __uint_as_float(((__float_as_uint(acc[r]) & 0xffffff80u) | (unsigned)(hh << 2)) | kidx); } \
                sort16<16 * kt>(v); __builtin_amdgcn_sched_barrier(0); }
            TK_KT(0) TK_KT(1) top16_merge<0, 16>(v); __builtin_amdgcn_sched_barrier(0);
            TK_KT(2) TK_KT(3) top16_merge<32, 48>(v); __builtin_amdgcn_sched_barrier(0);
            top16_merge<0, 32>(v); __builtin_amdgcn_sched_barrier(0);
#undef TK_KT
            float t[16];
#pragma unroll
            for (int i = 0; i < 16; ++i) t[i] = __shfl_xor(v[15 - i], 32);
#pragma unroll
            for (int i = 0; i < 16; ++i) v[i] = fmaxf(v[i], t[i]);
            merge16<0>(v);
#pragma unroll
            for (int i = 0; i < 16; ++i) L[p][i] = v[i];
        }
        float sm[25];
#define X(c, i0, j0, i1, j1) { const float s0 = L[0][i0] + L[1][j0], s1 = L[0][i1] + L[1][j1]; sm[c] = hh ? s1 : s0; }
        TK_PAIR25(X)
#undef X
        float v[64];
#pragma unroll
        for (int c = 0; c < 25; ++c) v[c] = sm[c];
#pragma unroll
        for (int c = 25; c < 32; ++c) v[c] = -3.0e38f;
        sort16<0>(v); sort16<16>(v); top16_merge<0, 16>(v);
        float T;
        { float t[16];
#pragma unroll
          for (int i = 0; i < 16; ++i) t[i] = __shfl_xor(v[15 - i], 32);
#pragma unroll
          for (int i = 0; i < 16; ++i) t[i] = fmaxf(v[i], t[i]);
          T = fminf(fminf(t[0], t[1]), t[2]);
#pragma unroll
          for (int i = 3; i < 15; i += 2) T = fminf(fminf(T, t[i]), t[i + 1]);
          T = fminf(T, t[15]); }
        const float smax = L[0][0] + L[1][0];
        unsigned ia[16], ib[16];
#pragma unroll
        for (int i = 0; i < 16; ++i) { ia[i] = (__float_as_uint(L[0][i]) & 127u) << 7; ib[i] = __float_as_uint(L[1][i]) & 127u; }
        float pe[25]; float den = 0.f; int cnt = 0;
#pragma unroll
        for (int c = 0; c < 25; ++c) { const bool sel = sm[c] >= T; const float e = __builtin_amdgcn_exp2f((sm[c] - smax) * LOG2E); pe[c] = e; den += sel ? e : 0.f; cnt += sel ? 1 : 0; }
        den += __shfl_xor(den, 32);
        const int ocnt = __shfl_xor(cnt, 32);
        int pos = hh ? ocnt : 0;
        const float inv = 1.0f / den;
        LAS float* lg = (LAS float*)(lds + 256 * SKP + wave * 4096); LAS int* li = (LAS int*)(lg + 512);
#define X(c, i0, j0, i1, j1) { const unsigned e0 = ia[i0] + ib[j0], e1 = ia[i1] + ib[j1]; const unsigned em = hh ? e1 : e0; \
            const bool sel = sm[c] >= T; \
            if (sel && pos < 16) { lg[r32 * 16 + pos] = pe[c] * inv; li[r32 * 16 + pos] = (int)em; } \
            pos += sel ? 1 : 0; }
        TK_PAIR25(X)
#undef X
        asm volatile("s_waitcnt lgkmcnt(0)" ::: "memory");
#pragma unroll
        for (int rr = 0; rr < 2; ++rr) { const int tl = rr * 16 + (lane >> 2), pg = lane & 3; const size_t ob = (size_t)(tile * 32 + tl) * 128 + h * 16 + 4 * pg;
            *(f32x4*)(GATE + ob) = *(const LAS f32x4*)(lg + tl * 16 + 4 * pg); *(v4u*)(IDX + ob) = *(const LAS v4u*)(li + tl * 16 + 4 * pg); }
        asm volatile("s_waitcnt lgkmcnt(0)" ::: "memory");
    }
}
}

__device__ __forceinline__ float dot2bf(unsigned a, unsigned b, float c) { return __builtin_amdgcn_fdot2_f32_bf16(__builtin_bit_cast(bf16x2_t, a), __builtin_bit_cast(bf16x2_t, b), c, false); }
__device__ __forceinline__ float gelu_erf(float x) { return 0.5f * x * (1.0f + erff(x * 0.70710678118654752f)); }
typedef int v8i __attribute__((ext_vector_type(8)));
typedef int v4i __attribute__((ext_vector_type(4)));
__device__ __forceinline__ void gather_phase(LAS unsigned char* lds, const bf16* XG2, const float* SSQ, const unsigned char* EU, const unsigned char* EV, const float* SU, const float* SV, const int* IDX, const float* GATE, float* WGT, const float* fg, float* OUT, int vcu, int G) {
    const int tid = opaque_tid(), lane = tid & 63, wave = tid >> 6, c32 = lane & 31, hf = lane >> 5;
    const int emap = 16 * (lane & 3) + 2 * ((lane >> 2) & 7) + hf;
    const unsigned loff = (unsigned)c32 * 24u;
    struct __attribute__((packed, aligned(4))) U6 { unsigned d[6]; };
    {
    constexpr int RPITCH = 784, WLDS = 3072 + 16 * RPITCH;
    const int wv = __builtin_amdgcn_readfirstlane(wave);
    LAS unsigned char* wl_ = lds + wv * WLDS;
    LAS unsigned char* rb = wl_ + 3072;
    const int r16 = lane & 15, q4 = lane >> 4;
    const unsigned char* eul = EU + lane * 16;
#define DMA_HEAD(idxv_, hh_) do { if (lane < 48) { _Pragma("unroll") for (int r_ = 0; r_ < 16; ++r_) { const int si_ = __builtin_amdgcn_readlane((idxv_), ((hh_) & 3) * 16 + r_); \
        __builtin_amdgcn_global_load_lds((const unsigned*)(eul + (size_t)si_ * E6ROW), (LAS unsigned*)(rb + r_ * RPITCH), 16, 0, 0); } } } while (0)
    const int tok0 = vcu * NWAVES + wave;
    int nidx0 = 0, nidx1 = 0;
    if (tok0 < M) { nidx0 = IDX[(size_t)tok0 * 128 + lane]; nidx1 = IDX[(size_t)tok0 * 128 + 64 + lane]; }
    for (int tok = tok0; tok < M; tok += G * NWAVES) {
        const int idx0 = nidx0, idx1 = nidx1;
        DMA_HEAD(idx0, 0);
        { const int nt = tok + G * NWAVES; if (nt < M) { nidx0 = IDX[(size_t)nt * 128 + lane]; nidx1 = IDX[(size_t)nt * 128 + 64 + lane]; } }
        const float rs2 = 1.0f / sqrtf(SSQ[tok] * (1.f / 1024.f) + EPS);
        { const v4u* hp = (const v4u*)(XG2 + (size_t)tok * 1024 + lane * 16); const v4u w0 = hp[0], w1 = hp[1];
          const unsigned ww[8] = {w0.x, w0.y, w0.z, w0.w, w1.x, w1.y, w1.z, w1.w};
          float xv[16];
#pragma unroll
          for (int j = 0; j < 8; ++j) { xv[2 * j] = bflo(ww[j]) * rs2; xv[2 * j + 1] = bfhi(ww[j]) * rs2; }
          unsigned hi4[4], lo4[4];
#pragma unroll
          for (int j = 0; j < 4; ++j) {
              const float x0 = xv[4 * j], x1 = xv[4 * j + 1], x2 = xv[4 * j + 2], x3 = xv[4 * j + 3];
              int h = __builtin_amdgcn_cvt_pk_fp8_f32(x0, x1, 0, false); h = __builtin_amdgcn_cvt_pk_fp8_f32(x2, x3, h, true);
              const float r0 = x0 - __builtin_amdgcn_cvt_f32_fp8(h, 0), r1 = x1 - __builtin_amdgcn_cvt_f32_fp8(h, 1), r2 = x2 - __builtin_amdgcn_cvt_f32_fp8(h, 2), r3 = x3 - __builtin_amdgcn_cvt_f32_fp8(h, 3);
              int l = __builtin_amdgcn_cvt_pk_fp8_f32(r0, r1, 0, false); l = __builtin_amdgcn_cvt_pk_fp8_f32(r2, r3, l, true);
              hi4[j] = (unsigned)h; lo4[j] = (unsigned)l; }
          *(LAS v4u*)(wl_ + lane * 16) = (v4u){hi4[0], hi4[1], hi4[2], hi4[3]}; *(LAS v4u*)(wl_ + 1024 + lane * 16) = (v4u){lo4[0], lo4[1], lo4[2], lo4[3]};
        }
        const float g0 = GATE[(size_t)tok * 128 + lane], g1 = GATE[(size_t)tok * 128 + 64 + lane];
        const float su0 = SU[idx0], su1 = SU[idx1], sv0 = SV[idx0], sv1 = SV[idx1];
        v8i Bx[8];
        {
          const LAS unsigned char* bpa = wl_ + (r16 == 1 ? 1024 : 0) + 256 * (q4 >> 1) + 16 * (q4 & 1); const LAS unsigned char* bpb = bpa + 512;
#pragma unroll
          for (int s = 0; s < 8; ++s) { const v4u a = *(const LAS v4u*)(bpa + s * 32), b = *(const LAS v4u*)(bpb + s * 32);
              Bx[s] = (v8i){(int)a.x, (int)a.y, (int)a.z, (int)a.w, (int)b.x, (int)b.y, (int)b.z, (int)b.w}; } }
#pragma unroll
        for (int h = 0; h < 8; ++h) {
            asm volatile("s_waitcnt vmcnt(0)" ::: "memory");
            const LAS v4i* lp = (const LAS v4i*)(rb + r16 * RPITCH + q4 * 192);
            v4i L[12];
#pragma unroll
            for (int i = 0; i < 12; ++i) L[i] = lp[i];
            asm volatile("s_waitcnt lgkmcnt(0)" ::: "memory");
            __builtin_amdgcn_sched_barrier(0);
            if (h < 7) DMA_HEAD(h + 1 < 4 ? idx0 : idx1, h + 1);
            __builtin_amdgcn_sched_barrier(0);
            f32x4 acc = {0.f, 0.f, 0.f, 0.f};
#pragma unroll
            for (int t = 0; t < 4; ++t) {
                const v8i A0 = __builtin_shufflevector(L[3 * t], L[3 * t + 1], 0, 1, 2, 3, 4, 5, 6, 7);
                const v8i T = __builtin_shufflevector(L[3 * t + 1], L[3 * t + 2], 0, 1, 2, 3, 4, 5, 6, 7);
                const v8i A1 = __builtin_shufflevector(T, T, 2, 3, 4, 5, 6, 7, -1, -1);
                acc = __builtin_amdgcn_mfma_scale_f32_16x16x128_f8f6f4(A0, Bx[2 * t], acc, 2, 0, 0, 0, 0, 0);
                acc = __builtin_amdgcn_mfma_scale_f32_16x16x128_f8f6f4(A1, Bx[2 * t + 1], acc, 2, 0, 0, 0, 0, 0);
            }
            if (r16 < 2) *(LAS f32x4*)(wl_ + 2048 + r16 * 512 + (h * 16 + 4 * q4) * 4) = acc;
        }
        const float d0 = *(const LAS float*)(wl_ + 2048 + lane * 4) + *(const LAS float*)(wl_ + 2560 + lane * 4);
        const float d1 = *(const LAS float*)(wl_ + 2048 + 256 + lane * 4) + *(const LAS float*)(wl_ + 2560 + 256 + lane * 4);
        WGT[(size_t)tok * 128 + lane] = g0 * gelu_erf(d0 * su0) * sv0;
        WGT[(size_t)tok * 128 + 64 + lane] = g1 * gelu_erf(d1 * su1) * sv1;
    }
#undef DMA_HEAD
    }
    for (int tok = vcu * NWAVES + wave; tok < M; tok += G * NWAVES) {
        int idxl[2]; float wl[2];
#pragma unroll
        for (int blk = 0; blk < 2; ++blk) { idxl[blk] = IDX[(size_t)tok * 128 + blk * 64 + emap]; wl[blk] = WGT[(size_t)tok * 128 + blk * 64 + emap]; }
        v32f acc;
#pragma unroll
        for (int k = 0; k < 32; ++k) acc[k] = 0.f;
#pragma unroll
        for (int blk = 0; blk < 2; ++blk) {
#pragma unroll 1
            for (int bt = 0; bt < 4; ++bt) {
                U6 vr[8];
#pragma unroll
                for (int i = 0; i < 8; ++i) { const int pr = bt * 8 + i; const int ia = __builtin_amdgcn_readlane(idxl[blk], pr), ib = __builtin_amdgcn_readlane(idxl[blk], 32 + pr);
                    vr[i] = *(const U6*)(EV + (size_t)(hf ? ib : ia) * E6ROW + loff); }
#pragma unroll
                for (int i = 0; i < 8; ++i) { const int pr = bt * 8 + i;
                    const int wa = __builtin_amdgcn_readlane((int)__float_as_uint(wl[blk]), pr), wb = __builtin_amdgcn_readlane((int)__float_as_uint(wl[blk]), 32 + pr);
                    const float w = __uint_as_float((unsigned)(hf ? wb : wa));
                    const v6u d = {vr[i].d[0], vr[i].d[1], vr[i].d[2], vr[i].d[3], vr[i].d[4], vr[i].d[5]};
                    const v32f rv = __builtin_amdgcn_cvt_scalef32_pk32_f32_fp6(d, 1.0f);
                    acc = acc + rv * w; }
            }
        }
        float o16[16];
#pragma unroll
        for (int k = 0; k < 16; ++k) { const float lo = acc[k], hi = acc[16 + k]; const float mine = hf ? hi : lo, other = hf ? lo : hi; o16[k] = mine + __shfl_xor(other, 32); }
        const size_t co = (size_t)tok * 1024 + c32 * 32 + hf * 16;
        float* orow = OUT + co; float ss = 0.f; f32x4 x2[4];
        { const v4u* xp = (const v4u*)(XG2 + co); const v4u w0 = xp[0], w1 = xp[1];
          x2[0] = (f32x4){bflo(w0.x) + o16[0], bfhi(w0.x) + o16[1], bflo(w0.y) + o16[2], bfhi(w0.y) + o16[3]};
          x2[1] = (f32x4){bflo(w0.z) + o16[4], bfhi(w0.z) + o16[5], bflo(w0.w) + o16[6], bfhi(w0.w) + o16[7]};
          x2[2] = (f32x4){bflo(w1.x) + o16[8], bfhi(w1.x) + o16[9], bflo(w1.y) + o16[10], bfhi(w1.y) + o16[11]};
          x2[3] = (f32x4){bflo(w1.z) + o16[12], bfhi(w1.z) + o16[13], bflo(w1.w) + o16[14], bfhi(w1.w) + o16[15]}; }
#pragma unroll
        for (int j = 0; j < 4; ++j) ss += (x2[j][0] * x2[j][0] + x2[j][1] * x2[j][1]) + (x2[j][2] * x2[j][2] + x2[j][3] * x2[j][3]);
        const float rs = 1.0f / sqrtf(wave_sum(ss) * (1.f / 1024.f) + EPS);
#pragma unroll
        for (int j = 0; j < 4; ++j) { const f32x4 g4 = *(const f32x4*)(fg + c32 * 32 + hf * 16 + 4 * j); *(f32x4*)(orow + 4 * j) = x2[j] * rs * g4; }
    }
}

#define RLX_AGENT __ATOMIC_RELAXED, __HIP_MEMORY_SCOPE_AGENT
#define XB_TMO      128
#define XB_XCNT(j)  (256  + 64 * (j))
#define XB_XSUB(j)  (1280 + 64 * (j))
#define XB_XGEN(j)  (2304 + 64 * (j))
#define XB_TOP      3328
#define XB_TOPGEN   3392
#define XCD_BAR_WORDS 3456
#define XB_SPIN_CAP (1u << 18)

__device__ __forceinline__ unsigned xb_ld(unsigned* p)              { return __hip_atomic_load(p, __ATOMIC_RELAXED, __HIP_MEMORY_SCOPE_AGENT); }
__device__ __forceinline__ unsigned xb_add(unsigned* p, unsigned v) { return __hip_atomic_fetch_add(p, v, __ATOMIC_RELAXED, __HIP_MEMORY_SCOPE_AGENT); }
__device__ __forceinline__ unsigned xb_xcc_id() { return (unsigned)__builtin_amdgcn_s_getreg((3 << 11) | 20) & 0xFu; }
#define XB_SPIN(cond, bar) do { unsigned _sp = 0; while (cond) { __builtin_amdgcn_s_sleep(1); \
    if ((++_sp & 255u) == 0u) { if (xb_ld(&(bar)[XB_TMO])) break; if (_sp > XB_SPIN_CAP) { atomicAdd(&(bar)[XB_TMO], 1u); break; } } } } while (0)

struct XcdBarrier {
    unsigned* bar; unsigned x;
    volatile LAS unsigned* st;
};

__device__ __forceinline__ XcdBarrier xcd_barrier_post(unsigned* bar, volatile LAS unsigned* st) {
    XcdBarrier b; b.bar = bar; b.x = xb_xcc_id(); b.st = st;
    if (threadIdx.x == 0) (void)xb_add(&bar[XB_XCNT(b.x)], 1u);
    return b;
}
__device__ __forceinline__ void xcd_barrier_complete(unsigned* bar, unsigned x, unsigned& nloc, unsigned& nx) {
    const unsigned G = gridDim.x * gridDim.y * gridDim.z;
    unsigned sum, cnt, mine, sp = 0u;
    for (;;) {
        sum = 0u; cnt = 0u; mine = 0u;
#pragma unroll
        for (unsigned j = 0; j < 16; ++j) { const unsigned c = xb_ld(&bar[XB_XCNT(j)]); sum += c; cnt += (c > 0u) ? 1u : 0u; mine = (j == x) ? c : mine; }
        if (sum == G) break;
        __builtin_amdgcn_s_sleep(1);
        if ((++sp & 255u) == 0u) { if (xb_ld(&bar[XB_TMO])) break; if (sp > XB_SPIN_CAP) { atomicAdd(&bar[XB_TMO], 1u); break; } }
    }
    nloc = mine > 0u ? mine : 1u; nx = cnt > 0u ? cnt : 1u;
}

__device__ __forceinline__ void xcd_barrier(const XcdBarrier& b) {
    asm volatile("s_waitcnt vmcnt(0)" ::: "memory");
    __syncthreads();
    if (threadIdx.x == 0) {
        unsigned* bar = b.bar;
        __builtin_amdgcn_s_waitcnt(0);
        unsigned nloc = b.st[0], nx = b.st[1];
        if (nloc == 0u) { xcd_barrier_complete(bar, b.x, nloc, nx); b.st[0] = nloc; b.st[1] = nx; }
        const unsigned old = xb_add(&bar[XB_XSUB(b.x)], 1u);
        const unsigned gen = old / nloc;
        if (old + 1u == (gen + 1u) * nloc) {
            __builtin_amdgcn_fence(__ATOMIC_RELEASE, "agent");
            asm volatile("s_waitcnt vmcnt(0)" ::: "memory");
            const unsigned og = xb_add(&bar[XB_TOP], 1u);
            const unsigned tg = og / nx;
            if (og + 1u == (tg + 1u) * nx) xb_add(&bar[XB_TOPGEN], 1u);
            else XB_SPIN(xb_ld(&bar[XB_TOPGEN]) == tg, bar);
            __builtin_amdgcn_fence(__ATOMIC_ACQUIRE, "agent");
            xb_add(&bar[XB_XGEN(b.x)], 1u);
            asm volatile("s_waitcnt vmcnt(0)" ::: "memory");
        } else {
            XB_SPIN(xb_ld(&bar[XB_XGEN(b.x)]) == gen, bar);
            __builtin_amdgcn_fence(__ATOMIC_ACQUIRE, "agent");
            asm volatile("s_waitcnt vmcnt(0)" ::: "memory");
        }
    }
    __syncthreads();
}


__global__ void __launch_bounds__(NTHREADS, 2) fwd_kernel(Args args) {
    extern __shared__ __attribute__((aligned(16))) unsigned char lds[];
    const int tid = threadIdx.x, lane = tid & 63, wave = __builtin_amdgcn_readfirstlane(tid >> 6);
    const int G = gridDim.x, bx = blockIdx.x;
    const int vcu = (G % 8 == 0) ? (bx % 8) * (G / 8) + bx / 8 : bx;
    unsigned char* ws = args.ws;
    const float* x = args.in[0];
    bf16* WinT = (bf16*)(ws + WS_WIN); bf16* WpwT = (bf16*)(ws + WS_WPW); bf16* WoT = (bf16*)(ws + WS_WO); bf16* WoutT = (bf16*)(ws + WS_WOUT); bf16* WqT = (bf16*)(ws + WS_WQ);
    unsigned char* EU = ws + WS_EU; unsigned char* EV = ws + WS_EV; float* SU = (float*)(ws + WS_ESC); float* SV = SU + NEXP; float* SSQ = SV + NEXP; bf16* SKb = (bf16*)(ws + WS_SK);
    bf16* XN = (bf16*)(ws + WS_XN); bf16* Ub = (bf16*)(ws + WS_U); bf16* MG = (bf16*)(ws + WS_MG); bf16* XG2 = (bf16*)(ws + WS_XG2);
    bf16* Gt = (bf16*)(ws + WS_G); bf16* QP = (bf16*)(ws + WS_QP);
    bf16* Qb = (bf16*)(ws + WS_Q); bf16* Kb = (bf16*)(ws + WS_K); bf16* Vb = (bf16*)(ws + WS_V);
    int* IDX = (int*)(ws + WS_IDX); float* GATE = (float*)(ws + WS_GATE);
    bf16* CA = (bf16*)(ws + WS_CA);
    LAS unsigned char* lds3 = (LAS unsigned char*)lds;
    const int lo = args.ph_lo, hi = args.ph_hi;
    volatile LAS unsigned* MISC = (volatile LAS unsigned*)(lds3 + MISC_OFF);
    if (tid < 32) MISC[tid] = 0u;
    __syncthreads();
    XcdBarrier bar_; bar_.bar = (unsigned*)(ws + WS_CTL) + CW_BAR; bar_.x = 0; bar_.st = nullptr;
    if (hi - lo > 1) bar_ = xcd_barrier_post((unsigned*)(ws + WS_CTL) + CW_BAR, MISC + 8);
#define SEAM(k) do { if (IN(k) && IN((k) + 1)) xcd_barrier(bar_); } while (0)
#ifdef ONLY_PHASE
#define IN(k) ((k) == ONLY_PHASE && lo <= (k) && (k) < hi)
#else
#define IN(k) (lo <= (k) && (k) < hi)
#endif

    if (IN(0)) {
        LAS float* scr = (LAS float*)(lds3 + wave * 16384);
        const int gw = vcu * NWAVES + wave, NGW = G * NWAVES;
        constexpr int I_IN = 16 * (IN_DIM / 32), I_SQ = 16 * 32, I_Q = 16 * 64;
        constexpr int NITEMS = I_IN + 3 * I_SQ + I_Q;
        for (int it = gw; it < NITEMS; it += NGW) {
            int r = it;
            if (r < I_IN) { const int nblk = IN_DIM / 32, kb = r / nblk, nb = r % nblk; p0_transpose_item(args.in[2], D, IN_DIM, WinT, glu_row(32 * nb), scr, kb, nb, lane); continue; } r -= I_IN;
            if (r < I_SQ) { p0_transpose_item(args.in[7], D, D, WpwT, 32 * (r % 32), scr, r / 32, r % 32, lane); continue; } r -= I_SQ;
            if (r < I_SQ) { p0_transpose_item(args.in[9], D, D, WoT, 32 * (r % 32), scr, r / 32, r % 32, lane); continue; } r -= I_SQ;
            if (r < I_SQ) { p0_transpose_item(args.in[10], D, D, WoutT, 32 * (r % 32), scr, r / 32, r % 32, lane); continue; } r -= I_SQ;
            p0_transpose_item(args.in[12], D, 2048, WqT, 32 * (r % 64), scr, r / 64, r % 64, lane, args.in[11]);
        }
        const size_t gt = (size_t)vcu * NTHREADS + tid, ngt = (size_t)G * NTHREADS;
        for (size_t i = gt; i < (size_t)M; i += ngt) SSQ[i] = 0.f;
        cvt_stream(args.in[13], SKb, (size_t)2 * NKEYS * PHALF, gt, ngt);
        for (int r = gw; r < NEXP; r += NGW) { const int tb = r >= NEXP / 2, e = 2 * (r - tb * (NEXP / 2)); rows_to_fp6(args.in[14 + tb] + (size_t)e * D, (tb ? EV : EU) + (size_t)e * E6ROW, (tb ? SV : SU) + e, lane, tb ? nullptr : args.in[11], scr); }
        for (int m = gw; m < M; m += 4 * NGW) {
            f32x4 v[4][4]; float ssr[4];
#pragma unroll
            for (int r = 0; r < 4; ++r) { const f32x4* xr = (const f32x4*)(x + (size_t)(m + r * NGW) * D) + lane;
#pragma unroll
                for (int j = 0; j < 4; ++j) v[r][j] = xr[64 * j]; }
#pragma unroll
            for (int r = 0; r < 4; ++r) { float q = 0.f;
#pragma unroll
                for (int j = 0; j < 4; ++j) q += (v[r][j][0] * v[r][j][0] + v[r][j][1] * v[r][j][1]) + (v[r][j][2] * v[r][j][2] + v[r][j][3] * v[r][j][3]);
                ssr[r] = q; }
#pragma unroll
            for (int o = 1; o < 64; o <<= 1) {
#pragma unroll
                for (int r = 0; r < 4; ++r) ssr[r] += __shfl_xor(ssr[r], o); }
#pragma unroll
            for (int r = 0; r < 4; ++r) { const float rs = 1.0f / sqrtf(ssr[r] * (1.f / 1024.f) + EPS); v2u* o8 = (v2u*)(XN + (size_t)(m + r * NGW) * D) + lane;
#pragma unroll
                for (int j = 0; j < 4; ++j) { const f32x4 gg = ((const f32x4*)args.in[1])[lane + 64 * j]; v2u o; o.x = pk2(v[r][j][0] * rs * gg[0], v[r][j][1] * rs * gg[1]); o.y = pk2(v[r][j][2] * rs * gg[2], v[r][j][3] * rs * gg[3]); o8[64 * j] = o; } }
        }
    }
    SEAM(0);
    if (IN(1)) {
        pg8::Gemm g{XN, WinT, XN, WinT, M, IN_DIM, D}; pg8::StaticOrder S; S.init(M, IN_DIM, G, bx, 1);
        EpiInProj E{Ub, Qb, Kb, Vb, Gt};
        pg8::gemm_phase<EpiInProj>(lds3, g, S, E);
    }
    SEAM(1);
    if (IN(2)) {
        conv_phase(lds3, Ub, CA, args.in[3], args.in[4], args.in[5], args.in[6], vcu, G);
        __syncthreads();
        att::attn_phase(lds3, Qb, Kb, Vb, Qb, args.in[8], vcu, G);
    }
    SEAM(2);
    if (IN(3)) {
        pg8::Gemm g{CA, WpwT, Qb, WoT, M, D, D}; pg8::StaticOrder S; S.init(M, D, G, bx, 2);
        EpiMerge E{Gt, MG};
        pg8::gemm_phase<EpiMerge>(lds3, g, S, E);
    }
    SEAM(3);
    if (IN(4)) {
        pg8::Gemm g{MG, WoutT, MG, WoutT, M, D, D}; pg8::StaticOrder S; S.init(M, D, G, bx, 1);
        EpiResid E{x, XG2, SSQ};
        pg8::gemm_phase<EpiResid>(lds3, g, S, E);
    }
    SEAM(4);
    if (IN(5)) {
        pg8::Gemm g{XG2, WqT, XG2, WqT, M, 2048, D}; pg8::StaticOrder S; S.init(M, 2048, G, bx, 1);
        EpiBf16Rs E{QP, SSQ};
        pg8::gemm_phase<EpiBf16Rs>(lds3, g, S, E);
    }
    SEAM(5);
    if (IN(6)) tk::topk_phase(lds3, QP, SKb, IDX, GATE, vcu, G);
    SEAM(6);
    if (IN(7)) gather_phase(lds3, XG2, SSQ, EU, EV, SU, SV, IDX, GATE, GATE, args.in[16], args.out, vcu, G);
#undef IN
#undef SEAM
}

extern "C" void kernel_launch(void* const* d_in, const int* in_sizes, int n_in, void* d_out, int out_size, void* d_ws, size_t ws_size, hipStream_t stream) {
    static int grid = 0;
    if (grid == 0) {
        if (n_in != 17 || in_sizes[0] != M * D || out_size != M * D || ws_size < WS_END) { fprintf(stderr, "kernel_launch: unexpected shapes (n_in %d, in0 %d, out %d, ws %zu)\n", n_in, n_in > 0 ? in_sizes[0] : -1, out_size, ws_size); grid = -1; return; }
        int dev = 0, cus = 0;
        if (hipGetDevice(&dev) != hipSuccess || hipDeviceGetAttribute(&cus, hipDeviceAttributeMultiprocessorCount, dev) != hipSuccess) { grid = -1; return; }
        if (hipFuncSetAttribute((const void*)fwd_kernel, hipFuncAttributeMaxDynamicSharedMemorySize, LDS_BYTES) != hipSuccess) { fprintf(stderr, "kernel_launch: hipFuncSetAttribute failed\n"); grid = -1; return; }
        int per_cu = 0;
        if (hipOccupancyMaxActiveBlocksPerMultiprocessor(&per_cu, (const void*)fwd_kernel, NTHREADS, LDS_BYTES) != hipSuccess || per_cu < 1) { fprintf(stderr, "kernel_launch: occupancy query says %d\n", per_cu); }
        (void)hipGetLastError();
        grid = cus;
    }
    if (grid < 0) return;
    Args a{};
    for (int i = 0; i < 17; ++i) a.in[i] = (const float*)d_in[i];
    a.out = (float*)d_out; a.ws = (unsigned char*)d_ws;
    if (MK_N_LAUNCHES == 1) {
        a.ph_lo = 0; a.ph_hi = 8;
        if (hipMemsetAsync((char*)d_ws + WS_CTL, 0, CTL_ZERO_BYTES, stream) != hipSuccess) { fprintf(stderr, "kernel_launch: memset failed\n"); return; }
        hipLaunchKernelGGL(fwd_kernel, dim3(grid), dim3(NTHREADS), LDS_BYTES, stream, a);
    } else {
        for (int p = 0; p < 8; ++p) {
            a.ph_lo = p; a.ph_hi = p + 1;
            hipLaunchKernelGGL(fwd_kernel, dim3(grid), dim3(NTHREADS), LDS_BYTES, stream, a);
        }
    }
}
```

```cpp
#include <hip/hip_runtime.h>
#include <cstdio>
#include <cstdint>

#ifndef MK_N_LAUNCHES
#define MK_N_LAUNCHES 1
#endif

constexpr int BATCH = 16, SEQ = 2048, D = 1024, M = BATCH * SEQ;
constexpr int CK = 31, CPAD = 15;
constexpr int NH = 16, NKV = 4, HD = 64, KVD = 256, WIN = 128;
constexpr int IN_DIM = 5632;
constexpr int PHD = 8, PKD = 256, PHALF = 128, NKEYS = 128, NEXP = 16384, TOPK = 16;
constexpr float EPS = 1e-6f;
constexpr int NWAVES = 8, NTHREADS = 512;
constexpr float LOG2E = 1.4426950408889634f, QSCALE = 0.125f * 1.4426950408889634f;

typedef unsigned short bf16;
typedef unsigned v4u __attribute__((ext_vector_type(4)));
typedef unsigned v2u __attribute__((ext_vector_type(2)));
typedef float f32x4 __attribute__((ext_vector_type(4)));
typedef float f32x2 __attribute__((ext_vector_type(2)));
typedef __bf16 bf16x2_t __attribute__((ext_vector_type(2)));
#define LAS __attribute__((address_space(3)))

__device__ __forceinline__ int opaque_tid() { int t = threadIdx.x; asm volatile("" : "+v"(t)); return t; }
__device__ __forceinline__ void fmac_s(float& acc, float a, float b) { asm volatile("v_fmac_f32 %0, %1, %2" : "+v"(acc) : "v"(a), "v"(b)); }
__device__ __forceinline__ void mul_s(float& x, float a) { asm volatile("v_mul_f32 %0, %0, %1" : "+v"(x) : "v"(a)); }
__device__ __forceinline__ unsigned pk2(float lo, float hi) { f32x2 v = {lo, hi}; bf16x2_t b = __builtin_convertvector(v, bf16x2_t); return __builtin_bit_cast(unsigned, b); }
__device__ __forceinline__ float bflo(unsigned u) { return __uint_as_float(u << 16); }
__device__ __forceinline__ float bfhi(unsigned u) { return __uint_as_float(u & 0xffff0000u); }
__device__ __forceinline__ float sigmoidf_(float x) { return __builtin_amdgcn_rcpf(1.0f + __builtin_amdgcn_exp2f(x * -1.4426950408889634f)); }
__device__ __forceinline__ float wave_sum(float v) {
#pragma unroll
    for (int o = 1; o < 64; o <<= 1) v += __shfl_xor(v, o);
    return v;
}

namespace pg8 {
typedef unsigned short bf16_t;
typedef short bf16x8 __attribute__((ext_vector_type(8)));
constexpr int BM = 256, BK = 64, HALF = 128, HTB = HALF * BK * 2, STAGE_BYTES = 8 * HTB, NXCD = 8, WGM = 8;

__host__ __device__ __forceinline__ int lds_byte(int r, int c) { const int st = (r >> 4) * 2 + (c >> 5), rr = r & 15, cc = c & 31, ob = rr * 64 + cc * 2; return st * 1024 + (ob ^ (((ob >> 9) & 1) << 5)); }
__host__ __device__ __forceinline__ void stage_rc(int b, int& R, int& C) { const int st = b / 1024, sb = b % 1024, swz = sb ^ (((sb >> 9) & 1) << 5); R = (st >> 1) * 16 + swz / 64; C = (st & 1) * 32 + (swz % 64) / 2; }
__host__ __device__ __forceinline__ int perm32(int rho) { const int n = rho >> 4, i = rho & 15; return 8 * (i >> 2) + 4 * n + (i & 3); }

struct Unit { int pm, pn, g; };
struct Gemm { const bf16_t* A0; const bf16_t* B0; const bf16_t* A1; const bf16_t* B1; int M, N, K; };

struct StaticOrder {
    int nM, nN, nwg, G, c, per;
    __host__ __device__ void init(int M_, int N_, int G_, int c_, int per_) { nM = M_ / BM; nN = N_ / BM; nwg = nM * nN; G = G_; c = c_; per = per_; }
    __host__ __device__ bool next(int i, Unit& u) const {
        const int ti = i / per; u.g = i % per;
        const long L = (long)ti * G + c; if (L >= nwg) return false;
        int wgid = (int)L; { const int q = nwg / NXCD, r = nwg % NXCD, xcd = wgid % NXCD, off = wgid / NXCD; wgid = (xcd < r ? xcd * (q + 1) : r * (q + 1) + (xcd - r) * q) + off; }
        const int nig = WGM * nN, gid = wgid / nig, fm = gid * WGM, gsz = (nM - fm) < WGM ? (nM - fm) : WGM;
        u.pm = fm + ((wgid % nig) % gsz); u.pn = (wgid % nig) / gsz; return true;
    }
};

template <class Epi>
__device__ __forceinline__ void gemm_phase(LAS unsigned char* lds, const Gemm g, const StaticOrder& S, const Epi& E) {
    const int tid = opaque_tid(), wid = __builtin_amdgcn_readfirstlane(tid >> 6), lane = tid & 63, wr = wid >> 2, wc = wid & 3, fr = lane & 15, fq = lane >> 4;
    const int K = g.K, nt = K / BK;
    unsigned voffA[2], voffB[2];
#pragma unroll
    for (int i = 0; i < 2; ++i) { int R, C; stage_rc(tid * 16 + i * 8192, R, C); const int Rb = Epi::PERM ? ((R & ~31) + perm32(R & 31)) : R;
        voffA[i] = (unsigned)(R * K + C) * 2u; voffB[i] = (unsigned)(Rb * K + C) * 2u; }
    const size_t kstep = (size_t)(BK * 2);
    const size_t hstep = (size_t)HALF * K * 2;
    const size_t tstep = 2 * hstep;
    const unsigned ldsw = (unsigned)wid * 1024u;
    const int aoff = lds_byte(wr * 64 + fr, fq * 8), boff = lds_byte(wc * 32 + fr, fq * 8);
#define PG8_SA(b, h) (((b) * 2 + (h)) * HTB)
#define PG8_SB(b, h) ((4 + (b) * 2 + (h)) * HTB)
#define PG8_STAGE(bufoff, gbase, voff) do { _Pragma("unroll") for (int _i = 0; _i < 2; ++_i) \
        __builtin_amdgcn_global_load_lds((const unsigned*)((const char*)(gbase) + (voff)[_i]), (LAS unsigned*)(lds + (bufoff) + ldsw + _i * 8192), 16, 0, 0); } while (0)
#define PG8_LDA(dst, b, h) do { _Pragma("unroll") for (int m = 0; m < 4; ++m) _Pragma("unroll") for (int k = 0; k < 2; ++k) dst[m][k] = *(const LAS bf16x8*)(lds + PG8_SA(b, h) + aoff + m * 2048 + k * 1024); } while (0)
#define PG8_LDB(dst, b, h) do { _Pragma("unroll") for (int n = 0; n < 2; ++n) _Pragma("unroll") for (int k = 0; k < 2; ++k) dst[n][k] = *(const LAS bf16x8*)(lds + PG8_SB(b, h) + boff + n * 2048 + k * 1024); } while (0)
#define PG8_MMA(ai, bj, At, Bt) do { __builtin_amdgcn_s_setprio(1); _Pragma("unroll") for (int m = 0; m < 4; ++m) _Pragma("unroll") for (int n = 0; n < 2; ++n) _Pragma("unroll") for (int k = 0; k < 2; ++k) \
        acc[ai][bj][m][n] = __builtin_amdgcn_mfma_f32_16x16x32_bf16(Bt[n][k], At[m][k], acc[ai][bj][m][n], 0, 0, 0); __builtin_amdgcn_s_setprio(0); } while (0)
#define PG8_WAIT_V(n) asm volatile("s_waitcnt vmcnt(" #n ")" ::: "memory")
#define PG8_WAIT_L(n) asm volatile("s_waitcnt lgkmcnt(" #n ")" ::: "memory")
#define PG8_BAR __builtin_amdgcn_s_barrier()
#define PG8_SCHED __builtin_amdgcn_sched_barrier(0)
    Unit cur, nxt; int ui = 0;
    if (!S.next(0, cur)) return;
    f32x4 acc[2][2][4][2];
#pragma unroll
    for (int a = 0; a < 2; ++a)
#pragma unroll
        for (int b = 0; b < 2; ++b)
#pragma unroll
            for (int m = 0; m < 4; ++m)
#pragma unroll
                for (int n = 0; n < 2; ++n) acc[a][b][m][n] = (f32x4){0.f, 0.f, 0.f, 0.f};
    bf16x8 At[4][2], B0[2][2], B1[2][2];
    const char* cA = (const char*)(cur.g ? g.A1 : g.A0) + (size_t)cur.pm * tstep; const char* cB = (const char*)(cur.g ? g.B1 : g.B0) + (size_t)cur.pn * tstep;
    PG8_STAGE(PG8_SB(0, 0), cB, voffB); PG8_STAGE(PG8_SB(0, 1), cB + hstep, voffB); PG8_STAGE(PG8_SA(0, 0), cA, voffA); PG8_STAGE(PG8_SA(0, 1), cA + hstep, voffA);
    if (wr == 1) PG8_BAR;
    PG8_WAIT_V(2); PG8_BAR;
    PG8_STAGE(PG8_SB(1, 0), cB + kstep, voffB); PG8_STAGE(PG8_SA(1, 0), cA + kstep, voffA); PG8_STAGE(PG8_SB(1, 1), cB + hstep + kstep, voffB);
    PG8_WAIT_V(6); PG8_BAR;
    for (;;) {
        const bool has_next = S.next(ui + 1, nxt);
        const char* nA = has_next ? (const char*)(nxt.g ? g.A1 : g.A0) + (size_t)nxt.pm * tstep : cA; const char* nB = has_next ? (const char*)(nxt.g ? g.B1 : g.B0) + (size_t)nxt.pn * tstep : cB;
        for (int t = 0; t < nt; t += 2) {
            const bool last = (t == nt - 2);
            const char* a1 = cA + (size_t)(t + 1) * kstep;
            const char* a2 = last ? nA : cA + (size_t)(t + 2) * kstep; const char* b2 = last ? nB : cB + (size_t)(t + 2) * kstep;
            const char* a3 = a2 + kstep; const char* b3 = b2 + kstep;
            PG8_LDB(B0, 0, 0); PG8_LDB(B1, 0, 1); PG8_SCHED; PG8_LDA(At, 0, 0); PG8_STAGE(PG8_SA(1, 1), a1 + hstep, voffA);
            PG8_WAIT_V(8); PG8_WAIT_L(0); PG8_BAR; PG8_MMA(0, 0, At, B0); PG8_MMA(0, 1, At, B1); PG8_BAR; PG8_SCHED;
            PG8_LDA(At, 0, 1); PG8_STAGE(PG8_SB(0, 0), b2, voffB); PG8_STAGE(PG8_SB(0, 1), b2 + hstep, voffB); PG8_STAGE(PG8_SA(0, 0), a2, voffA);
            PG8_WAIT_V(8); PG8_WAIT_L(0); PG8_BAR; PG8_MMA(1, 0, At, B0); PG8_MMA(1, 1, At, B1); PG8_BAR; PG8_SCHED;
            PG8_LDB(B0, 1, 0); PG8_LDB(B1, 1, 1); PG8_SCHED; PG8_LDA(At, 1, 0); PG8_STAGE(PG8_SA(0, 1), a2 + hstep, voffA);
            PG8_WAIT_V(8); PG8_WAIT_L(0); PG8_BAR; PG8_MMA(0, 0, At, B0); PG8_MMA(0, 1, At, B1); PG8_BAR; PG8_SCHED;
            PG8_LDA(At, 1, 1); PG8_STAGE(PG8_SB(1, 0), b3, voffB); PG8_STAGE(PG8_SB(1, 1), b3 + hstep, voffB); PG8_STAGE(PG8_SA(1, 0), a3, voffA);
            PG8_WAIT_V(8); PG8_WAIT_L(0); PG8_BAR; PG8_MMA(1, 0, At, B0); PG8_MMA(1, 1, At, B1); PG8_BAR; PG8_SCHED;
        }
        if (wr == 0) PG8_BAR;
        E(acc, cur, wr, wc, fr, fq);
        if (!has_next) break;
        if (!(Epi::CHAIN && cur.g == 0))
#pragma unroll
        for (int a = 0; a < 2; ++a)
#pragma unroll
            for (int b = 0; b < 2; ++b)
#pragma unroll
                for (int m = 0; m < 4; ++m)
#pragma unroll
                    for (int n = 0; n < 2; ++n) acc[a][b][m][n] = (f32x4){0.f, 0.f, 0.f, 0.f};
        cur = nxt; cA = nA; cB = nB; ++ui;
        if (wr == 1) PG8_BAR;
    }
    PG8_WAIT_V(0);
    PG8_BAR;
#undef PG8_SA
#undef PG8_SB
#undef PG8_STAGE
#undef PG8_LDA
#undef PG8_LDB
#undef PG8_MMA
#undef PG8_WAIT_V
#undef PG8_WAIT_L
#undef PG8_BAR
#undef PG8_SCHED
}
}

constexpr size_t MiB = 1u << 20;
constexpr size_t WS_CTL = 0;
constexpr size_t WS_WIN = 2 * MiB, WS_WPW = 13 * MiB, WS_WO = 15 * MiB, WS_WOUT = 17 * MiB, WS_WQ = 19 * MiB, WS_SK = 23 * MiB;
constexpr size_t WS_EU = 24 * MiB, WS_EV = 40 * MiB, WS_ESC = 56 * MiB;
constexpr size_t WS_XN = 88 * MiB, WS_U = 152 * MiB;
constexpr size_t WS_MG = 88 * MiB, WS_XG2 = 152 * MiB;
constexpr size_t WS_G = 216 * MiB;
constexpr size_t WS_QP = 216 * MiB;
constexpr size_t WS_Q = 344 * MiB, WS_K = 408 * MiB, WS_V = 424 * MiB;
constexpr size_t WS_IDX = 344 * MiB, WS_GATE = 360 * MiB;
constexpr size_t WS_CA = 440 * MiB;
constexpr size_t WS_END = 504 * MiB;
constexpr int LDS_BYTES = 147456;
constexpr int MISC_OFF = 131072 + 8192;
constexpr int CW_BAR = 4096;
constexpr size_t CTL_ZERO_BYTES = 65536;

struct Args { const float* in[17]; float* out; unsigned char* ws; int ph_lo, ph_hi; };

struct EpiInProj {
    static constexpr bool PERM = true, CHAIN = false;
    bf16 *U, *Q, *K, *V, *G;
    __device__ __forceinline__ void operator()(f32x4 (&acc)[2][2][4][2], const pg8::Unit& u, int wr, int wc, int fr, int fq) const {
        const int row0 = u.pm * 256 + wr * 64 + fr; const int cw = wc * 32 + 8 * fq;
        if (u.pn < 8) {
#pragma unroll
            for (int ai = 0; ai < 2; ++ai)
#pragma unroll
                for (int m = 0; m < 4; ++m) { const size_t row = (size_t)(row0 + ai * 128 + m * 16);
                    f32x4 a0 = acc[ai][0][m][0], a1 = acc[ai][0][m][1], b0 = acc[ai][1][m][0], b1 = acc[ai][1][m][1];
                    v4u w; w.x = pk2(a0[0] * sigmoidf_(b0[0]), a0[1] * sigmoidf_(b0[1])); w.y = pk2(a0[2] * sigmoidf_(b0[2]), a0[3] * sigmoidf_(b0[3]));
                    w.z = pk2(a1[0] * sigmoidf_(b1[0]), a1[1] * sigmoidf_(b1[1])); w.w = pk2(a1[2] * sigmoidf_(b1[2]), a1[3] * sigmoidf_(b1[3]));
                    *(v4u*)(U + row * 1024 + u.pn * 128 + cw) = w; }
        } else if (u.pn >= 14) {
            const int p = u.pn - 14; unsigned char* G8 = (unsigned char*)G;
#pragma unroll
            for (int ai = 0; ai < 2; ++ai)
#pragma unroll
                for (int m = 0; m < 4; ++m) { unsigned char* rowp = G8 + (size_t)(row0 + ai * 128 + m * 16) * 2048 + (size_t)(p * 128 + cw) * 2;
                    v4u w = {0u, 0u, 0u, 0u};
#pragma unroll
                    for (int j = 0; j < 4; ++j) { w.x = __builtin_amdgcn_cvt_pk_u8_f32(sigmoidf_(acc[ai][0][m][0][j]) * 255.0f, j, w.x); w.y = __builtin_amdgcn_cvt_pk_u8_f32(sigmoidf_(acc[ai][0][m][1][j]) * 255.0f, j, w.y);
                        w.z = __builtin_amdgcn_cvt_pk_u8_f32(sigmoidf_(acc[ai][1][m][0][j]) * 255.0f, j, w.z); w.w = __builtin_amdgcn_cvt_pk_u8_f32(sigmoidf_(acc[ai][1][m][1][j]) * 255.0f, j, w.w); }
                    *(v4u*)rowp = w; }
        } else {
            bf16* base; int ld, col0; float sc = 1.0f;
            if (u.pn < 12) { base = Q; ld = 1024; col0 = (u.pn - 8) * 256; sc = QSCALE; }
            else if (u.pn == 12) { base = K; ld = 256; col0 = 0; }
            else { base = V; ld = 256; col0 = 0; }
#pragma unroll
            for (int ai = 0; ai < 2; ++ai)
#pragma unroll
                for (int m = 0; m < 4; ++m) { bf16* rowp = base + (size_t)(row0 + ai * 128 + m * 16) * ld + col0 + cw;
#pragma unroll
                    for (int bj = 0; bj < 2; ++bj) { f32x4 v0 = acc[ai][bj][m][0] * sc, v1 = acc[ai][bj][m][1] * sc;
                        v4u w; w.x = pk2(v0[0], v0[1]); w.y = pk2(v0[2], v0[3]); w.z = pk2(v1[0], v1[1]); w.w = pk2(v1[2], v1[3]);
                        *(v4u*)(rowp + bj * 128) = w; } }
        }
    }
};
struct EpiMerge {
    static constexpr bool PERM = true, CHAIN = true;
    const bf16* G; bf16* MG;
    __device__ __forceinline__ void operator()(f32x4 (&acc)[2][2][4][2], const pg8::Unit& u, int wr, int wc, int fr, int fq) const {
        const int row0 = u.pm * 256 + wr * 64 + fr; const int col0 = u.pn * 256 + wc * 32 + 8 * fq;
        const unsigned char* G8 = (const unsigned char*)G;
#pragma unroll
        for (int ai = 0; ai < 2; ++ai) { const size_t row = (size_t)(row0 + ai * 128);
            const unsigned char* gp = G8 + row * 2048 + (size_t)col0 * 2; bf16* mp = MG + row * 1024 + col0;
            v4u gw[4][2];
#pragma unroll
            for (int m = 0; m < 4; ++m)
#pragma unroll
                for (int bj = 0; bj < 2; ++bj) gw[m][bj] = *(const v4u*)(gp + (size_t)(m * 16) * 2048 + bj * 256);
#pragma unroll
            for (int m = 0; m < 4; ++m)
#pragma unroll
                for (int bj = 0; bj < 2; ++bj) { const v4u g4 = gw[m][bj]; f32x4 v0 = acc[ai][bj][m][0], v1 = acc[ai][bj][m][1];
                    float fb[8];
#pragma unroll
                    for (int j = 0; j < 4; ++j) { fb[j] = fmaxf((float)((g4.z >> (8 * j)) & 0xffu), 1.0f); fb[4 + j] = fmaxf((float)((g4.w >> (8 * j)) & 0xffu), 1.0f); }
                    if (u.g) {
#pragma unroll
                        for (int j = 0; j < 4; ++j) { v0[j] *= fb[j] * (1.0f / 255.0f); v1[j] *= fb[4 + j] * (1.0f / 255.0f); }
                        v4u w; w.x = pk2(v0[0], v0[1]); w.y = pk2(v0[2], v0[3]); w.z = pk2(v1[0], v1[1]); w.w = pk2(v1[2], v1[3]); *(v4u*)(mp + (size_t)(m * 16) * 1024 + bj * 128) = w;
                    } else {
#pragma unroll
                        for (int j = 0; j < 4; ++j) { v0[j] *= (float)((g4.x >> (8 * j)) & 0xffu) * __builtin_amdgcn_rcpf(fb[j]); v1[j] *= (float)((g4.y >> (8 * j)) & 0xffu) * __builtin_amdgcn_rcpf(fb[4 + j]); }
                        acc[ai][bj][m][0] = v0; acc[ai][bj][m][1] = v1; } } }
    }
};
struct EpiResid {
    static constexpr bool PERM = true, CHAIN = false;
    const float* X; bf16* XG; float* SSQ;
    __device__ __forceinline__ void operator()(f32x4 (&acc)[2][2][4][2], const pg8::Unit& u, int wr, int wc, int fr, int fq) const {
        const int row0 = u.pm * 256 + wr * 64 + fr; const int col0 = u.pn * 256 + wc * 32 + 8 * fq;
#pragma unroll
        for (int ai = 0; ai < 2; ++ai) {
            f32x4 xv[4][2][2];
#pragma unroll
            for (int m = 0; m < 4; ++m) { const size_t off = (size_t)(row0 + ai * 128 + m * 16) * 1024 + col0;
#pragma unroll
                for (int bj = 0; bj < 2; ++bj)
#pragma unroll
                    for (int n = 0; n < 2; ++n) xv[m][bj][n] = *(const f32x4*)(X + off + bj * 128 + n * 4); }
#pragma unroll
            for (int m = 0; m < 4; ++m) { const int row = row0 + ai * 128 + m * 16; const size_t off = (size_t)row * 1024 + col0; float ss = 0.f;
#pragma unroll
                for (int bj = 0; bj < 2; ++bj) { const f32x4 x0 = xv[m][bj][0] + acc[ai][bj][m][0], x1 = xv[m][bj][1] + acc[ai][bj][m][1];
                    ss += ((x0[0] * x0[0] + x0[1] * x0[1]) + (x0[2] * x0[2] + x0[3] * x0[3])) + ((x1[0] * x1[0] + x1[1] * x1[1]) + (x1[2] * x1[2] + x1[3] * x1[3]));
                    v4u w; w.x = pk2(x0[0], x0[1]); w.y = pk2(x0[2], x0[3]); w.z = pk2(x1[0], x1[1]); w.w = pk2(x1[2], x1[3]); *(v4u*)(XG + off + bj * 128) = w; }
                ss += __shfl_xor(ss, 16); ss += __shfl_xor(ss, 32);
                if (fq == 0) atomicAdd(SSQ + row, ss); }
        }
    }
};
struct EpiBf16Rs {
    static constexpr bool PERM = true, CHAIN = false;
    bf16* O; const float* SSQ;
    __device__ __forceinline__ void operator()(f32x4 (&acc)[2][2][4][2], const pg8::Unit& u, int wr, int wc, int fr, int fq) const {
        const int row0 = u.pm * 256 + wr * 64 + fr;
        float ssq[2][4];
#pragma unroll
        for (int ai = 0; ai < 2; ++ai)
#pragma unroll
            for (int m = 0; m < 4; ++m) ssq[ai][m] = SSQ[row0 + ai * 128 + m * 16];
        const int sidx = 2 * wc + (fq >> 1), hh = fq & 1;
#pragma unroll
        for (int ai = 0; ai < 2; ++ai)
#pragma unroll
            for (int m = 0; m < 4; ++m) { const int row = row0 + ai * 128 + m * 16; const int tile = row >> 5, r32 = row & 31;
                const float rs = 1.0f / sqrtf(ssq[ai][m] * (1.f / 1024.f) + EPS);
#pragma unroll
                for (int bj = 0; bj < 2; ++bj) { const f32x4 v0 = acc[ai][bj][m][0] * rs, v1 = acc[ai][bj][m][1] * rs;
                    v4u w; w.x = pk2(v0[0], v0[1]); w.y = pk2(v0[2], v0[3]); w.z = pk2(v1[0], v1[1]); w.w = pk2(v1[2], v1[3]);
                    *(v4u*)(O + ((((size_t)(tile * 8 + u.pn) * 2 + bj) * 8 + sidx) * 64 + r32 + 32 * hh) * 8) = w; } }
    }
};

__device__ __forceinline__ void p0_transpose_item(const float* W, int K, int N, bf16* WT, int dst0, LAS float* scr, int kb, int nb, int lane, const float* kscale = nullptr) {
    const int k0 = 64 * kb, n0 = 32 * nb;
#pragma unroll 8
    for (int i = 0; i < 32; ++i) { const int kk = 2 * i + (lane >> 5); float wv_ = W[(size_t)(k0 + kk) * N + n0 + (lane & 31)]; if (kscale) wv_ *= kscale[k0 + kk]; scr[kk * 33 + (lane & 31)] = wv_; }
    asm volatile("s_waitcnt lgkmcnt(0)" ::: "memory");
    const int c = lane & 7;
#pragma unroll
    for (int j = 0; j < 4; ++j) { const int n = (lane >> 3) + 8 * j; const LAS float* s = scr + (8 * c) * 33 + n;
        v4u o; o.x = pk2(s[0 * 33], s[1 * 33]); o.y = pk2(s[2 * 33], s[3 * 33]); o.z = pk2(s[4 * 33], s[5 * 33]); o.w = pk2(s[6 * 33], s[7 * 33]);
        *(v4u*)(WT + (size_t)(dst0 + n) * K + k0 + 8 * c) = o; }
    asm volatile("s_waitcnt lgkmcnt(0)" ::: "memory");
}
__device__ __forceinline__ int glu_row(int n0) {
    if (n0 < 1024) return 256 * (n0 >> 7) + (n0 & 127);
    if (n0 < 2048) { const int n1 = n0 - 1024; return 256 * (n1 >> 7) + 128 + (n1 & 127); }
    if (n0 < 3584) return n0;
    if (n0 < 4608) { const int n1 = n0 - 3584; return 3584 + 256 * (n1 >> 7) + (n1 & 127); }
    { const int n1 = n0 - 4608; return 3584 + 256 * (n1 >> 7) + 128 + (n1 & 127); }
}
__device__ __forceinline__ void cvt_stream(const float* src, bf16* dst, size_t n, size_t gtid, size_t gthreads) {
    for (size_t i = gtid * 8; i < n; i += gthreads * 8) {
        const f32x4 a = *(const f32x4*)(src + i), b = *(const f32x4*)(src + i + 4);
        v4u o; o.x = pk2(a[0], a[1]); o.y = pk2(a[2], a[3]); o.z = pk2(b[0], b[1]); o.w = pk2(b[2], b[3]);
        *(v4u*)(dst + i) = o; }
}
typedef float v16f __attribute__((ext_vector_type(16)));
typedef float v32f __attribute__((ext_vector_type(32)));
typedef unsigned v6u __attribute__((ext_vector_type(6)));
typedef __bf16 v32bf __attribute__((ext_vector_type(32)));
constexpr int E6ROW = 768, E4ROW = 512;
__device__ __forceinline__ void rows_to_fp6(const float* x2rows, unsigned char* o2rows, float* inv_scale2, int lane, const float* cscale, LAS float* scr) {
    const int c = lane & 31, hf = lane >> 5;
    { f32x4 t[8];
#pragma unroll
      for (int i = 0; i < 8; ++i) t[i] = *(const f32x4*)(x2rows + i * 256 + lane * 4);
#pragma unroll
      for (int i = 0; i < 8; ++i) { const int e = i * 256 + lane * 4; *(LAS f32x4*)((LAS unsigned char*)scr + (e >> 5) * 144 + (e & 31) * 4) = t[i]; }
      asm volatile("s_waitcnt lgkmcnt(0)" ::: "memory"); }
    const LAS f32x4* xr = (const LAS f32x4*)((LAS unsigned char*)scr + lane * 144);
    v16f a, b; float am = 0.f;
#pragma unroll
    for (int j = 0; j < 4; ++j) { f32x4 u = xr[j], w = xr[4 + j];
        if (cscale) { u = u * *(const f32x4*)(cscale + c * 32 + 4 * j); w = w * *(const f32x4*)(cscale + c * 32 + 16 + 4 * j); }
#pragma unroll
        for (int k = 0; k < 4; ++k) { am = fmaxf(am, fmaxf(fabsf(u[k]), fabsf(w[k]))); }
        a[2 * j] = u[0]; b[2 * j] = u[1]; a[2 * j + 1] = u[2]; b[2 * j + 1] = u[3];
        a[8 + 2 * j] = w[0]; b[8 + 2 * j] = w[1]; a[8 + 2 * j + 1] = w[2]; b[8 + 2 * j + 1] = w[3]; }
#pragma unroll
    for (int o = 1; o < 32; o <<= 1) am = fmaxf(am, __shfl_xor(am, o));
    am = fmaxf(am, 1e-30f);
    if (cscale) {
        const float s4 = 6.0f / am; unsigned d4[4] = {0u, 0u, 0u, 0u};
#define F4Q(i_) d4[(i_) >> 2] = __builtin_amdgcn_cvt_scalef32_pk_fp4_f32(d4[(i_) >> 2], a[i_] * s4, b[i_] * s4, 1.0f, (i_) & 3)
        F4Q(0); F4Q(1); F4Q(2); F4Q(3); F4Q(4); F4Q(5); F4Q(6); F4Q(7); F4Q(8); F4Q(9); F4Q(10); F4Q(11); F4Q(12); F4Q(13); F4Q(14); F4Q(15);
#undef F4Q
        *(v4u*)(o2rows + (size_t)hf * E4ROW + c * 16) = (v4u){d4[0], d4[1], d4[2], d4[3]};
        if (c == 0) inv_scale2[hf] = am * (1.0f / 6.0f);
        asm volatile("s_waitcnt lgkmcnt(0)" ::: "memory");
        return;
    }
    const float sc = 7.5f / am;
    a = a * sc; b = b * sc;
    const v6u d = __builtin_amdgcn_cvt_scalef32_2xpk16_fp6_f32(a, b, 1.0f);
    unsigned char* ob = o2rows + (size_t)hf * E6ROW + c * 24;
    *(v2u*)(ob) = (v2u){d[0], d[1]}; *(v2u*)(ob + 8) = (v2u){d[2], d[3]}; *(v2u*)(ob + 16) = (v2u){d[4], d[5]};
    if (c == 0) inv_scale2[hf] = am * (1.0f / 7.5f);
    asm volatile("s_waitcnt lgkmcnt(0)" ::: "memory");
}
__device__ __forceinline__ void rms_row_to_bf16(const float* xrow, const float* g, bf16* orow, int lane) {
    const f32x4* xr = (const f32x4*)xrow + lane; const f32x4* gr = (const f32x4*)g + lane;
    f32x4 v[4]; float s = 0.f;
#pragma unroll
    for (int j = 0; j < 4; ++j) { v[j] = xr[64 * j]; s += (v[j][0] * v[j][0] + v[j][1] * v[j][1]) + (v[j][2] * v[j][2] + v[j][3] * v[j][3]); }
    const float rs = 1.0f / sqrtf(wave_sum(s) * (1.f / 1024.f) + EPS);
    v2u* o8 = (v2u*)orow + lane;
#pragma unroll
    for (int j = 0; j < 4; ++j) { const f32x4 gg = gr[64 * j]; v2u o; o.x = pk2(v[j][0] * rs * gg[0], v[j][1] * rs * gg[1]); o.y = pk2(v[j][2] * rs * gg[2], v[j][3] * rs * gg[3]); o8[64 * j] = o; }
}

__device__ __forceinline__ void conv_phase(LAS unsigned char* lds, const bf16* U, bf16* CA, const float* dw_w, const float* dw_b, const float* ln_g, const float* ln_b, int vcu, int G) {
    const int tid = opaque_tid(), lane = tid & 63, wave = tid >> 6;
    const int c0 = 2 * tid;
    constexpr int TT = 32, ROWS = TT + 2 * CPAD, TILE_B = ROWS * 2048;
    f32x2 wv[CK];
#pragma unroll
    for (int j = 0; j < CK; ++j) wv[j] = *(const f32x2*)(dw_w + j * 1024 + c0);
    const f32x2 bi = *(const f32x2*)(dw_b + c0), lg = *(const f32x2*)(ln_g + c0), lb = *(const f32x2*)(ln_b + c0);
    LAS float* red = (LAS float*)(lds + TILE_B);
    LAS float* stat = red + 512;
    const LAS unsigned char* xb = lds + c0 * 2;
    for (int item = vcu; item < BATCH * (SEQ / TT); item += G) {
        const int b = item / (SEQ / TT), t0 = (item % (SEQ / TT)) * TT;
#pragma unroll
        for (int hb = 0; hb < 2; ++hb) {
            v4u val[8];
#pragma unroll
            for (int it = 0; it < 8; ++it) { const int i = tid + (hb * 8 + it) * NTHREADS; const int row = i >> 7, ch = i & 127, tt = t0 - CPAD + row; const bool ok = (i < ROWS * 128) && (tt >= 0) && (tt < SEQ);
                val[it] = *(const v4u*)(U + ((size_t)b * SEQ + (ok ? tt : t0)) * 1024 + ch * 8); if (!ok) val[it] = (v4u){0u, 0u, 0u, 0u}; }
#pragma unroll
            for (int it = 0; it < 8; ++it) { const int i = tid + (hb * 8 + it) * NTHREADS; const int row = i >> 7, ch = i & 127; if (i < ROWS * 128) *(LAS v4u*)(lds + row * 2048 + ch * 16) = val[it]; }
        }
        __syncthreads();
#pragma unroll 1
        for (int rd = 0; rd < 2; ++rd) {
            const LAS unsigned char* xr = xb + rd * 16 * 2048;
            float ac0[16], ac1[16];
#pragma unroll
            for (int t = 0; t < 16; ++t) { ac0[t] = bi[0]; ac1[t] = bi[1]; }
#pragma clang loop unroll(full)
            for (int r = 0; r < 16 + 2 * CPAD; ++r) {
                const unsigned raw = *(const LAS unsigned*)(xr + r * 2048); const float x0 = bflo(raw), x1 = bfhi(raw);
#pragma clang loop unroll(full)
                for (int j = 0; j < CK; ++j) { const int t = r - j; if (t >= 0 && t < 16) { fmac_s(ac0[t], wv[j][0], x0); fmac_s(ac1[t], wv[j][1], x1); } }
            }
            float v[32];
#pragma unroll
            for (int t = 0; t < 16; ++t) { v[2 * t] = ac0[t] + ac1[t]; v[2 * t + 1] = ac0[t] * ac0[t] + ac1[t] * ac1[t]; }
#pragma unroll
            for (int o = 32, n = 16; n >= 1; o >>= 1, n >>= 1) { const bool hi = (lane & o) != 0;
#pragma unroll
                for (int k = 0; k < n; ++k) { const float a = v[k], bb = v[k + n]; const float send = hi ? a : bb, keep = hi ? bb : a; v[k] = keep + __shfl_xor(send, o); } }
            const float rr = v[0] + __shfl_xor(v[0], 1);
            if ((lane & 1) == 0) red[wave * 32 + (lane >> 1)] = rr;
            __syncthreads();
            if (tid < 16) { float s1 = 0.f, s2 = 0.f;
#pragma unroll
                for (int w = 0; w < 8; ++w) { s1 += red[w * 32 + 2 * tid]; s2 += red[w * 32 + 2 * tid + 1]; }
                const float mean = s1 * (1.f / 1024.f); const float var = s2 * (1.f / 1024.f) - mean * mean;
                stat[2 * tid] = mean; stat[2 * tid + 1] = 1.0f / sqrtf(var + EPS); }
            __syncthreads();
            bf16* Cb = CA + ((size_t)b * SEQ + t0 + 16 * rd) * 1024 + c0;
#pragma unroll
            for (int t = 0; t < 16; ++t) { const float mean = stat[2 * t], rstd = stat[2 * t + 1];
                float y0 = (ac0[t] - mean) * rstd * lg[0] + lb[0], y1 = (ac1[t] - mean) * rstd * lg[1] + lb[1];
                y0 = y0 * sigmoidf_(y0); y1 = y1 * sigmoidf_(y1);
                *(unsigned*)(Cb + (size_t)t * 1024) = pk2(y0, y1); }
            __syncthreads();
        }
    }
}

namespace att {
typedef short bf16x8 __attribute__((ext_vector_type(8)));
typedef short s16x4 __attribute__((ext_vector_type(4)));
typedef float f32x16 __attribute__((ext_vector_type(16)));
constexpr int KP = 144, SPAN = 320, VOFF = SPAN * KP, WSTG = 2 * SPAN * KP;
__device__ __forceinline__ s16x4 vtr(const LAS unsigned char* p) { return __builtin_bit_cast(s16x4, __builtin_amdgcn_ds_read_tr16_b64_v4i16((LAS s16x4*)p)); }
__device__ __forceinline__ void attn_phase(LAS unsigned char* lds, const bf16* Q, const bf16* K, const bf16* V, bf16* AO, const float* sink, int vcu, int G) {
    const int tid = opaque_tid(), lane = tid & 63, wave = __builtin_amdgcn_readfirstlane(tid >> 6), r32 = lane & 31, hh = lane >> 5;
    v4u kreg[5], vreg[5];
#define ATT_STAGE_LOAD(UNIT) do { const int qb_ = (UNIT) % (SEQ / 64), kvh_ = ((UNIT) / (SEQ / 64)) % NKV, b_ = (UNIT) / ((SEQ / 64) * NKV); const int t0_ = qb_ * 64, s0_ = t0_ - WIN; \
        _Pragma("unroll") for (int it = 0; it < 5; ++it) { const int i = tid + it * NTHREADS; const int row = i >> 3, ch = i & 7, sp = s0_ + row; const bool ok = (sp >= 0) && (sp < SEQ); \
            const size_t go = ((size_t)b_ * SEQ + (ok ? sp : t0_)) * KVD + kvh_ * 64 + ch * 8; kreg[it] = *(const v4u*)(K + go); vreg[it] = *(const v4u*)(V + go); } } while (0)
    if (vcu < BATCH * NKV * (SEQ / 64)) ATT_STAGE_LOAD(vcu);
    for (int unit = vcu; unit < BATCH * NKV * (SEQ / 64); unit += G) {
        const int qb = unit % (SEQ / 64), kvh = (unit / (SEQ / 64)) % NKV, b = unit / ((SEQ / 64) * NKV);
        const int t0 = qb * 64;
#pragma unroll
        for (int it = 0; it < 5; ++it) { const int i = tid + it * NTHREADS; const int row = i >> 3, ch = i & 7;
            *(LAS v4u*)(lds + row * KP + ch * 16) = kreg[it]; *(LAS v4u*)(lds + VOFF + row * KP + ch * 16) = vreg[it]; }
        if (unit + G < BATCH * NKV * (SEQ / 64)) ATT_STAGE_LOAD(unit + G);
        __syncthreads();
        {
            const int head = kvh * 4 + (wave >> 1), qoff = (wave & 1) * 32, q0 = t0 + qoff;
            const float slope2 = exp2f(-0.5f * (float)(head + 1)) * LOG2E, sink2 = sink[head] * LOG2E;
            LAS unsigned char* stg = lds + WSTG + wave * (32 * KP);
            const size_t qbase = ((size_t)b * SEQ + q0) * 1024 + head * 64;
#pragma unroll
            for (int i = 0; i < 4; ++i) { const int id = i * 64 + lane, row = id >> 3, ch = id & 7; *(LAS v4u*)(stg + row * KP + ch * 16) = *(const v4u*)(Q + qbase + (size_t)row * 1024 + ch * 8); }
            bf16x8 qf[4];
#pragma unroll
            for (int s = 0; s < 4; ++s) qf[s] = *(const LAS bf16x8*)(stg + r32 * KP + (2 * s + hh) * 16);
            float m = sink2, l = (hh == 0) ? 1.0f : 0.0f;
            f32x16 O0, O1, negm;
#pragma unroll
            for (int r = 0; r < 16; ++r) { O0[r] = 0.f; O1[r] = 0.f; negm[r] = -sink2; }
            const int q4 = (lane & 15) >> 2, p4 = lane & 3, g16 = (lane >> 4) & 1;
#pragma unroll 1
            for (int it = 0; it < 9; ++it) {
                const int j = (it & 1) ? 4 - ((it + 1) >> 1) : 4 + (it >> 1);
                const int kt0 = q0 - WIN + 32 * j;
                if (kt0 < 0 || kt0 >= SEQ) continue;
                const int lrow0 = qoff + 32 * j;
                f32x16 sa = negm;
#pragma unroll
                for (int s = 0; s < 4; ++s) { const bf16x8 kf = *(const LAS bf16x8*)(lds + (lrow0 + r32) * KP + 32 * s + 16 * hh); sa = __builtin_amdgcn_mfma_f32_32x32x16_bf16(kf, qf[s], sa, 0, 0, 0); }
                const float cf = (float)(WIN - 32 * j + r32 - 4 * hh);
                if (j == 0 || j == 8) {
#pragma unroll
                    for (int r = 0; r < 16; ++r) { const float d = cf - (float)((r & 3) + 8 * (r >> 2)); float v = fmaf(-slope2, fabsf(d), sa[r]); v = (fabsf(d) > (float)WIN) ? -1e30f : v; sa[r] = v; }
                } else {
#pragma unroll
                    for (int r = 0; r < 16; ++r) { const float d = cf - (float)((r & 3) + 8 * (r >> 2)); sa[r] = fmaf(-slope2, fabsf(d), sa[r]); }
                }
                float tmax = fmaxf(fmaxf(sa[0], sa[1]), sa[2]);
#pragma unroll
                for (int r = 3; r < 15; r += 2) tmax = fmaxf(fmaxf(tmax, sa[r]), sa[r + 1]);
                tmax = fmaxf(tmax, sa[15]);
                if (__any(tmax > 16.0f)) {
                    tmax = fmaxf(tmax, __shfl_xor(tmax, 32));
                    const float dl = fmaxf(tmax, 0.f), alpha = __builtin_amdgcn_exp2f(-dl); m += dl; l *= alpha;
#pragma unroll
                    for (int r = 0; r < 16; ++r) { O0[r] *= alpha; O1[r] *= alpha; sa[r] -= dl; negm[r] = -m; }
                }
                float ls0 = 0.f, ls1 = 0.f;
#pragma unroll
                for (int r = 0; r < 16; r += 2) { sa[r] = __builtin_amdgcn_exp2f(sa[r]); sa[r + 1] = __builtin_amdgcn_exp2f(sa[r + 1]); ls0 += sa[r]; ls1 += sa[r + 1]; }
                l += ls0 + ls1;
                v4u pw0, pw1;
                pw0.x = pk2(sa[0], sa[1]); pw0.y = pk2(sa[2], sa[3]); pw0.z = pk2(sa[4], sa[5]); pw0.w = pk2(sa[6], sa[7]);
                pw1.x = pk2(sa[8], sa[9]); pw1.y = pk2(sa[10], sa[11]); pw1.z = pk2(sa[12], sa[13]); pw1.w = pk2(sa[14], sa[15]);
                const bf16x8 pb0 = __builtin_bit_cast(bf16x8, pw0), pb1 = __builtin_bit_cast(bf16x8, pw1);
                const LAS unsigned char* vb = lds + VOFF + (lrow0 + 4 * hh + q4) * KP + (16 * g16 + 4 * p4) * 2;
#pragma unroll
                for (int s2 = 0; s2 < 2; ++s2) {
                    const s16x4 a0l = vtr(vb + (16 * s2) * KP), a0h = vtr(vb + (16 * s2 + 8) * KP);
                    const s16x4 a1l = vtr(vb + (16 * s2) * KP + 64), a1h = vtr(vb + (16 * s2 + 8) * KP + 64);
                    const bf16x8 A0 = (bf16x8){a0l[0], a0l[1], a0l[2], a0l[3], a0h[0], a0h[1], a0h[2], a0h[3]};
                    const bf16x8 A1 = (bf16x8){a1l[0], a1l[1], a1l[2], a1l[3], a1h[0], a1h[1], a1h[2], a1h[3]};
                    O0 = __builtin_amdgcn_mfma_f32_32x32x16_bf16(A0, s2 ? pb1 : pb0, O0, 0, 0, 0);
                    O1 = __builtin_amdgcn_mfma_f32_32x32x16_bf16(A1, s2 ? pb1 : pb0, O1, 0, 0, 0);
                }
            }
            const float inv = 1.0f / (l + __shfl_xor(l, 32));
#pragma unroll
            for (int g4 = 0; g4 < 4; ++g4) { v2u w0, w1;
                w0.x = pk2(O0[4 * g4] * inv, O0[4 * g4 + 1] * inv); w0.y = pk2(O0[4 * g4 + 2] * inv, O0[4 * g4 + 3] * inv);
                w1.x = pk2(O1[4 * g4] * inv, O1[4 * g4 + 1] * inv); w1.y = pk2(O1[4 * g4 + 2] * inv, O1[4 * g4 + 3] * inv);
                *(LAS v2u*)(stg + r32 * KP + (8 * g4 + 4 * hh) * 2) = w0; *(LAS v2u*)(stg + r32 * KP + (32 + 8 * g4 + 4 * hh) * 2) = w1; }
#pragma unroll
            for (int i = 0; i < 4; ++i) { const int id = i * 64 + lane, row = id >> 3, ch = id & 7; *(v4u*)(AO + qbase + (size_t)row * 1024 + ch * 8) = *(const LAS v4u*)(stg + row * KP + ch * 16); }
        }
        __syncthreads();
    }
}
#undef ATT_STAGE_LOAD
}

namespace tk {
typedef short bf16x8 __attribute__((ext_vector_type(8)));
typedef float f32x16 __attribute__((ext_vector_type(16)));
constexpr int SKP = 272;
#define TK_CAND50(X) X(0,0,0) X(1,0,1) X(2,0,2) X(3,0,3) X(4,0,4) X(5,0,5) X(6,0,6) X(7,0,7) X(8,0,8) X(9,0,9) X(10,0,10) X(11,0,11) X(12,0,12) X(13,0,13) X(14,0,14) X(15,0,15) X(16,1,0) X(17,1,1) X(18,1,2) X(19,1,3) X(20,1,4) X(21,1,5) X(22,1,6) X(23,1,7) X(24,2,0) X(25,2,1) X(26,2,2) X(27,2,3) X(28,2,4) X(29,3,0) X(30,3,1) X(31,3,2) X(32,3,3) X(33,4,0) X(34,4,1) X(35,4,2) X(36,5,0) X(37,5,1) X(38,6,0) X(39,6,1) X(40,7,0) X(41,7,1) X(42,8,0) X(43,9,0) X(44,10,0) X(45,11,0) X(46,12,0) X(47,13,0) X(48,14,0) X(49,15,0)
#define TK_PAIR25(X) X(0,0,0,2,1) X(1,0,1,2,2) X(2,0,2,2,3) X(3,0,3,2,4) X(4,0,4,3,0) X(5,0,5,3,1) X(6,0,6,3,2) X(7,0,7,3,3) X(8,0,8,4,0) X(9,0,9,4,1) X(10,0,10,4,2) X(11,0,11,5,0) X(12,0,12,5,1) X(13,0,13,6,0) X(14,0,14,6,1) X(15,0,15,7,0) X(16,1,0,7,1) X(17,1,1,8,0) X(18,1,2,9,0) X(19,1,3,10,0) X(20,1,4,11,0) X(21,1,5,12,0) X(22,1,6,13,0) X(23,1,7,14,0) X(24,2,0,15,0)
template <int OFF> __device__ __forceinline__ void sort16(float (&v)[64]) {
#pragma unroll
    for (int k = 2; k <= 16; k <<= 1)
#pragma unroll
        for (int j = k >> 1; j > 0; j >>= 1)
#pragma unroll
            for (int i = 0; i < 16; ++i) { const int l = i ^ j; if (l > i) { const float a = v[OFF + i], b = v[OFF + l]; const float hi = fmaxf(a, b), lo = fminf(a, b);
                if ((i & k) == 0) { v[OFF + i] = hi; v[OFF + l] = lo; } else { v[OFF + i] = lo; v[OFF + l] = hi; } } }
}
template <int OFF> __device__ __forceinline__ void merge16(float (&v)[64]) {
#pragma unroll
    for (int j = 8; j > 0; j >>= 1)
#pragma unroll
        for (int i = 0; i < 16; ++i) { const int l = i ^ j; if (l > i) { const float a = v[OFF + i], b = v[OFF + l]; v[OFF + i] = fmaxf(a, b); v[OFF + l] = fminf(a, b); } }
}
template <int A, int B> __device__ __forceinline__ void top16_merge(float (&v)[64]) {
#pragma unroll
    for (int i = 0; i < 16; ++i) v[A + i] = fmaxf(v[A + i], v[B + 15 - i]);
    merge16<A>(v);
}
__device__ __forceinline__ void top16_of_64(float (&v)[64]) {
    sort16<0>(v); sort16<16>(v); sort16<32>(v); sort16<48>(v);
    top16_merge<0, 16>(v); top16_merge<32, 48>(v); top16_merge<0, 32>(v);
}
__device__ __forceinline__ void topk_phase(LAS unsigned char* lds, const bf16* QP, const bf16* SKb, int* IDX, float* GATE, int vcu, int G) {
    const int tid = opaque_tid(), lane = tid & 63, wave = __builtin_amdgcn_readfirstlane(tid >> 6), r32 = lane & 31, hh = lane >> 5;
    for (int i = tid; i < 256 * 16; i += NTHREADS) { const int row = i >> 4, ch = i & 15; *(LAS v4u*)(lds + row * SKP + ch * 16) = *(const v4u*)(SKb + row * 128 + ch * 8); }
    __syncthreads();
    for (int unit = vcu * NWAVES + wave; unit < (M / 32) * PHD; unit += G * NWAVES) {
        const int tile = unit >> 3, h = unit & 7; const int tok = tile * 32 + r32;
        float L[2][16];
#pragma unroll
        for (int p = 0; p < 2; ++p) {
            bf16x8 qf[8];
#pragma unroll
            for (int sidx = 0; sidx < 8; ++sidx) qf[sidx] = *(const bf16x8*)(QP + ((((size_t)(tile * 8 + h) * 2 + p) * 8 + sidx) * 64 + lane) * 8);
            float v[64];
#define TK_KT(kt) { f32x16 acc; \
                _Pragma("unroll") for (int r = 0; r < 16; ++r) acc[r] = 0.f; \
                _Pragma("unroll") for (int sidx = 0; sidx < 8; ++sidx) { const bf16x8 kf = *(const LAS bf16x8*)(lds + (p * 128 + 32 * kt + r32) * SKP + 32 * sidx + 16 * hh); acc = __builtin_amdgcn_mfma_f32_32x32x16_bf16(kf, qf[sidx], acc, 0, 0, 0); } \
                _Pragma("unroll") for (int r = 0; r < 16; ++r) { const unsigned kidx = (unsigned)(32 * kt + (r & 3) + 8 * (r >> 2)); v[16 * kt + r] = __uint_as_float(((__float_as_uint(acc[r]) & 0xffffff80u) | (unsigned)(hh << 2)) | kidx); } \
                sort16<16 * kt>(v); __builtin_amdgcn_sched_barrier(0); }
            TK_KT(0) TK_KT(1) top16_merge<0, 16>(v); __builtin_amdgcn_sched_barrier(0);
            TK_KT(2) TK_KT(3) top16_merge<32, 48>(v); __builtin_amdgcn_sched_barrier(0);
            top16_merge<0, 32>(v); __builtin_amdgcn_sched_barrier(0);
#undef TK_KT
            float t[16];
#pragma unroll
            for (int i = 0; i < 16; ++i) t[i] = __shfl_xor(v[15 - i], 32);
#pragma unroll
            for (int i = 0; i < 16; ++i) v[i] = fmaxf(v[i], t[i]);
            merge16<0>(v);
#pragma unroll
            for (int i = 0; i < 16; ++i) L[p][i] = v[i];
        }
        float sm[25];
#define X(c, i0, j0, i1, j1) { const float s0 = L[0][i0] + L[1][j0], s1 = L[0][i1] + L[1][j1]; sm[c] = hh ? s1 : s0; }
        TK_PAIR25(X)
#undef X
        float v[64];
#pragma unroll
        for (int c = 0; c < 25; ++c) v[c] = sm[c];
#pragma unroll
        for (int c = 25; c < 32; ++c) v[c] = -3.0e38f;
        sort16<0>(v); sort16<16>(v); top16_merge<0, 16>(v);
        float T;
        { float t[16];
#pragma unroll
          for (int i = 0; i < 16; ++i) t[i] = __shfl_xor(v[15 - i], 32);
#pragma unroll
          for (int i = 0; i < 16; ++i) t[i] = fmaxf(v[i], t[i]);
          T = fminf(fminf(t[0], t[1]), t[2]);
#pragma unroll
          for (int i = 3; i < 15; i += 2) T = fminf(fminf(T, t[i]), t[i + 1]);
          T = fminf(T, t[15]); }
        const float smax = L[0][0] + L[1][0];
        unsigned ia[16], ib[16];
#pragma unroll
        for (int i = 0; i < 16; ++i) { ia[i] = (__float_as_uint(L[0][i]) & 127u) << 7; ib[i] = __float_as_uint(L[1][i]) & 127u; }
        float pe[25]; float den = 0.f; int cnt = 0;
#pragma unroll
        for (int c = 0; c < 25; ++c) { const bool sel = sm[c] >= T; const float e = __builtin_amdgcn_exp2f((sm[c] - smax) * LOG2E); pe[c] = e; den += sel ? e : 0.f; cnt += sel ? 1 : 0; }
        den += __shfl_xor(den, 32);
        const int ocnt = __shfl_xor(cnt, 32);
        int pos = hh ? ocnt : 0;
        const float inv = 1.0f / den;
        LAS float* lg = (LAS float*)(lds + 256 * SKP + wave * 4096); LAS int* li = (LAS int*)(lg + 512);
#define X(c, i0, j0, i1, j1) { const unsigned e0 = ia[i0] + ib[j0], e1 = ia[i1] + ib[j1]; const unsigned em = hh ? e1 : e0; \
            const bool sel = sm[c] >= T; \
            if (sel && pos < 16) { lg[r32 * 16 + pos] = pe[c] * inv; li[r32 * 16 + pos] = (int)em; } \
            pos += sel ? 1 : 0; }
        TK_PAIR25(X)
#undef X
        asm volatile("s_waitcnt lgkmcnt(0)" ::: "memory");
#pragma unroll
        for (int rr = 0; rr < 2; ++rr) { const int tl = rr * 16 + (lane >> 2), pg = lane & 3; const size_t ob = (size_t)(tile * 32 + tl) * 128 + h * 16 + 4 * pg;
            *(f32x4*)(GATE + ob) = *(const LAS f32x4*)(lg + tl * 16 + 4 * pg); *(v4u*)(IDX + ob) = *(const LAS v4u*)(li + tl * 16 + 4 * pg); }
        asm volatile("s_waitcnt lgkmcnt(0)" ::: "memory");
    }
}
}

__device__ __forceinline__ float dot2bf(unsigned a, unsigned b, float c) { return __builtin_amdgcn_fdot2_f32_bf16(__builtin_bit_cast(bf16x2_t, a), __builtin_bit_cast(bf16x2_t, b), c, false); }
__device__ __forceinline__ float gelu_erf(float x) { return 0.5f * x * (1.0f + erff(x * 0.70710678118654752f)); }
typedef int v8i __attribute__((ext_vector_type(8)));
typedef int v4i __attribute__((ext_vector_type(4)));
__device__ __forceinline__ void gather_phase(LAS unsigned char* lds, const bf16* XG2, const float* SSQ, const unsigned char* EU, const unsigned char* EV, const float* SU, const float* SV, const int* IDX, const float* GATE, float* WGT, const float* fg, float* OUT, int vcu, int G) {
    const int tid = opaque_tid(), lane = tid & 63, wave = tid >> 6, c32 = lane & 31, hf = lane >> 5;
    const int emap = 16 * (lane & 3) + 2 * ((lane >> 2) & 7) + hf;
    const unsigned loff = (unsigned)c32 * 24u;
    struct __attribute__((packed, aligned(4))) U6 { unsigned d[6]; };
    {
    constexpr int RPITCH = 528, WLDS = 3072 + 16 * RPITCH;
    const int wv = __builtin_amdgcn_readfirstlane(wave);
    LAS unsigned char* wl_ = lds + wv * WLDS;
    LAS unsigned char* rb = wl_ + 3072;
    const int r16 = lane & 15, q4 = lane >> 4;
    const unsigned char* eul = EU + lane * 16;
#define DMA_HEAD(idxv_, hh_) do { if (lane < 32) { _Pragma("unroll") for (int r_ = 0; r_ < 16; ++r_) { const int si_ = __builtin_amdgcn_readlane((idxv_), ((hh_) & 3) * 16 + r_); \
        __builtin_amdgcn_global_load_lds((const unsigned*)(eul + (size_t)si_ * E4ROW), (LAS unsigned*)(rb + r_ * RPITCH), 16, 0, 0); } } } while (0)
    const int tok0 = vcu * NWAVES + wave;
    int nidx0 = 0, nidx1 = 0;
    if (tok0 < M) { nidx0 = IDX[(size_t)tok0 * 128 + lane]; nidx1 = IDX[(size_t)tok0 * 128 + 64 + lane]; }
    for (int tok = tok0; tok < M; tok += G * NWAVES) {
        const int idx0 = nidx0, idx1 = nidx1;
        DMA_HEAD(idx0, 0);
        { const int nt = tok + G * NWAVES; if (nt < M) { nidx0 = IDX[(size_t)nt * 128 + lane]; nidx1 = IDX[(size_t)nt * 128 + 64 + lane]; } }
        const float rs2 = 1.0f / sqrtf(SSQ[tok] * (1.f / 1024.f) + EPS);
        { const v4u* hp = (const v4u*)(XG2 + (size_t)tok * 1024 + lane * 16); const v4u w0 = hp[0], w1 = hp[1];
          const unsigned ww[8] = {w0.x, w0.y, w0.z, w0.w, w1.x, w1.y, w1.z, w1.w};
          float xv[16];
#pragma unroll
          for (int j = 0; j < 8; ++j) { xv[2 * j] = bflo(ww[j]) * rs2; xv[2 * j + 1] = bfhi(ww[j]) * rs2; }
          unsigned hi4[4], lo4[4];
#pragma unroll
          for (int j = 0; j < 4; ++j) {
              const float x0 = xv[4 * j], x1 = xv[4 * j + 1], x2 = xv[4 * j + 2], x3 = xv[4 * j + 3];
              int h = __builtin_amdgcn_cvt_pk_fp8_f32(x0, x1, 0, false); h = __builtin_amdgcn_cvt_pk_fp8_f32(x2, x3, h, true);
              const float r0 = x0 - __builtin_amdgcn_cvt_f32_fp8(h, 0), r1 = x1 - __builtin_amdgcn_cvt_f32_fp8(h, 1), r2 = x2 - __builtin_amdgcn_cvt_f32_fp8(h, 2), r3 = x3 - __builtin_amdgcn_cvt_f32_fp8(h, 3);
              int l = __builtin_amdgcn_cvt_pk_fp8_f32(r0, r1, 0, false); l = __builtin_amdgcn_cvt_pk_fp8_f32(r2, r3, l, true);
              hi4[j] = (unsigned)h; lo4[j] = (unsigned)l; }
          *(LAS v4u*)(wl_ + lane * 16) = (v4u){hi4[0], hi4[1], hi4[2], hi4[3]}; *(LAS v4u*)(wl_ + 1024 + lane * 16) = (v4u){lo4[0], lo4[1], lo4[2], lo4[3]};
        }
        const float g0 = GATE[(size_t)tok * 128 + lane], g1 = GATE[(size_t)tok * 128 + 64 + lane];
        const float su0 = SU[idx0], su1 = SU[idx1], sv0 = SV[idx0], sv1 = SV[idx1];
        v8i Bx[8];
        {
          const LAS unsigned char* bpa = wl_ + (r16 == 1 ? 1024 : 0) + 256 * (q4 >> 1) + 16 * (q4 & 1); const LAS unsigned char* bpb = bpa + 512;
#pragma unroll
          for (int s = 0; s < 8; ++s) { const v4u a = *(const LAS v4u*)(bpa + s * 32), b = *(const LAS v4u*)(bpb + s * 32);
              Bx[s] = (v8i){(int)a.x, (int)a.y, (int)a.z, (int)a.w, (int)b.x, (int)b.y, (int)b.z, (int)b.w}; } }
#pragma unroll
        for (int h = 0; h < 8; ++h) {
            asm volatile("s_waitcnt vmcnt(0)" ::: "memory");
            const LAS v4i* lp = (const LAS v4i*)(rb + r16 * RPITCH + q4 * 128);
            v4i L[8];
#pragma unroll
            for (int i = 0; i < 8; ++i) L[i] = lp[i];
            asm volatile("s_waitcnt lgkmcnt(0)" ::: "memory");
            __builtin_amdgcn_sched_barrier(0);
            if (h < 7) DMA_HEAD(h + 1 < 4 ? idx0 : idx1, h + 1);
            __builtin_amdgcn_sched_barrier(0);
            f32x4 acc = {0.f, 0.f, 0.f, 0.f};
#pragma unroll
            for (int s = 0; s < 8; ++s) {
                const v8i A = __builtin_shufflevector(L[s], L[s], 0, 1, 2, 3, -1, -1, -1, -1);
                acc = __builtin_amdgcn_mfma_scale_f32_16x16x128_f8f6f4(A, Bx[s], acc, 4, 0, 0, 0, 0, 0);
            }
            if (r16 < 2) *(LAS f32x4*)(wl_ + 2048 + r16 * 512 + (h * 16 + 4 * q4) * 4) = acc;
        }
        const float d0 = *(const LAS float*)(wl_ + 2048 + lane * 4) + *(const LAS float*)(wl_ + 2560 + lane * 4);
        const float d1 = *(const LAS float*)(wl_ + 2048 + 256 + lane * 4) + *(const LAS float*)(wl_ + 2560 + 256 + lane * 4);
        WGT[(size_t)tok * 128 + lane] = g0 * gelu_erf(d0 * su0) * sv0;
        WGT[(size_t)tok * 128 + 64 + lane] = g1 * gelu_erf(d1 * su1) * sv1;
    }
#undef DMA_HEAD
    }
    for (int tok = vcu * NWAVES + wave; tok < M; tok += G * NWAVES) {
        int idxl[2]; float wl[2];
#pragma unroll
        for (int blk = 0; blk < 2; ++blk) { idxl[blk] = IDX[(size_t)tok * 128 + blk * 64 + emap]; wl[blk] = WGT[(size_t)tok * 128 + blk * 64 + emap]; }
        v32f acc;
#pragma unroll
        for (int k = 0; k < 32; ++k) acc[k] = 0.f;
#pragma unroll
        for (int blk = 0; blk < 2; ++blk) {
#pragma unroll 1
            for (int bt = 0; bt < 4; ++bt) {
                U6 vr[8];
#pragma unroll
                for (int i = 0; i < 8; ++i) { const int pr = bt * 8 + i; const int ia = __builtin_amdgcn_readlane(idxl[blk], pr), ib = __builtin_amdgcn_readlane(idxl[blk], 32 + pr);
                    vr[i] = *(const U6*)(EV + (size_t)(hf ? ib : ia) * E6ROW + loff); }
#pragma unroll
                for (int i = 0; i < 8; ++i) { const int pr = bt * 8 + i;
                    const int wa = __builtin_amdgcn_readlane((int)__float_as_uint(wl[blk]), pr), wb = __builtin_amdgcn_readlane((int)__float_as_uint(wl[blk]), 32 + pr);
                    const float w = __uint_as_float((unsigned)(hf ? wb : wa));
                    const v6u d = {vr[i].d[0], vr[i].d[1], vr[i].d[2], vr[i].d[3], vr[i].d[4], vr[i].d[5]};
                    const v32f rv = __builtin_amdgcn_cvt_scalef32_pk32_f32_fp6(d, 1.0f);
                    acc = acc + rv * w; }
            }
        }
        float o16[16];
#pragma unroll
        for (int k = 0; k < 16; ++k) { const float lo = acc[k], hi = acc[16 + k]; const float mine = hf ? hi : lo, other = hf ? lo : hi; o16[k] = mine + __shfl_xor(other, 32); }
        const size_t co = (size_t)tok * 1024 + c32 * 32 + hf * 16;
        float* orow = OUT + co; float ss = 0.f; f32x4 x2[4];
        { const v4u* xp = (const v4u*)(XG2 + co); const v4u w0 = xp[0], w1 = xp[1];
          x2[0] = (f32x4){bflo(w0.x) + o16[0], bfhi(w0.x) + o16[1], bflo(w0.y) + o16[2], bfhi(w0.y) + o16[3]};
          x2[1] = (f32x4){bflo(w0.z) + o16[4], bfhi(w0.z) + o16[5], bflo(w0.w) + o16[6], bfhi(w0.w) + o16[7]};
          x2[2] = (f32x4){bflo(w1.x) + o16[8], bfhi(w1.x) + o16[9], bflo(w1.y) + o16[10], bfhi(w1.y) + o16[11]};
          x2[3] = (f32x4){bflo(w1.z) + o16[12], bfhi(w1.z) + o16[13], bflo(w1.w) + o16[14], bfhi(w1.w) + o16[15]}; }
#pragma unroll
        for (int j = 0; j < 4; ++j) ss += (x2[j][0] * x2[j][0] + x2[j][1] * x2[j][1]) + (x2[j][2] * x2[j][2] + x2[j][3] * x2[j][3]);
        const float rs = 1.0f / sqrtf(wave_sum(ss) * (1.f / 1024.f) + EPS);
#pragma unroll
        for (int j = 0; j < 4; ++j) { const f32x4 g4 = *(const f32x4*)(fg + c32 * 32 + hf * 16 + 4 * j); *(f32x4*)(orow + 4 * j) = x2[j] * rs * g4; }
    }
}

#define RLX_AGENT __ATOMIC_RELAXED, __HIP_MEMORY_SCOPE_AGENT
#define XB_TMO      128
#define XB_XCNT(j)  (256  + 64 * (j))
#define XB_XSUB(j)  (1280 + 64 * (j))
#define XB_XGEN(j)  (2304 + 64 * (j))
#define XB_TOP      3328
#define XB_TOPGEN   3392
#define XCD_BAR_WORDS 3456
#define XB_SPIN_CAP (1u << 18)

__device__ __forceinline__ unsigned xb_ld(unsigned* p)              { return __hip_atomic_load(p, __ATOMIC_RELAXED, __HIP_MEMORY_SCOPE_AGENT); }
__device__ __forceinline__ unsigned xb_add(unsigned* p, unsigned v) { return __hip_atomic_fetch_add(p, v, __ATOMIC_RELAXED, __HIP_MEMORY_SCOPE_AGENT); }
__device__ __forceinline__ unsigned xb_xcc_id() { return (unsigned)__builtin_amdgcn_s_getreg((3 << 11) | 20) & 0xFu; }
#define XB_SPIN(cond, bar) do { unsigned _sp = 0; while (cond) { __builtin_amdgcn_s_sleep(1); \
    if ((++_sp & 255u) == 0u) { if (xb_ld(&(bar)[XB_TMO])) break; if (_sp > XB_SPIN_CAP) { atomicAdd(&(bar)[XB_TMO], 1u); break; } } } } while (0)

struct XcdBarrier {
    unsigned* bar; unsigned x;
    volatile LAS unsigned* st;
};

__device__ __forceinline__ XcdBarrier xcd_barrier_post(unsigned* bar, volatile LAS unsigned* st) {
    XcdBarrier b; b.bar = bar; b.x = xb_xcc_id(); b.st = st;
    if (threadIdx.x == 0) (void)xb_add(&bar[XB_XCNT(b.x)], 1u);
    return b;
}
__device__ __forceinline__ void xcd_barrier_complete(unsigned* bar, unsigned x, unsigned& nloc, unsigned& nx) {
    const unsigned G = gridDim.x * gridDim.y * gridDim.z;
    unsigned sum, cnt, mine, sp = 0u;
    for (;;) {
        sum = 0u; cnt = 0u; mine = 0u;
#pragma unroll
        for (unsigned j = 0; j < 16; ++j) { const unsigned c = xb_ld(&bar[XB_XCNT(j)]); sum += c; cnt += (c > 0u) ? 1u : 0u; mine = (j == x) ? c : mine; }
        if (sum == G) break;
        __builtin_amdgcn_s_sleep(1);
        if ((++sp & 255u) == 0u) { if (xb_ld(&bar[XB_TMO])) break; if (sp > XB_SPIN_CAP) { atomicAdd(&bar[XB_TMO], 1u); break; } }
    }
    nloc = mine > 0u ? mine : 1u; nx = cnt > 0u ? cnt : 1u;
}

__device__ __forceinline__ void xcd_barrier(const XcdBarrier& b) {
    asm volatile("s_waitcnt vmcnt(0)" ::: "memory");
    __syncthreads();
    if (threadIdx.x == 0) {
        unsigned* bar = b.bar;
        __builtin_amdgcn_s_waitcnt(0);
        unsigned nloc = b.st[0], nx = b.st[1];
        if (nloc == 0u) { xcd_barrier_complete(bar, b.x, nloc, nx); b.st[0] = nloc; b.st[1] = nx; }
        const unsigned old = xb_add(&bar[XB_XSUB(b.x)], 1u);
        const unsigned gen = old / nloc;
        if (old + 1u == (gen + 1u) * nloc) {
            __builtin_amdgcn_fence(__ATOMIC_RELEASE, "agent");
            asm volatile("s_waitcnt vmcnt(0)" ::: "memory");
            const unsigned og = xb_add(&bar[XB_TOP], 1u);
            const unsigned tg = og / nx;
            if (og + 1u == (tg + 1u) * nx) xb_add(&bar[XB_TOPGEN], 1u);
            else XB_SPIN(xb_ld(&bar[XB_TOPGEN]) == tg, bar);
            __builtin_amdgcn_fence(__ATOMIC_ACQUIRE, "agent");
            xb_add(&bar[XB_XGEN(b.x)], 1u);
            asm volatile("s_waitcnt vmcnt(0)" ::: "memory");
        } else {
            XB_SPIN(xb_ld(&bar[XB_XGEN(b.x)]) == gen, bar);
            __builtin_amdgcn_fence(__ATOMIC_ACQUIRE, "agent");
            asm volatile("s_waitcnt vmcnt(0)" ::: "memory");
        }
    }
    __syncthreads();
}


__global__ void __launch_bounds__(NTHREADS, 2) fwd_kernel(Args args) {
    extern __shared__ __attribute__((aligned(16))) unsigned char lds[];
    const int tid = threadIdx.x, lane = tid & 63, wave = __builtin_amdgcn_readfirstlane(tid >> 6);
    const int G = gridDim.x, bx = blockIdx.x;
    const int vcu = (G % 8 == 0) ? (bx % 8) * (G / 8) + bx / 8 : bx;
    unsigned char* ws = args.ws;
    const float* x = args.in[0];
    bf16* WinT = (bf16*)(ws + WS_WIN); bf16* WpwT = (bf16*)(ws + WS_WPW); bf16* WoT = (bf16*)(ws + WS_WO); bf16* WoutT = (bf16*)(ws + WS_WOUT); bf16* WqT = (bf16*)(ws + WS_WQ);
    unsigned char* EU = ws + WS_EU; unsigned char* EV = ws + WS_EV; float* SU = (float*)(ws + WS_ESC); float* SV = SU + NEXP; float* SSQ = SV + NEXP; bf16* SKb = (bf16*)(ws + WS_SK);
    bf16* XN = (bf16*)(ws + WS_XN); bf16* Ub = (bf16*)(ws + WS_U); bf16* MG = (bf16*)(ws + WS_MG); bf16* XG2 = (bf16*)(ws + WS_XG2);
    bf16* Gt = (bf16*)(ws + WS_G); bf16* QP = (bf16*)(ws + WS_QP);
    bf16* Qb = (bf16*)(ws + WS_Q); bf16* Kb = (bf16*)(ws + WS_K); bf16* Vb = (bf16*)(ws + WS_V);
    int* IDX = (int*)(ws + WS_IDX); float* GATE = (float*)(ws + WS_GATE);
    bf16* CA = (bf16*)(ws + WS_CA);
    LAS unsigned char* lds3 = (LAS unsigned char*)lds;
    const int lo = args.ph_lo, hi = args.ph_hi;
    volatile LAS unsigned* MISC = (volatile LAS unsigned*)(lds3 + MISC_OFF);
    if (tid < 32) MISC[tid] = 0u;
    __syncthreads();
    XcdBarrier bar_; bar_.bar = (unsigned*)(ws + WS_CTL) + CW_BAR; bar_.x = 0; bar_.st = nullptr;
    if (hi - lo > 1) bar_ = xcd_barrier_post((unsigned*)(ws + WS_CTL) + CW_BAR, MISC + 8);
#define SEAM(k) do { if (IN(k) && IN((k) + 1)) xcd_barrier(bar_); } while (0)
#ifdef ONLY_PHASE
#define IN(k) ((k) == ONLY_PHASE && lo <= (k) && (k) < hi)
#else
#define IN(k) (lo <= (k) && (k) < hi)
#endif

    if (IN(0)) {
        LAS float* scr = (LAS float*)(lds3 + wave * 16384);
        const int gw = vcu * NWAVES + wave, NGW = G * NWAVES;
        constexpr int I_IN = 16 * (IN_DIM / 32), I_SQ = 16 * 32, I_Q = 16 * 64;
        constexpr int NITEMS = I_IN + 3 * I_SQ + I_Q;
        for (int it = gw; it < NITEMS; it += NGW) {
            int r = it;
            if (r < I_IN) { const int nblk = IN_DIM / 32, kb = r / nblk, nb = r % nblk; p0_transpose_item(args.in[2], D, IN_DIM, WinT, glu_row(32 * nb), scr, kb, nb, lane); continue; } r -= I_IN;
            if (r < I_SQ) { p0_transpose_item(args.in[7], D, D, WpwT, 32 * (r % 32), scr, r / 32, r % 32, lane); continue; } r -= I_SQ;
            if (r < I_SQ) { p0_transpose_item(args.in[9], D, D, WoT, 32 * (r % 32), scr, r / 32, r % 32, lane); continue; } r -= I_SQ;
            if (r < I_SQ) { p0_transpose_item(args.in[10], D, D, WoutT, 32 * (r % 32), scr, r / 32, r % 32, lane); continue; } r -= I_SQ;
            p0_transpose_item(args.in[12], D, 2048, WqT, 32 * (r % 64), scr, r / 64, r % 64, lane, args.in[11]);
        }
        const size_t gt = (size_t)vcu * NTHREADS + tid, ngt = (size_t)G * NTHREADS;
        for (size_t i = gt; i < (size_t)M; i += ngt) SSQ[i] = 0.f;
        cvt_stream(args.in[13], SKb, (size_t)2 * NKEYS * PHALF, gt, ngt);
        for (int r = gw; r < NEXP; r += NGW) { const int tb = r >= NEXP / 2, e = 2 * (r - tb * (NEXP / 2)); rows_to_fp6(args.in[14 + tb] + (size_t)e * D, tb ? EV + (size_t)e * E6ROW : EU + (size_t)e * E4ROW, (tb ? SV : SU) + e, lane, tb ? nullptr : args.in[11], scr); }
        for (int m = gw; m < M; m += 4 * NGW) {
            f32x4 v[4][4]; float ssr[4];
#pragma unroll
            for (int r = 0; r < 4; ++r) { const f32x4* xr = (const f32x4*)(x + (size_t)(m + r * NGW) * D) + lane;
#pragma unroll
                for (int j = 0; j < 4; ++j) v[r][j] = xr[64 * j]; }
#pragma unroll
            for (int r = 0; r < 4; ++r) { float q = 0.f;
#pragma unroll
                for (int j = 0; j < 4; ++j) q += (v[r][j][0] * v[r][j][0] + v[r][j][1] * v[r][j][1]) + (v[r][j][2] * v[r][j][2] + v[r][j][3] * v[r][j][3]);
                ssr[r] = q; }
#pragma unroll
            for (int o = 1; o < 64; o <<= 1) {
#pragma unroll
                for (int r = 0; r < 4; ++r) ssr[r] += __shfl_xor(ssr[r], o); }
#pragma unroll
            for (int r = 0; r < 4; ++r) { const float rs = 1.0f / sqrtf(ssr[r] * (1.f / 1024.f) + EPS); v2u* o8 = (v2u*)(XN + (size_t)(m + r * NGW) * D) + lane;
#pragma unroll
                for (int j = 0; j < 4; ++j) { const f32x4 gg = ((const f32x4*)args.in[1])[lane + 64 * j]; v2u o; o.x = pk2(v[r][j][0] * rs * gg[0], v[r][j][1] * rs * gg[1]); o.y = pk2(v[r][j][2] * rs * gg[2], v[r][j][3] * rs * gg[3]); o8[64 * j] = o; } }
        }
    }
    SEAM(0);
    if (IN(1)) {
        pg8::Gemm g{XN, WinT, XN, WinT, M, IN_DIM, D}; pg8::StaticOrder S; S.init(M, IN_DIM, G, bx, 1);
        EpiInProj E{Ub, Qb, Kb, Vb, Gt};
        pg8::gemm_phase<EpiInProj>(lds3, g, S, E);
    }
    SEAM(1);
    if (IN(2)) {
        conv_phase(lds3, Ub, CA, args.in[3], args.in[4], args.in[5], args.in[6], vcu, G);
        __syncthreads();
        att::attn_phase(lds3, Qb, Kb, Vb, Qb, args.in[8], vcu, G);
    }
    SEAM(2);
    if (IN(3)) {
        pg8::Gemm g{CA, WpwT, Qb, WoT, M, D, D}; pg8::StaticOrder S; S.init(M, D, G, bx, 2);
        EpiMerge E{Gt, MG};
        pg8::gemm_phase<EpiMerge>(lds3, g, S, E);
    }
    SEAM(3);
    if (IN(4)) {
        pg8::Gemm g{MG, WoutT, MG, WoutT, M, D, D}; pg8::StaticOrder S; S.init(M, D, G, bx, 1);
        EpiResid E{x, XG2, SSQ};
        pg8::gemm_phase<EpiResid>(lds3, g, S, E);
    }
    SEAM(4);
    if (IN(5)) {
        pg8::Gemm g{XG2, WqT, XG2, WqT, M, 2048, D}; pg8::StaticOrder S; S.init(M, 2048, G, bx, 1);
        EpiBf16Rs E{QP, SSQ};
        pg8::gemm_phase<EpiBf16Rs>(lds3, g, S, E);
    }
    SEAM(5);
    if (IN(6)) tk::topk_phase(lds3, QP, SKb, IDX, GATE, vcu, G);
    SEAM(6);
    if (IN(7)) gather_phase(lds3, XG2, SSQ, EU, EV, SU, SV, IDX, GATE, GATE, args.in[16], args.out, vcu, G);
#undef IN
#undef SEAM
}

extern "C" void kernel_launch(void* const* d_in, const int* in_sizes, int n_in, void* d_out, int out_size, void* d_ws, size_t ws_size, hipStream_t stream) {
    static int grid = 0;
    if (grid == 0) {
        if (n_in != 17 || in_sizes[0] != M * D || out_size != M * D || ws_size < WS_END) { fprintf(stderr, "kernel_launch: unexpected shapes (n_in %d, in0 %d, out %d, ws %zu)\n", n_in, n_in > 0 ? in_sizes[0] : -1, out_size, ws_size); grid = -1; return; }
        int dev = 0, cus = 0;
        if (hipGetDevice(&dev) != hipSuccess || hipDeviceGetAttribute(&cus, hipDeviceAttributeMultiprocessorCount, dev) != hipSuccess) { grid = -1; return; }
        if (hipFuncSetAttribute((const void*)fwd_kernel, hipFuncAttributeMaxDynamicSharedMemorySize, LDS_BYTES) != hipSuccess) { fprintf(stderr, "kernel_launch: hipFuncSetAttribute failed\n"); grid = -1; return; }
        int per_cu = 0;
        if (hipOccupancyMaxActiveBlocksPerMultiprocessor(&per_cu, (const void*)fwd_kernel, NTHREADS, LDS_BYTES) != hipSuccess || per_cu < 1) { fprintf(stderr, "kernel_launch: occupancy query says %d\n", per_cu); }
        (void)hipGetLastError();
        grid = cus;
    }
    if (grid < 0) return;
    Args a{};
    for (int i = 0; i < 17; ++i) a.in[i] = (const float*)d_in[i];
    a.out = (float*)d_out; a.ws = (unsigned char*)d_ws;
    if (MK_N_LAUNCHES == 1) {
        a.ph_lo = 0; a.ph_hi = 8;
        if (hipMemsetAsync((char*)d_ws + WS_CTL, 0, CTL_ZERO_BYTES, stream) != hipSuccess) { fprintf(stderr, "kernel_launch: memset failed\n"); return; }
        hipLaunchKernelGGL(fwd_kernel, dim3(grid), dim3(NTHREADS), LDS_BYTES, stream, a);
    } else {
        for (int p = 0; p < 8; ++p) {
            a.ph_lo = p; a.ph_hi = p + 1;
            hipLaunchKernelGGL(fwd_kernel, dim3(grid), dim3(NTHREADS), LDS_BYTES, stream, a);
        }
    }
}
```

```cpp
#include <hip/hip_runtime.h>
#include <cstdio>
#include <cstdint>

#ifndef MK_N_LAUNCHES
#define MK_N_LAUNCHES 1
#endif

constexpr int BATCH = 16, SEQ = 2048, D = 1024, M = BATCH * SEQ;
constexpr int CK = 31, CPAD = 15;
constexpr int NH = 16, NKV = 4, HD = 64, KVD = 256, WIN = 128;
constexpr int IN_DIM = 5632;
constexpr int PHD = 8, PKD = 256, PHALF = 128, NKEYS = 128, NEXP = 16384, TOPK = 16;
constexpr float EPS = 1e-6f;
constexpr int NWAVES = 8, NTHREADS = 512;
constexpr float LOG2E = 1.4426950408889634f, QSCALE = 0.125f * 1.4426950408889634f;

typedef unsigned short bf16;
typedef unsigned v4u __attribute__((ext_vector_type(4)));
typedef unsigned v2u __attribute__((ext_vector_type(2)));
typedef float f32x4 __attribute__((ext_vector_type(4)));
typedef float f32x2 __attribute__((ext_vector_type(2)));
typedef __bf16 bf16x2_t __attribute__((ext_vector_type(2)));
#define LAS __attribute__((address_space(3)))

__device__ __forceinline__ int opaque_tid() { int t = threadIdx.x; asm volatile("" : "+v"(t)); return t; }
__device__ __forceinline__ void fmac_s(float& acc, float a, float b) { asm volatile("v_fmac_f32 %0, %1, %2" : "+v"(acc) : "v"(a), "v"(b)); }
__device__ __forceinline__ void mul_s(float& x, float a) { asm volatile("v_mul_f32 %0, %0, %1" : "+v"(x) : "v"(a)); }
__device__ __forceinline__ unsigned pk2(float lo, float hi) { f32x2 v = {lo, hi}; bf16x2_t b = __builtin_convertvector(v, bf16x2_t); return __builtin_bit_cast(unsigned, b); }
__device__ __forceinline__ float bflo(unsigned u) { return __uint_as_float(u << 16); }
__device__ __forceinline__ float bfhi(unsigned u) { return __uint_as_float(u & 0xffff0000u); }
__device__ __forceinline__ float sigmoidf_(float x) { return __builtin_amdgcn_rcpf(1.0f + __builtin_amdgcn_exp2f(x * -1.4426950408889634f)); }
__device__ __forceinline__ float wave_sum(float v) {
#pragma unroll
    for (int o = 1; o < 64; o <<= 1) v += __shfl_xor(v, o);
    return v;
}

namespace pg8 {
typedef unsigned short bf16_t;
typedef short bf16x8 __attribute__((ext_vector_type(8)));
constexpr int BM = 256, BK = 64, HALF = 128, HTB = HALF * BK * 2, STAGE_BYTES = 8 * HTB, NXCD = 8, WGM = 8;

__host__ __device__ __forceinline__ int lds_byte(int r, int c) { const int st = (r >> 4) * 2 + (c >> 5), rr = r & 15, cc = c & 31, ob = rr * 64 + cc * 2; return st * 1024 + (ob ^ (((ob >> 9) & 1) << 5)); }
__host__ __device__ __forceinline__ void stage_rc(int b, int& R, int& C) { const int st = b / 1024, sb = b % 1024, swz = sb ^ (((sb >> 9) & 1) << 5); R = (st >> 1) * 16 + swz / 64; C = (st & 1) * 32 + (swz % 64) / 2; }
__host__ __device__ __forceinline__ int perm32(int rho) { const int n = rho >> 4, i = rho & 15; return 8 * (i >> 2) + 4 * n + (i & 3); }

struct Unit { int pm, pn, g; };
struct Gemm { const bf16_t* A0; const bf16_t* B0; const bf16_t* A1; const bf16_t* B1; int M, N, K; };

struct StaticOrder {
    int nM, nN, nwg, G, c, per;
    __host__ __device__ void init(int M_, int N_, int G_, int c_, int per_) { nM = M_ / BM; nN = N_ / BM; nwg = nM * nN; G = G_; c = c_; per = per_; }
    __host__ __device__ bool next(int i, Unit& u) const {
        const int ti = i / per; u.g = i % per;
        const long L = (long)ti * G + c; if (L >= nwg) return false;
        int wgid = (int)L; { const int q = nwg / NXCD, r = nwg % NXCD, xcd = wgid % NXCD, off = wgid / NXCD; wgid = (xcd < r ? xcd * (q + 1) : r * (q + 1) + (xcd - r) * q) + off; }
        const int nig = WGM * nN, gid = wgid / nig, fm = gid * WGM, gsz = (nM - fm) < WGM ? (nM - fm) : WGM;
        u.pm = fm + ((wgid % nig) % gsz); u.pn = (wgid % nig) / gsz; return true;
    }
};

template <class Epi>
__device__ __forceinline__ void gemm_phase(LAS unsigned char* lds, const Gemm g, const StaticOrder& S, const Epi& E) {
    const int tid = opaque_tid(), wid = __builtin_amdgcn_readfirstlane(tid >> 6), lane = tid & 63, wr = wid >> 2, wc = wid & 3, fr = lane & 15, fq = lane >> 4;
    const int K = g.K, nt = K / BK;
    unsigned voffA[2], voffB[2];
#pragma unroll
    for (int i = 0; i < 2; ++i) { int R, C; stage_rc(tid * 16 + i * 8192, R, C); const int Rb = Epi::PERM ? ((R & ~31) + perm32(R & 31)) : R;
        voffA[i] = (unsigned)(R * K + C) * 2u; voffB[i] = (unsigned)(Rb * K + C) * 2u; }
    const size_t kstep = (size_t)(BK * 2);
    const size_t hstep = (size_t)HALF * K * 2;
    const size_t tstep = 2 * hstep;
    const unsigned ldsw = (unsigned)wid * 1024u;
    const int aoff = lds_byte(wr * 64 + fr, fq * 8), boff = lds_byte(wc * 32 + fr, fq * 8);
#define PG8_SA(b, h) (((b) * 2 + (h)) * HTB)
#define PG8_SB(b, h) ((4 + (b) * 2 + (h)) * HTB)
#define PG8_STAGE(bufoff, gbase, voff) do { _Pragma("unroll") for (int _i = 0; _i < 2; ++_i) \
        __builtin_amdgcn_global_load_lds((const unsigned*)((const char*)(gbase) + (voff)[_i]), (LAS unsigned*)(lds + (bufoff) + ldsw + _i * 8192), 16, 0, 0); } while (0)
#define PG8_LDA(dst, b, h) do { _Pragma("unroll") for (int m = 0; m < 4; ++m) _Pragma("unroll") for (int k = 0; k < 2; ++k) dst[m][k] = *(const LAS bf16x8*)(lds + PG8_SA(b, h) + aoff + m * 2048 + k * 1024); } while (0)
#define PG8_LDB(dst, b, h) do { _Pragma("unroll") for (int n = 0; n < 2; ++n) _Pragma("unroll") for (int k = 0; k < 2; ++k) dst[n][k] = *(const LAS bf16x8*)(lds + PG8_SB(b, h) + boff + n * 2048 + k * 1024); } while (0)
#define PG8_MMA(ai, bj, At, Bt) do { __builtin_amdgcn_s_setprio(1); _Pragma("unroll") for (int m = 0; m < 4; ++m) _Pragma("unroll") for (int n = 0; n < 2; ++n) _Pragma("unroll") for (int k = 0; k < 2; ++k) \
        acc[ai][bj][m][n] = __builtin_amdgcn_mfma_f32_16x16x32_bf16(Bt[n][k], At[m][k], acc[ai][bj][m][n], 0, 0, 0); __builtin_amdgcn_s_setprio(0); } while (0)
#define PG8_WAIT_V(n) asm volatile("s_waitcnt vmcnt(" #n ")" ::: "memory")
#define PG8_WAIT_L(n) asm volatile("s_waitcnt lgkmcnt(" #n ")" ::: "memory")
#define PG8_BAR __builtin_amdgcn_s_barrier()
#define PG8_SCHED __builtin_amdgcn_sched_barrier(0)
    Unit cur, nxt; int ui = 0;
    if (!S.next(0, cur)) return;
    f32x4 acc[2][2][4][2];
#pragma unroll
    for (int a = 0; a < 2; ++a)
#pragma unroll
        for (int b = 0; b < 2; ++b)
#pragma unroll
            for (int m = 0; m < 4; ++m)
#pragma unroll
                for (int n = 0; n < 2; ++n) acc[a][b][m][n] = (f32x4){0.f, 0.f, 0.f, 0.f};
    bf16x8 At[4][2], B0[2][2], B1[2][2];
    const char* cA = (const char*)(cur.g ? g.A1 : g.A0) + (size_t)cur.pm * tstep; const char* cB = (const char*)(cur.g ? g.B1 : g.B0) + (size_t)cur.pn * tstep;
    PG8_STAGE(PG8_SB(0, 0), cB, voffB); PG8_STAGE(PG8_SB(0, 1), cB + hstep, voffB); PG8_STAGE(PG8_SA(0, 0), cA, voffA); PG8_STAGE(PG8_SA(0, 1), cA + hstep, voffA);
    if (wr == 1) PG8_BAR;
    PG8_WAIT_V(2); PG8_BAR;
    PG8_STAGE(PG8_SB(1, 0), cB + kstep, voffB); PG8_STAGE(PG8_SA(1, 0), cA + kstep, voffA); PG8_STAGE(PG8_SB(1, 1), cB + hstep + kstep, voffB);
    PG8_WAIT_V(6); PG8_BAR;
    for (;;) {
        const bool has_next = S.next(ui + 1, nxt);
        const char* nA = has_next ? (const char*)(nxt.g ? g.A1 : g.A0) + (size_t)nxt.pm * tstep : cA; const char* nB = has_next ? (const char*)(nxt.g ? g.B1 : g.B0) + (size_t)nxt.pn * tstep : cB;
        for (int t = 0; t < nt; t += 2) {
            const bool last = (t == nt - 2);
            const char* a1 = cA + (size_t)(t + 1) * kstep;
            const char* a2 = last ? nA : cA + (size_t)(t + 2) * kstep; const char* b2 = last ? nB : cB + (size_t)(t + 2) * kstep;
            const char* a3 = a2 + kstep; const char* b3 = b2 + kstep;
            PG8_LDB(B0, 0, 0); PG8_LDB(B1, 0, 1); PG8_SCHED; PG8_LDA(At, 0, 0); PG8_STAGE(PG8_SA(1, 1), a1 + hstep, voffA);
            PG8_WAIT_V(8); PG8_WAIT_L(0); PG8_BAR; PG8_MMA(0, 0, At, B0); PG8_MMA(0, 1, At, B1); PG8_BAR; PG8_SCHED;
            PG8_LDA(At, 0, 1); PG8_STAGE(PG8_SB(0, 0), b2, voffB); PG8_STAGE(PG8_SB(0, 1), b2 + hstep, voffB); PG8_STAGE(PG8_SA(0, 0), a2, voffA);
            PG8_WAIT_V(8); PG8_WAIT_L(0); PG8_BAR; PG8_MMA(1, 0, At, B0); PG8_MMA(1, 1, At, B1); PG8_BAR; PG8_SCHED;
            PG8_LDB(B0, 1, 0); PG8_LDB(B1, 1, 1); PG8_SCHED; PG8_LDA(At, 1, 0); PG8_STAGE(PG8_SA(0, 1), a2 + hstep, voffA);
            PG8_WAIT_V(8); PG8_WAIT_L(0); PG8_BAR; PG8_MMA(0, 0, At, B0); PG8_MMA(0, 1, At, B1); PG8_BAR; PG8_SCHED;
            PG8_LDA(At, 1, 1); PG8_STAGE(PG8_SB(1, 0), b3, voffB); PG8_STAGE(PG8_SB(1, 1), b3 + hstep, voffB); PG8_STAGE(PG8_SA(1, 0), a3, voffA);
            PG8_WAIT_V(8); PG8_WAIT_L(0); PG8_BAR; PG8_MMA(1, 0, At, B0); PG8_MMA(1, 1, At, B1); PG8_BAR; PG8_SCHED;
        }
        if (wr == 0) PG8_BAR;
        E(acc, cur, wr, wc, fr, fq);
        if (!has_next) break;
        if (!(Epi::CHAIN && cur.g == 0))
#pragma unroll
        for (int a = 0; a < 2; ++a)
#pragma unroll
            for (int b = 0; b < 2; ++b)
#pragma unroll
                for (int m = 0; m < 4; ++m)
#pragma unroll
                    for (int n = 0; n < 2; ++n) acc[a][b][m][n] = (f32x4){0.f, 0.f, 0.f, 0.f};
        cur = nxt; cA = nA; cB = nB; ++ui;
        if (wr == 1) PG8_BAR;
    }
    PG8_WAIT_V(0);
    PG8_BAR;
#undef PG8_SA
#undef PG8_SB
#undef PG8_STAGE
#undef PG8_LDA
#undef PG8_LDB
#undef PG8_MMA
#undef PG8_WAIT_V
#undef PG8_WAIT_L
#undef PG8_BAR
#undef PG8_SCHED
}
}

constexpr size_t MiB = 1u << 20;
constexpr size_t WS_CTL = 0;
constexpr size_t WS_WIN = 2 * MiB, WS_WPW = 13 * MiB, WS_WO = 15 * MiB, WS_WOUT = 17 * MiB, WS_WQ = 19 * MiB, WS_SK = 23 * MiB;
constexpr size_t WS_EU = 24 * MiB, WS_EV = 40 * MiB, WS_ESC = 56 * MiB;
constexpr size_t WS_XN = 88 * MiB, WS_U = 152 * MiB;
constexpr size_t WS_MG = 88 * MiB, WS_XG2 = 152 * MiB;
constexpr size_t WS_G = 216 * MiB;
constexpr size_t WS_QP = 216 * MiB;
constexpr size_t WS_Q = 344 * MiB, WS_K = 408 * MiB, WS_V = 424 * MiB;
constexpr size_t WS_IDX = 344 * MiB, WS_GATE = 360 * MiB;
constexpr size_t WS_CA = 440 * MiB;
constexpr size_t WS_END = 504 * MiB;
constexpr int LDS_BYTES = 147456;
constexpr int MISC_OFF = 131072 + 8192;
constexpr int CW_BAR = 4096;
constexpr size_t CTL_ZERO_BYTES = 65536;

struct Args { const float* in[17]; float* out; unsigned char* ws; int ph_lo, ph_hi; };

struct EpiInProj {
    static constexpr bool PERM = true, CHAIN = false;
    bf16 *U, *Q, *K, *V, *G;
    __device__ __forceinline__ void operator()(f32x4 (&acc)[2][2][4][2], const pg8::Unit& u, int wr, int wc, int fr, int fq) const {
        const int row0 = u.pm * 256 + wr * 64 + fr; const int cw = wc * 32 + 8 * fq;
        if (u.pn < 8) {
#pragma unroll
            for (int ai = 0; ai < 2; ++ai)
#pragma unroll
                for (int m = 0; m < 4; ++m) { const size_t row = (size_t)(row0 + ai * 128 + m * 16);
                    f32x4 a0 = acc[ai][0][m][0], a1 = acc[ai][0][m][1], b0 = acc[ai][1][m][0], b1 = acc[ai][1][m][1];
                    v4u w; w.x = pk2(a0[0] * sigmoidf_(b0[0]), a0[1] * sigmoidf_(b0[1])); w.y = pk2(a0[2] * sigmoidf_(b0[2]), a0[3] * sigmoidf_(b0[3]));
                    w.z = pk2(a1[0] * sigmoidf_(b1[0]), a1[1] * sigmoidf_(b1[1])); w.w = pk2(a1[2] * sigmoidf_(b1[2]), a1[3] * sigmoidf_(b1[3]));
                    *(v4u*)(U + row * 1024 + u.pn * 128 + cw) = w; }
        } else if (u.pn >= 14) {
            const int p = u.pn - 14; unsigned char* G8 = (unsigned char*)G;
#pragma unroll
            for (int ai = 0; ai < 2; ++ai)
#pragma unroll
                for (int m = 0; m < 4; ++m) { unsigned char* rowp = G8 + (size_t)(row0 + ai * 128 + m * 16) * 2048 + (size_t)(p * 128 + cw) * 2;
                    v4u w = {0u, 0u, 0u, 0u};
#pragma unroll
                    for (int j = 0; j < 4; ++j) { w.x = __builtin_amdgcn_cvt_pk_u8_f32(sigmoidf_(acc[ai][0][m][0][j]) * 255.0f, j, w.x); w.y = __builtin_amdgcn_cvt_pk_u8_f32(sigmoidf_(acc[ai][0][m][1][j]) * 255.0f, j, w.y);
                        w.z = __builtin_amdgcn_cvt_pk_u8_f32(sigmoidf_(acc[ai][1][m][0][j]) * 255.0f, j, w.z); w.w = __builtin_amdgcn_cvt_pk_u8_f32(sigmoidf_(acc[ai][1][m][1][j]) * 255.0f, j, w.w); }
                    *(v4u*)rowp = w; }
        } else {
            bf16* base; int ld, col0; float sc = 1.0f;
            if (u.pn < 12) { base = Q; ld = 1024; col0 = (u.pn - 8) * 256; sc = QSCALE; }
            else if (u.pn == 12) { base = K; ld = 256; col0 = 0; }
            else { base = V; ld = 256; col0 = 0; }
#pragma unroll
            for (int ai = 0; ai < 2; ++ai)
#pragma unroll
                for (int m = 0; m < 4; ++m) { bf16* rowp = base + (size_t)(row0 + ai * 128 + m * 16) * ld + col0 + cw;
#pragma unroll
                    for (int bj = 0; bj < 2; ++bj) { f32x4 v0 = acc[ai][bj][m][0] * sc, v1 = acc[ai][bj][m][1] * sc;
                        v4u w; w.x = pk2(v0[0], v0[1]); w.y = pk2(v0[2], v0[3]); w.z = pk2(v1[0], v1[1]); w.w = pk2(v1[2], v1[3]);
                        *(v4u*)(rowp + bj * 128) = w; } }
        }
    }
};
struct EpiMerge {
    static constexpr bool PERM = true, CHAIN = true;
    const bf16* G; bf16* MG;
    __device__ __forceinline__ void operator()(f32x4 (&acc)[2][2][4][2], const pg8::Unit& u, int wr, int wc, int fr, int fq) const {
        const int row0 = u.pm * 256 + wr * 64 + fr; const int col0 = u.pn * 256 + wc * 32 + 8 * fq;
        const unsigned char* G8 = (const unsigned char*)G;
#pragma unroll
        for (int ai = 0; ai < 2; ++ai) { const size_t row = (size_t)(row0 + ai * 128);
            const unsigned char* gp = G8 + row * 2048 + (size_t)col0 * 2; bf16* mp = MG + row * 1024 + col0;
            v4u gw[4][2];
#pragma unroll
            for (int m = 0; m < 4; ++m)
#pragma unroll
                for (int bj = 0; bj < 2; ++bj) gw[m][bj] = *(const v4u*)(gp + (size_t)(m * 16) * 2048 + bj * 256);
#pragma unroll
            for (int m = 0; m < 4; ++m)
#pragma unroll
                for (int bj = 0; bj < 2; ++bj) { const v4u g4 = gw[m][bj]; f32x4 v0 = acc[ai][bj][m][0], v1 = acc[ai][bj][m][1];
                    float fb[8];
#pragma unroll
                    for (int j = 0; j < 4; ++j) { fb[j] = fmaxf((float)((g4.z >> (8 * j)) & 0xffu), 1.0f); fb[4 + j] = fmaxf((float)((g4.w >> (8 * j)) & 0xffu), 1.0f); }
                    if (u.g) {
#pragma unroll
                        for (int j = 0; j < 4; ++j) { v0[j] *= fb[j] * (1.0f / 255.0f); v1[j] *= fb[4 + j] * (1.0f / 255.0f); }
                        v4u w; w.x = pk2(v0[0], v0[1]); w.y = pk2(v0[2], v0[3]); w.z = pk2(v1[0], v1[1]); w.w = pk2(v1[2], v1[3]); *(v4u*)(mp + (size_t)(m * 16) * 1024 + bj * 128) = w;
                    } else {
#pragma unroll
                        for (int j = 0; j < 4; ++j) { v0[j] *= (float)((g4.x >> (8 * j)) & 0xffu) * __builtin_amdgcn_rcpf(fb[j]); v1[j] *= (float)((g4.y >> (8 * j)) & 0xffu) * __builtin_amdgcn_rcpf(fb[4 + j]); }
                        acc[ai][bj][m][0] = v0; acc[ai][bj][m][1] = v1; } } }
    }
};
struct EpiResid {
    static constexpr bool PERM = true, CHAIN = false;
    const float* X; bf16* XG; float* SSQ;
    __device__ __forceinline__ void operator()(f32x4 (&acc)[2][2][4][2], const pg8::Unit& u, int wr, int wc, int fr, int fq) const {
        const int row0 = u.pm * 256 + wr * 64 + fr; const int col0 = u.pn * 256 + wc * 32 + 8 * fq;
#pragma unroll
        for (int ai = 0; ai < 2; ++ai) {
            f32x4 xv[4][2][2];
#pragma unroll
            for (int m = 0; m < 4; ++m) { const size_t off = (size_t)(row0 + ai * 128 + m * 16) * 1024 + col0;
#pragma unroll
                for (int bj = 0; bj < 2; ++bj)
#pragma unroll
                    for (int n = 0; n < 2; ++n) xv[m][bj][n] = *(const f32x4*)(X + off + bj * 128 + n * 4); }
#pragma unroll
            for (int m = 0; m < 4; ++m) { const int row = row0 + ai * 128 + m * 16; const size_t off = (size_t)row * 1024 + col0; float ss = 0.f;
#pragma unroll
                for (int bj = 0; bj < 2; ++bj) { const f32x4 x0 = xv[m][bj][0] + acc[ai][bj][m][0], x1 = xv[m][bj][1] + acc[ai][bj][m][1];
                    ss += ((x0[0] * x0[0] + x0[1] * x0[1]) + (x0[2] * x0[2] + x0[3] * x0[3])) + ((x1[0] * x1[0] + x1[1] * x1[1]) + (x1[2] * x1[2] + x1[3] * x1[3]));
                    v4u w; w.x = pk2(x0[0], x0[1]); w.y = pk2(x0[2], x0[3]); w.z = pk2(x1[0], x1[1]); w.w = pk2(x1[2], x1[3]); *(v4u*)(XG + off + bj * 128) = w; }
                ss += __shfl_xor(ss, 16); ss += __shfl_xor(ss, 32);
                if (fq == 0) atomicAdd(SSQ + row, ss); }
        }
    }
};
struct EpiBf16Rs {
    static constexpr bool PERM = true, CHAIN = false;
    bf16* O; const float* SSQ;
    __device__ __forceinline__ void operator()(f32x4 (&acc)[2][2][4][2], const pg8::Unit& u, int wr, int wc, int fr, int fq) const {
        const int row0 = u.pm * 256 + wr * 64 + fr;
        float ssq[2][4];
#pragma unroll
        for (int ai = 0; ai < 2; ++ai)
#pragma unroll
            for (int m = 0; m < 4; ++m) ssq[ai][m] = SSQ[row0 + ai * 128 + m * 16];
        const int sidx = 2 * wc + (fq >> 1), hh = fq & 1;
#pragma unroll
        for (int ai = 0; ai < 2; ++ai)
#pragma unroll
            for (int m = 0; m < 4; ++m) { const int row = row0 + ai * 128 + m * 16; const int tile = row >> 5, r32 = row & 31;
                const float rs = 1.0f / sqrtf(ssq[ai][m] * (1.f / 1024.f) + EPS);
#pragma unroll
                for (int bj = 0; bj < 2; ++bj) { const f32x4 v0 = acc[ai][bj][m][0] * rs, v1 = acc[ai][bj][m][1] * rs;
                    v4u w; w.x = pk2(v0[0], v0[1]); w.y = pk2(v0[2], v0[3]); w.z = pk2(v1[0], v1[1]); w.w = pk2(v1[2], v1[3]);
                    *(v4u*)(O + ((((size_t)(tile * 8 + u.pn) * 2 + bj) * 8 + sidx) * 64 + r32 + 32 * hh) * 8) = w; } }
    }
};

__device__ __forceinline__ void p0_transpose_item(const float* W, int K, int N, bf16* WT, int dst0, LAS float* scr, int kb, int nb, int lane, const float* kscale = nullptr) {
    const int k0 = 64 * kb, n0 = 32 * nb;
#pragma unroll 8
    for (int i = 0; i < 32; ++i) { const int kk = 2 * i + (lane >> 5); float wv_ = W[(size_t)(k0 + kk) * N + n0 + (lane & 31)]; if (kscale) wv_ *= kscale[k0 + kk]; scr[kk * 33 + (lane & 31)] = wv_; }
    asm volatile("s_waitcnt lgkmcnt(0)" ::: "memory");
    const int c = lane & 7;
#pragma unroll
    for (int j = 0; j < 4; ++j) { const int n = (lane >> 3) + 8 * j; const LAS float* s = scr + (8 * c) * 33 + n;
        v4u o; o.x = pk2(s[0 * 33], s[1 * 33]); o.y = pk2(s[2 * 33], s[3 * 33]); o.z = pk2(s[4 * 33], s[5 * 33]); o.w = pk2(s[6 * 33], s[7 * 33]);
        *(v4u*)(WT + (size_t)(dst0 + n) * K + k0 + 8 * c) = o; }
    asm volatile("s_waitcnt lgkmcnt(0)" ::: "memory");
}
__device__ __forceinline__ int glu_row(int n0) {
    if (n0 < 1024) return 256 * (n0 >> 7) + (n0 & 127);
    if (n0 < 2048) { const int n1 = n0 - 1024; return 256 * (n1 >> 7) + 128 + (n1 & 127); }
    if (n0 < 3584) return n0;
    if (n0 < 4608) { const int n1 = n0 - 3584; return 3584 + 256 * (n1 >> 7) + (n1 & 127); }
    { const int n1 = n0 - 4608; return 3584 + 256 * (n1 >> 7) + 128 + (n1 & 127); }
}
__device__ __forceinline__ void cvt_stream(const float* src, bf16* dst, size_t n, size_t gtid, size_t gthreads) {
    for (size_t i = gtid * 8; i < n; i += gthreads * 8) {
        const f32x4 a = *(const f32x4*)(src + i), b = *(const f32x4*)(src + i + 4);
        v4u o; o.x = pk2(a[0], a[1]); o.y = pk2(a[2], a[3]); o.z = pk2(b[0], b[1]); o.w = pk2(b[2], b[3]);
        *(v4u*)(dst + i) = o; }
}
typedef float v16f __attribute__((ext_vector_type(16)));
typedef float v32f __attribute__((ext_vector_type(32)));
typedef unsigned v6u __attribute__((ext_vector_type(6)));
typedef __bf16 v32bf __attribute__((ext_vector_type(32)));
constexpr int E6ROW = 768, E4ROW = 512;
__device__ __forceinline__ void rows_to_fp6(const float* x2rows, unsigned char* o2rows, float* inv_scale2, int lane, const float* cscale, LAS float* scr) {
    const int c = lane & 31, hf = lane >> 5;
    { f32x4 t[8];
#pragma unroll
      for (int i = 0; i < 8; ++i) t[i] = *(const f32x4*)(x2rows + i * 256 + lane * 4);
#pragma unroll
      for (int i = 0; i < 8; ++i) { const int e = i * 256 + lane * 4; *(LAS f32x4*)((LAS unsigned char*)scr + (e >> 5) * 144 + (e & 31) * 4) = t[i]; }
      asm volatile("s_waitcnt lgkmcnt(0)" ::: "memory"); }
    const LAS f32x4* xr = (const LAS f32x4*)((LAS unsigned char*)scr + lane * 144);
    v16f a, b; float am = 0.f;
#pragma unroll
    for (int j = 0; j < 4; ++j) { f32x4 u = xr[j], w = xr[4 + j];
        if (cscale) { u = u * *(const f32x4*)(cscale + c * 32 + 4 * j); w = w * *(const f32x4*)(cscale + c * 32 + 16 + 4 * j); }
#pragma unroll
        for (int k = 0; k < 4; ++k) { am = fmaxf(am, fmaxf(fabsf(u[k]), fabsf(w[k]))); }
        a[2 * j] = u[0]; b[2 * j] = u[1]; a[2 * j + 1] = u[2]; b[2 * j + 1] = u[3];
        a[8 + 2 * j] = w[0]; b[8 + 2 * j] = w[1]; a[8 + 2 * j + 1] = w[2]; b[8 + 2 * j + 1] = w[3]; }
#pragma unroll
    for (int o = 1; o < 32; o <<= 1) am = fmaxf(am, __shfl_xor(am, o));
    am = fmaxf(am, 1e-30f);
    {
        const float s4 = 6.0f / am; unsigned d4[4] = {0u, 0u, 0u, 0u};
#define F4Q(i_) d4[(i_) >> 2] = __builtin_amdgcn_cvt_scalef32_pk_fp4_f32(d4[(i_) >> 2], a[i_] * s4, b[i_] * s4, 1.0f, (i_) & 3)
        F4Q(0); F4Q(1); F4Q(2); F4Q(3); F4Q(4); F4Q(5); F4Q(6); F4Q(7); F4Q(8); F4Q(9); F4Q(10); F4Q(11); F4Q(12); F4Q(13); F4Q(14); F4Q(15);
#undef F4Q
        *(v4u*)(o2rows + (size_t)hf * E4ROW + c * 16) = (v4u){d4[0], d4[1], d4[2], d4[3]};
        if (c == 0) inv_scale2[hf] = am * (1.0f / 6.0f);
        asm volatile("s_waitcnt lgkmcnt(0)" ::: "memory");
    }
}
__device__ __forceinline__ void rms_row_to_bf16(const float* xrow, const float* g, bf16* orow, int lane) {
    const f32x4* xr = (const f32x4*)xrow + lane; const f32x4* gr = (const f32x4*)g + lane;
    f32x4 v[4]; float s = 0.f;
#pragma unroll
    for (int j = 0; j < 4; ++j) { v[j] = xr[64 * j]; s += (v[j][0] * v[j][0] + v[j][1] * v[j][1]) + (v[j][2] * v[j][2] + v[j][3] * v[j][3]); }
    const float rs = 1.0f / sqrtf(wave_sum(s) * (1.f / 1024.f) + EPS);
    v2u* o8 = (v2u*)orow + lane;
#pragma unroll
    for (int j = 0; j < 4; ++j) { const f32x4 gg = gr[64 * j]; v2u o; o.x = pk2(v[j][0] * rs * gg[0], v[j][1] * rs * gg[1]); o.y = pk2(v[j][2] * rs * gg[2], v[j][3] * rs * gg[3]); o8[64 * j] = o; }
}

__device__ __forceinline__ void conv_phase(LAS unsigned char* lds, const bf16* U, bf16* CA, const float* dw_w, const float* dw_b, const float* ln_g, const float* ln_b, int vcu, int G) {
    const int tid = opaque_tid(), lane = tid & 63, wave = tid >> 6;
    const int c0 = 2 * tid;
    constexpr int TT = 32, ROWS = TT + 2 * CPAD, TILE_B = ROWS * 2048;
    f32x2 wv[CK];
#pragma unroll
    for (int j = 0; j < CK; ++j) wv[j] = *(const f32x2*)(dw_w + j * 1024 + c0);
    const f32x2 bi = *(const f32x2*)(dw_b + c0), lg = *(const f32x2*)(ln_g + c0), lb = *(const f32x2*)(ln_b + c0);
    LAS float* red = (LAS float*)(lds + TILE_B);
    LAS float* stat = red + 512;
    const LAS unsigned char* xb = lds + c0 * 2;
    for (int item = vcu; item < BATCH * (SEQ / TT); item += G) {
        const int b = item / (SEQ / TT), t0 = (item % (SEQ / TT)) * TT;
#pragma unroll
        for (int hb = 0; hb < 2; ++hb) {
            v4u val[8];
#pragma unroll
            for (int it = 0; it < 8; ++it) { const int i = tid + (hb * 8 + it) * NTHREADS; const int row = i >> 7, ch = i & 127, tt = t0 - CPAD + row; const bool ok = (i < ROWS * 128) && (tt >= 0) && (tt < SEQ);
                val[it] = *(const v4u*)(U + ((size_t)b * SEQ + (ok ? tt : t0)) * 1024 + ch * 8); if (!ok) val[it] = (v4u){0u, 0u, 0u, 0u}; }
#pragma unroll
            for (int it = 0; it < 8; ++it) { const int i = tid + (hb * 8 + it) * NTHREADS; const int row = i >> 7, ch = i & 127; if (i < ROWS * 128) *(LAS v4u*)(lds + row * 2048 + ch * 16) = val[it]; }
        }
        __syncthreads();
#pragma unroll 1
        for (int rd = 0; rd < 2; ++rd) {
            const LAS unsigned char* xr = xb + rd * 16 * 2048;
            float ac0[16], ac1[16];
#pragma unroll
            for (int t = 0; t < 16; ++t) { ac0[t] = bi[0]; ac1[t] = bi[1]; }
#pragma clang loop unroll(full)
            for (int r = 0; r < 16 + 2 * CPAD; ++r) {
                const unsigned raw = *(const LAS unsigned*)(xr + r * 2048); const float x0 = bflo(raw), x1 = bfhi(raw);
#pragma clang loop unroll(full)
                for (int j = 0; j < CK; ++j) { const int t = r - j; if (t >= 0 && t < 16) { fmac_s(ac0[t], wv[j][0], x0); fmac_s(ac1[t], wv[j][1], x1); } }
            }
            float v[32];
#pragma unroll
            for (int t = 0; t < 16; ++t) { v[2 * t] = ac0[t] + ac1[t]; v[2 * t + 1] = ac0[t] * ac0[t] + ac1[t] * ac1[t]; }
#pragma unroll
            for (int o = 32, n = 16; n >= 1; o >>= 1, n >>= 1) { const bool hi = (lane & o) != 0;
#pragma unroll
                for (int k = 0; k < n; ++k) { const float a = v[k], bb = v[k + n]; const float send = hi ? a : bb, keep = hi ? bb : a; v[k] = keep + __shfl_xor(send, o); } }
            const float rr = v[0] + __shfl_xor(v[0], 1);
            if ((lane & 1) == 0) red[wave * 32 + (lane >> 1)] = rr;
            __syncthreads();
            if (tid < 16) { float s1 = 0.f, s2 = 0.f;
#pragma unroll
                for (int w = 0; w < 8; ++w) { s1 += red[w * 32 + 2 * tid]; s2 += red[w * 32 + 2 * tid + 1]; }
                const float mean = s1 * (1.f / 1024.f); const float var = s2 * (1.f / 1024.f) - mean * mean;
                stat[2 * tid] = mean; stat[2 * tid + 1] = 1.0f / sqrtf(var + EPS); }
            __syncthreads();
            bf16* Cb = CA + ((size_t)b * SEQ + t0 + 16 * rd) * 1024 + c0;
#pragma unroll
            for (int t = 0; t < 16; ++t) { const float mean = stat[2 * t], rstd = stat[2 * t + 1];
                float y0 = (ac0[t] - mean) * rstd * lg[0] + lb[0], y1 = (ac1[t] - mean) * rstd * lg[1] + lb[1];
                y0 = y0 * sigmoidf_(y0); y1 = y1 * sigmoidf_(y1);
                *(unsigned*)(Cb + (size_t)t * 1024) = pk2(y0, y1); }
            __syncthreads();
        }
    }
}

namespace att {
typedef short bf16x8 __attribute__((ext_vector_type(8)));
typedef short s16x4 __attribute__((ext_vector_type(4)));
typedef float f32x16 __attribute__((ext_vector_type(16)));
constexpr int KP = 144, SPAN = 320, VOFF = SPAN * KP, WSTG = 2 * SPAN * KP;
__device__ __forceinline__ s16x4 vtr(const LAS unsigned char* p) { return __builtin_bit_cast(s16x4, __builtin_amdgcn_ds_read_tr16_b64_v4i16((LAS s16x4*)p)); }
__device__ __forceinline__ void attn_phase(LAS unsigned char* lds, const bf16* Q, const bf16* K, const bf16* V, bf16* AO, const float* sink, int vcu, int G) {
    const int tid = opaque_tid(), lane = tid & 63, wave = __builtin_amdgcn_readfirstlane(tid >> 6), r32 = lane & 31, hh = lane >> 5;
    v4u kreg[5], vreg[5];
#define ATT_STAGE_LOAD(UNIT) do { const int qb_ = (UNIT) % (SEQ / 64), kvh_ = ((UNIT) / (SEQ / 64)) % NKV, b_ = (UNIT) / ((SEQ / 64) * NKV); const int t0_ = qb_ * 64, s0_ = t0_ - WIN; \
        _Pragma("unroll") for (int it = 0; it < 5; ++it) { const int i = tid + it * NTHREADS; const int row = i >> 3, ch = i & 7, sp = s0_ + row; const bool ok = (sp >= 0) && (sp < SEQ); \
            const size_t go = ((size_t)b_ * SEQ + (ok ? sp : t0_)) * KVD + kvh_ * 64 + ch * 8; kreg[it] = *(const v4u*)(K + go); vreg[it] = *(const v4u*)(V + go); } } while (0)
    if (vcu < BATCH * NKV * (SEQ / 64)) ATT_STAGE_LOAD(vcu);
    for (int unit = vcu; unit < BATCH * NKV * (SEQ / 64); unit += G) {
        const int qb = unit % (SEQ / 64), kvh = (unit / (SEQ / 64)) % NKV, b = unit / ((SEQ / 64) * NKV);
        const int t0 = qb * 64;
#pragma unroll
        for (int it = 0; it < 5; ++it) { const int i = tid + it * NTHREADS; const int row = i >> 3, ch = i & 7;
            *(LAS v4u*)(lds + row * KP + ch * 16) = kreg[it]; *(LAS v4u*)(lds + VOFF + row * KP + ch * 16) = vreg[it]; }
        if (unit + G < BATCH * NKV * (SEQ / 64)) ATT_STAGE_LOAD(unit + G);
        __syncthreads();
        {
            const int head = kvh * 4 + (wave >> 1), qoff = (wave & 1) * 32, q0 = t0 + qoff;
            const float slope2 = exp2f(-0.5f * (float)(head + 1)) * LOG2E, sink2 = sink[head] * LOG2E;
            LAS unsigned char* stg = lds + WSTG + wave * (32 * KP);
            const size_t qbase = ((size_t)b * SEQ + q0) * 1024 + head * 64;
#pragma unroll
            for (int i = 0; i < 4; ++i) { const int id = i * 64 + lane, row = id >> 3, ch = id & 7; *(LAS v4u*)(stg + row * KP + ch * 16) = *(const v4u*)(Q + qbase + (size_t)row * 1024 + ch * 8); }
            bf16x8 qf[4];
#pragma unroll
            for (int s = 0; s < 4; ++s) qf[s] = *(const LAS bf16x8*)(stg + r32 * KP + (2 * s + hh) * 16);
            float m = sink2, l = (hh == 0) ? 1.0f : 0.0f;
            f32x16 O0, O1, negm;
#pragma unroll
            for (int r = 0; r < 16; ++r) { O0[r] = 0.f; O1[r] = 0.f; negm[r] = -sink2; }
            const int q4 = (lane & 15) >> 2, p4 = lane & 3, g16 = (lane >> 4) & 1;
#pragma unroll 1
            for (int it = 0; it < 9; ++it) {
                const int j = (it & 1) ? 4 - ((it + 1) >> 1) : 4 + (it >> 1);
                const int kt0 = q0 - WIN + 32 * j;
                if (kt0 < 0 || kt0 >= SEQ) continue;
                const int lrow0 = qoff + 32 * j;
                f32x16 sa = negm;
#pragma unroll
                for (int s = 0; s < 4; ++s) { const bf16x8 kf = *(const LAS bf16x8*)(lds + (lrow0 + r32) * KP + 32 * s + 16 * hh); sa = __builtin_amdgcn_mfma_f32_32x32x16_bf16(kf, qf[s], sa, 0, 0, 0); }
                const float cf = (float)(WIN - 32 * j + r32 - 4 * hh);
                if (j == 0 || j == 8) {
#pragma unroll
                    for (int r = 0; r < 16; ++r) { const float d = cf - (float)((r & 3) + 8 * (r >> 2)); float v = fmaf(-slope2, fabsf(d), sa[r]); v = (fabsf(d) > (float)WIN) ? -1e30f : v; sa[r] = v; }
                } else {
#pragma unroll
                    for (int r = 0; r < 16; ++r) { const float d = cf - (float)((r & 3) + 8 * (r >> 2)); sa[r] = fmaf(-slope2, fabsf(d), sa[r]); }
                }
                float tmax = fmaxf(fmaxf(sa[0], sa[1]), sa[2]);
#pragma unroll
                for (int r = 3; r < 15; r += 2) tmax = fmaxf(fmaxf(tmax, sa[r]), sa[r + 1]);
                tmax = fmaxf(tmax, sa[15]);
                if (__any(tmax > 16.0f)) {
                    tmax = fmaxf(tmax, __shfl_xor(tmax, 32));
                    const float dl = fmaxf(tmax, 0.f), alpha = __builtin_amdgcn_exp2f(-dl); m += dl; l *= alpha;
#pragma unroll
                    for (int r = 0; r < 16; ++r) { O0[r] *= alpha; O1[r] *= alpha; sa[r] -= dl; negm[r] = -m; }
                }
                float ls0 = 0.f, ls1 = 0.f;
#pragma unroll
                for (int r = 0; r < 16; r += 2) { sa[r] = __builtin_amdgcn_exp2f(sa[r]); sa[r + 1] = __builtin_amdgcn_exp2f(sa[r + 1]); ls0 += sa[r]; ls1 += sa[r + 1]; }
                l += ls0 + ls1;
                v4u pw0, pw1;
                pw0.x = pk2(sa[0], sa[1]); pw0.y = pk2(sa[2], sa[3]); pw0.z = pk2(sa[4], sa[5]); pw0.w = pk2(sa[6], sa[7]);
                pw1.x = pk2(sa[8], sa[9]); pw1.y = pk2(sa[10], sa[11]); pw1.z = pk2(sa[12], sa[13]); pw1.w = pk2(sa[14], sa[15]);
                const bf16x8 pb0 = __builtin_bit_cast(bf16x8, pw0), pb1 = __builtin_bit_cast(bf16x8, pw1);
                const LAS unsigned char* vb = lds + VOFF + (lrow0 + 4 * hh + q4) * KP + (16 * g16 + 4 * p4) * 2;
#pragma unroll
                for (int s2 = 0; s2 < 2; ++s2) {
                    const s16x4 a0l = vtr(vb + (16 * s2) * KP), a0h = vtr(vb + (16 * s2 + 8) * KP);
                    const s16x4 a1l = vtr(vb + (16 * s2) * KP + 64), a1h = vtr(vb + (16 * s2 + 8) * KP + 64);
                    const bf16x8 A0 = (bf16x8){a0l[0], a0l[1], a0l[2], a0l[3], a0h[0], a0h[1], a0h[2], a0h[3]};
                    const bf16x8 A1 = (bf16x8){a1l[0], a1l[1], a1l[2], a1l[3], a1h[0], a1h[1], a1h[2], a1h[3]};
                    O0 = __builtin_amdgcn_mfma_f32_32x32x16_bf16(A0, s2 ? pb1 : pb0, O0, 0, 0, 0);
                    O1 = __builtin_amdgcn_mfma_f32_32x32x16_bf16(A1, s2 ? pb1 : pb0, O1, 0, 0, 0);
                }
            }
            const float inv = 1.0f / (l + __shfl_xor(l, 32));
#pragma unroll
            for (int g4 = 0; g4 < 4; ++g4) { v2u w0, w1;
                w0.x = pk2(O0[4 * g4] * inv, O0[4 * g4 + 1] * inv); w0.y = pk2(O0[4 * g4 + 2] * inv, O0[4 * g4 + 3] * inv);
                w1.x = pk2(O1[4 * g4] * inv, O1[4 * g4 + 1] * inv); w1.y = pk2(O1[4 * g4 + 2] * inv, O1[4 * g4 + 3] * inv);
                *(LAS v2u*)(stg + r32 * KP + (8 * g4 + 4 * hh) * 2) = w0; *(LAS v2u*)(stg + r32 * KP + (32 + 8 * g4 + 4 * hh) * 2) = w1; }
#pragma unroll
            for (int i = 0; i < 4; ++i) { const int id = i * 64 + lane, row = id >> 3, ch = id & 7; *(v4u*)(AO + qbase + (size_t)row * 1024 + ch * 8) = *(const LAS v4u*)(stg + row * KP + ch * 16); }
        }
        __syncthreads();
    }
}
#undef ATT_STAGE_LOAD
}

namespace tk {
typedef short bf16x8 __attribute__((ext_vector_type(8)));
typedef float f32x16 __attribute__((ext_vector_type(16)));
constexpr int SKP = 272;
#define TK_CAND50(X) X(0,0,0) X(1,0,1) X(2,0,2) X(3,0,3) X(4,0,4) X(5,0,5) X(6,0,6) X(7,0,7) X(8,0,8) X(9,0,9) X(10,0,10) X(11,0,11) X(12,0,12) X(13,0,13) X(14,0,14) X(15,0,15) X(16,1,0) X(17,1,1) X(18,1,2) X(19,1,3) X(20,1,4) X(21,1,5) X(22,1,6) X(23,1,7) X(24,2,0) X(25,2,1) X(26,2,2) X(27,2,3) X(28,2,4) X(29,3,0) X(30,3,1) X(31,3,2) X(32,3,3) X(33,4,0) X(34,4,1) X(35,4,2) X(36,5,0) X(37,5,1) X(38,6,0) X(39,6,1) X(40,7,0) X(41,7,1) X(42,8,0) X(43,9,0) X(44,10,0) X(45,11,0) X(46,12,0) X(47,13,0) X(48,14,0) X(49,15,0)
#define TK_PAIR25(X) X(0,0,0,2,1) X(1,0,1,2,2) X(2,0,2,2,3) X(3,0,3,2,4) X(4,0,4,3,0) X(5,0,5,3,1) X(6,0,6,3,2) X(7,0,7,3,3) X(8,0,8,4,0) X(9,0,9,4,1) X(10,0,10,4,2) X(11,0,11,5,0) X(12,0,12,5,1) X(13,0,13,6,0) X(14,0,14,6,1) X(15,0,15,7,0) X(16,1,0,7,1) X(17,1,1,8,0) X(18,1,2,9,0) X(19,1,3,10,0) X(20,1,4,11,0) X(21,1,5,12,0) X(22,1,6,13,0) X(23,1,7,14,0) X(24,2,0,15,0)
template <int OFF> __device__ __forceinline__ void sort16(float (&v)[64]) {
#pragma unroll
    for (int k = 2; k <= 16; k <<= 1)
#pragma unroll
        for (int j = k >> 1; j > 0; j >>= 1)
#pragma unroll
            for (int i = 0; i < 16; ++i) { const int l = i ^ j; if (l > i) { const float a = v[OFF + i], b = v[OFF + l]; const float hi = fmaxf(a, b), lo = fminf(a, b);
                if ((i & k) == 0) { v[OFF + i] = hi; v[OFF + l] = lo; } else { v[OFF + i] = lo; v[OFF + l] = hi; } } }
}
template <int OFF> __device__ __forceinline__ void merge16(float (&v)[64]) {
#pragma unroll
    for (int j = 8; j > 0; j >>= 1)
#pragma unroll
        for (int i = 0; i < 16; ++i) { const int l = i ^ j; if (l > i) { const float a = v[OFF + i], b = v[OFF + l]; v[OFF + i] = fmaxf(a, b); v[OFF + l] = fminf(a, b); } }
}
template <int A, int B> __device__ __forceinline__ void top16_merge(float (&v)[64]) {
#pragma unroll
    for (int i = 0; i < 16; ++i) v[A + i] = fmaxf(v[A + i], v[B + 15 - i]);
    merge16<A>(v);
}
__device__ __forceinline__ void top16_of_64(float (&v)[64]) {
    sort16<0>(v); sort16<16>(v); sort16<32>(v); sort16<48>(v);
    top16_merge<0, 16>(v); top16_merge<32, 48>(v); top16_merge<0, 32>(v);
}
__device__ __forceinline__ void topk_phase(LAS unsigned char* lds, const bf16* QP, const bf16* SKb, int* IDX, float* GATE, int vcu, int G) {
    const int tid = opaque_tid(), lane = tid & 63, wave = __builtin_amdgcn_readfirstlane(tid >> 6), r32 = lane & 31, hh = lane >> 5;
    for (int i = tid; i < 256 * 16; i += NTHREADS) { const int row = i >> 4, ch = i & 15; *(LAS v4u*)(lds + row * SKP + ch * 16) = *(const v4u*)(SKb + row * 128 + ch * 8); }
    __syncthreads();
    for (int unit = vcu * NWAVES + wave; unit < (M / 32) * PHD; unit += G * NWAVES) {
        const int tile = unit >> 3, h = unit & 7; const int tok = tile * 32 + r32;
        float L[2][16];
#pragma unroll
        for (int p = 0; p < 2; ++p) {
            bf16x8 qf[8];
#pragma unroll
            for (int sidx = 0; sidx < 8; ++sidx) qf[sidx] = *(const bf16x8*)(QP + ((((size_t)(tile * 8 + h) * 2 + p) * 8 + sidx) * 64 + lane) * 8);
            float v[64];
#define TK_KT(kt) { f32x16 acc; \
                _Pragma("unroll") for (int r = 0; r < 16; ++r) acc[r] = 0.f; \
                _Pragma("unroll") for (int sidx = 0; sidx < 8; ++sidx) { const bf16x8 kf = *(const LAS bf16x8*)(lds + (p * 128 + 32 * kt + r32) * SKP + 32 * sidx + 16 * hh); acc = __builtin_amdgcn_mfma_f32_32x32x16_bf16(kf, qf[sidx], acc, 0, 0, 0); } \
                _Pragma("unroll") for (int r = 0; r < 16; ++r) { const unsigned kidx = (unsigned)(32 * kt + (r & 3) + 8 * (r >> 2)); v[16 * kt + r] = __uint_as_float(((__float_as_uint(acc[r]) & 0xffffff80u) | (unsigned)(hh << 2)) | kidx); } \
                sort16<16 * kt>(v); __builtin_amdgcn_sched_barrier(0); }
            TK_KT(0) TK_KT(1) top16_merge<0, 16>(v); __builtin_amdgcn_sched_barrier(0);
            TK_KT(2) TK_KT(3) top16_merge<32, 48>(v); __builtin_amdgcn_sched_barrier(0);
            top16_merge<0, 32>(v); __builtin_amdgcn_sched_barrier(0);
#undef TK_KT
            float t[16];
#pragma unroll
            for (int i = 0; i < 16; ++i) t[i] = __shfl_xor(v[15 - i], 32);
#pragma unroll
            for (int i = 0; i < 16; ++i) v[i] = fmaxf(v[i], t[i]);
            merge16<0>(v);
#pragma unroll
            for (int i = 0; i < 16; ++i) L[p][i] = v[i];
        }
        float sm[25];
#define X(c, i0, j0, i1, j1) { const float s0 = L[0][i0] + L[1][j0], s1 = L[0][i1] + L[1][j1]; sm[c] = hh ? s1 : s0; }
        TK_PAIR25(X)
#undef X
        float v[64];
#pragma unroll
        for (int c = 0; c < 25; ++c) v[c] = sm[c];
#pragma unroll
        for (int c = 25; c < 32; ++c) v[c] = -3.0e38f;
        sort16<0>(v); sort16<16>(v); top16_merge<0, 16>(v);
        float T;
        { float t[16];
#pragma unroll
          for (int i = 0; i < 16; ++i) t[i] = __shfl_xor(v[15 - i], 32);
#pragma unroll
          for (int i = 0; i < 16; ++i) t[i] = fmaxf(v[i], t[i]);
          T = fminf(fminf(t[0], t[1]), t[2]);
#pragma unroll
          for (int i = 3; i < 15; i += 2) T = fminf(fminf(T, t[i]), t[i + 1]);
          T = fminf(T, t[15]); }
        const float smax = L[0][0] + L[1][0];
        unsigned ia[16], ib[16];
#pragma unroll
        for (int i = 0; i < 16; ++i) { ia[i] = (__float_as_uint(L[0][i]) & 127u) << 7; ib[i] = __float_as_uint(L[1][i]) & 127u; }
        float pe[25]; float den = 0.f; int cnt = 0;
#pragma unroll
        for (int c = 0; c < 25; ++c) { const bool sel = sm[c] >= T; const float e = __builtin_amdgcn_exp2f((sm[c] - smax) * LOG2E); pe[c] = e; den += sel ? e : 0.f; cnt += sel ? 1 : 0; }
        den += __shfl_xor(den, 32);
        const int ocnt = __shfl_xor(cnt, 32);
        int pos = hh ? ocnt : 0;
        const float inv = 1.0f / den;
        LAS float* lg = (LAS float*)(lds + 256 * SKP + wave * 4096); LAS int* li = (LAS int*)(lg + 512);
#define X(c, i0, j0, i1, j1) { const unsigned e0 = ia[i0] + ib[j0], e1 = ia[i1] + ib[j1]; const unsigned em = hh ? e1 : e0; \
            const bool sel = sm[c] >= T; \
            if (sel && pos < 16) { lg[r32 * 16 + pos] = pe[c] * inv; li[r32 * 16 + pos] = (int)em; } \
            pos += sel ? 1 : 0; }
        TK_PAIR25(X)
#undef X
        asm volatile("s_waitcnt lgkmcnt(0)" ::: "memory");
#pragma unroll
        for (int rr = 0; rr < 2; ++rr) { const int tl = rr * 16 + (lane >> 2), pg = lane & 3; const size_t ob = (size_t)(tile * 32 + tl) * 128 + h * 16 + 4 * pg;
            *(f32x4*)(GATE + ob) = *(const LAS f32x4*)(lg + tl * 16 + 4 * pg); *(v4u*)(IDX + ob) = *(const LAS v4u*)(li + tl * 16 + 4 * pg); }
        asm volatile("s_waitcnt lgkmcnt(0)" ::: "memory");
    }
}
}

__device__ __forceinline__ float dot2bf(unsigned a, unsigned b, float c) { return __builtin_amdgcn_fdot2_f32_bf16(__builtin_bit_cast(bf16x2_t, a), __builtin_bit_cast(bf16x2_t, b), c, false); }
__device__ __forceinline__ float gelu_erf(float x) { return 0.5f * x * (1.0f + erff(x * 0.70710678118654752f)); }
typedef int v8i __attribute__((ext_vector_type(8)));
typedef int v4i __attribute__((ext_vector_type(4)));
__device__ __forceinline__ void gather_phase(LAS unsigned char* lds, const bf16* XG2, const float* SSQ, const unsigned char* EU, const unsigned char* EV, const float* SU, const float* SV, const int* IDX, const float* GATE, float* WGT, const float* fg, float* OUT, int vcu, int G) {
    const int tid = opaque_tid(), lane = tid & 63, wave = tid >> 6, c32 = lane & 31, hf = lane >> 5;
    const int emap = 16 * (lane & 3) + 2 * ((lane >> 2) & 7) + hf;
    const unsigned loff = (unsigned)c32 * 16u;
    struct __attribute__((packed, aligned(4))) U6 { unsigned d[6]; };
    {
    constexpr int RPITCH = 528, WLDS = 3072 + 16 * RPITCH;
    const int wv = __builtin_amdgcn_readfirstlane(wave);
    LAS unsigned char* wl_ = lds + wv * WLDS;
    LAS unsigned char* rb = wl_ + 3072;
    const int r16 = lane & 15, q4 = lane >> 4;
    const unsigned char* eul = EU + lane * 16;
#define DMA_HEAD(idxv_, hh_) do { if (lane < 32) { _Pragma("unroll") for (int r_ = 0; r_ < 16; ++r_) { const int si_ = __builtin_amdgcn_readlane((idxv_), ((hh_) & 3) * 16 + r_); \
        __builtin_amdgcn_global_load_lds((const unsigned*)(eul + (size_t)si_ * E4ROW), (LAS unsigned*)(rb + r_ * RPITCH), 16, 0, 0); } } } while (0)
    const int tok0 = vcu * NWAVES + wave;
    int nidx0 = 0, nidx1 = 0;
    if (tok0 < M) { nidx0 = IDX[(size_t)tok0 * 128 + lane]; nidx1 = IDX[(size_t)tok0 * 128 + 64 + lane]; }
    for (int tok = tok0; tok < M; tok += G * NWAVES) {
        const int idx0 = nidx0, idx1 = nidx1;
        DMA_HEAD(idx0, 0);
        { const int nt = tok + G * NWAVES; if (nt < M) { nidx0 = IDX[(size_t)nt * 128 + lane]; nidx1 = IDX[(size_t)nt * 128 + 64 + lane]; } }
        const float rs2 = 1.0f / sqrtf(SSQ[tok] * (1.f / 1024.f) + EPS);
        { const v4u* hp = (const v4u*)(XG2 + (size_t)tok * 1024 + lane * 16); const v4u w0 = hp[0], w1 = hp[1];
          const unsigned ww[8] = {w0.x, w0.y, w0.z, w0.w, w1.x, w1.y, w1.z, w1.w};
          float xv[16];
#pragma unroll
          for (int j = 0; j < 8; ++j) { xv[2 * j] = bflo(ww[j]) * rs2; xv[2 * j + 1] = bfhi(ww[j]) * rs2; }
          unsigned hi4[4], lo4[4];
#pragma unroll
          for (int j = 0; j < 4; ++j) {
              const float x0 = xv[4 * j], x1 = xv[4 * j + 1], x2 = xv[4 * j + 2], x3 = xv[4 * j + 3];
              int h = __builtin_amdgcn_cvt_pk_fp8_f32(x0, x1, 0, false); h = __builtin_amdgcn_cvt_pk_fp8_f32(x2, x3, h, true);
              const float r0 = x0 - __builtin_amdgcn_cvt_f32_fp8(h, 0), r1 = x1 - __builtin_amdgcn_cvt_f32_fp8(h, 1), r2 = x2 - __builtin_amdgcn_cvt_f32_fp8(h, 2), r3 = x3 - __builtin_amdgcn_cvt_f32_fp8(h, 3);
              int l = __builtin_amdgcn_cvt_pk_fp8_f32(r0, r1, 0, false); l = __builtin_amdgcn_cvt_pk_fp8_f32(r2, r3, l, true);
              hi4[j] = (unsigned)h; lo4[j] = (unsigned)l; }
          *(LAS v4u*)(wl_ + lane * 16) = (v4u){hi4[0], hi4[1], hi4[2], hi4[3]}; *(LAS v4u*)(wl_ + 1024 + lane * 16) = (v4u){lo4[0], lo4[1], lo4[2], lo4[3]};
        }
        const float g0 = GATE[(size_t)tok * 128 + lane], g1 = GATE[(size_t)tok * 128 + 64 + lane];
        const float su0 = SU[idx0], su1 = SU[idx1], sv0 = SV[idx0], sv1 = SV[idx1];
        v8i Bx[8];
        {
          const LAS unsigned char* bpa = wl_ + (r16 == 1 ? 1024 : 0) + 256 * (q4 >> 1) + 16 * (q4 & 1); const LAS unsigned char* bpb = bpa + 512;
#pragma unroll
          for (int s = 0; s < 8; ++s) { const v4u a = *(const LAS v4u*)(bpa + s * 32), b = *(const LAS v4u*)(bpb + s * 32);
              Bx[s] = (v8i){(int)a.x, (int)a.y, (int)a.z, (int)a.w, (int)b.x, (int)b.y, (int)b.z, (int)b.w}; } }
#pragma unroll
        for (int h = 0; h < 8; ++h) {
            asm volatile("s_waitcnt vmcnt(0)" ::: "memory");
            const LAS v4i* lp = (const LAS v4i*)(rb + r16 * RPITCH + q4 * 128);
            v4i L[8];
#pragma unroll
            for (int i = 0; i < 8; ++i) L[i] = lp[i];
            asm volatile("s_waitcnt lgkmcnt(0)" ::: "memory");
            __builtin_amdgcn_sched_barrier(0);
            if (h < 7) DMA_HEAD(h + 1 < 4 ? idx0 : idx1, h + 1);
            __builtin_amdgcn_sched_barrier(0);
            f32x4 acc = {0.f, 0.f, 0.f, 0.f};
#pragma unroll
            for (int s = 0; s < 8; ++s) {
                const v8i A = __builtin_shufflevector(L[s], L[s], 0, 1, 2, 3, -1, -1, -1, -1);
                acc = __builtin_amdgcn_mfma_scale_f32_16x16x128_f8f6f4(A, Bx[s], acc, 4, 0, 0, 0, 0, 0);
            }
            if (r16 < 2) *(LAS f32x4*)(wl_ + 2048 + r16 * 512 + (h * 16 + 4 * q4) * 4) = acc;
        }
        const float d0 = *(const LAS float*)(wl_ + 2048 + lane * 4) + *(const LAS float*)(wl_ + 2560 + lane * 4);
        const float d1 = *(const LAS float*)(wl_ + 2048 + 256 + lane * 4) + *(const LAS float*)(wl_ + 2560 + 256 + lane * 4);
        WGT[(size_t)tok * 128 + lane] = g0 * gelu_erf(d0 * su0) * sv0;
        WGT[(size_t)tok * 128 + 64 + lane] = g1 * gelu_erf(d1 * su1) * sv1;
    }
#undef DMA_HEAD
    }
    for (int tok = vcu * NWAVES + wave; tok < M; tok += G * NWAVES) {
        int idxl[2]; float wl[2];
#pragma unroll
        for (int blk = 0; blk < 2; ++blk) { idxl[blk] = IDX[(size_t)tok * 128 + blk * 64 + emap]; wl[blk] = WGT[(size_t)tok * 128 + blk * 64 + emap]; }
        v32f acc;
#pragma unroll
        for (int k = 0; k < 32; ++k) acc[k] = 0.f;
#pragma unroll
        for (int blk = 0; blk < 2; ++blk) {
#pragma unroll 1
            for (int bt = 0; bt < 4; ++bt) {
                v4u vr[8];
#pragma unroll
                for (int i = 0; i < 8; ++i) { const int pr = bt * 8 + i; const int ia = __builtin_amdgcn_readlane(idxl[blk], pr), ib = __builtin_amdgcn_readlane(idxl[blk], 32 + pr);
                    vr[i] = *(const v4u*)(EV + (size_t)(hf ? ib : ia) * E4ROW + loff); }
#pragma unroll
                for (int i = 0; i < 8; ++i) { const int pr = bt * 8 + i;
                    const int wa = __builtin_amdgcn_readlane((int)__float_as_uint(wl[blk]), pr), wb = __builtin_amdgcn_readlane((int)__float_as_uint(wl[blk]), 32 + pr);
                    const float w = __uint_as_float((unsigned)(hf ? wb : wa));
                    v32f rv;
#define F4D(j_) { const f32x2 p_ = __builtin_amdgcn_cvt_scalef32_pk_f32_fp4(vr[i][(j_) >> 2], 1.0f, (j_) & 3); rv[2 * (j_)] = p_[0]; rv[2 * (j_) + 1] = p_[1]; }
                    F4D(0) F4D(1) F4D(2) F4D(3) F4D(4) F4D(5) F4D(6) F4D(7) F4D(8) F4D(9) F4D(10) F4D(11) F4D(12) F4D(13) F4D(14) F4D(15)
#undef F4D
                    acc = acc + rv * w; }
            }
        }
        float o16[16];
#pragma unroll
        for (int k = 0; k < 16; ++k) { const float lo = acc[k], hi = acc[16 + k]; const float mine = hf ? hi : lo, other = hf ? lo : hi; o16[k] = mine + __shfl_xor(other, 32); }
        const size_t co = (size_t)tok * 1024 + c32 * 32 + hf * 16;
        float* orow = OUT + co; float ss = 0.f; f32x4 x2[4];
        { const v4u* xp = (const v4u*)(XG2 + co); const v4u w0 = xp[0], w1 = xp[1];
          x2[0] = (f32x4){bflo(w0.x) + o16[0], bfhi(w0.x) + o16[1], bflo(w0.y) + o16[2], bfhi(w0.y) + o16[3]};
          x2[1] = (f32x4){bflo(w0.z) + o16[4], bfhi(w0.z) + o16[5], bflo(w0.w) + o16[6], bfhi(w0.w) + o16[7]};
          x2[2] = (f32x4){bflo(w1.x) + o16[8], bfhi(w1.x) + o16[9], bflo(w1.y) + o16[10], bfhi(w1.y) + o16[11]};
          x2[3] = (f32x4){bflo(w1.z) + o16[12], bfhi(w1.z) + o16[13], bflo(w1.w) + o16[14], bfhi(w1.w) + o16[15]}; }
#pragma unroll
        for (int j = 0; j < 4; ++j) ss += (x2[j][0] * x2[j][0] + x2[j][1] * x2[j][1]) + (x2[j][2] * x2[j][2] + x2[j][3] * x2[j][3]);
        const float rs = 1.0f / sqrtf(wave_sum(ss) * (1.f / 1024.f) + EPS);
#pragma unroll
        for (int j = 0; j < 4; ++j) { const f32x4 g4 = *(const f32x4*)(fg + c32 * 32 + hf * 16 + 4 * j); *(f32x4*)(orow + 4 * j) = x2[j] * rs * g4; }
    }
}

#define RLX_AGENT __ATOMIC_RELAXED, __HIP_MEMORY_SCOPE_AGENT
#define XB_TMO      128
#define XB_XCNT(j)  (256  + 64 * (j))
#define XB_XSUB(j)  (1280 + 64 * (j))
#define XB_XGEN(j)  (2304 + 64 * (j))
#define XB_TOP      3328
#define XB_TOPGEN   3392
#define XCD_BAR_WORDS 3456
#define XB_SPIN_CAP (1u << 18)

__device__ __forceinline__ unsigned xb_ld(unsigned* p)              { return __hip_atomic_load(p, __ATOMIC_RELAXED, __HIP_MEMORY_SCOPE_AGENT); }
__device__ __forceinline__ unsigned xb_add(unsigned* p, unsigned v) { return __hip_atomic_fetch_add(p, v, __ATOMIC_RELAXED, __HIP_MEMORY_SCOPE_AGENT); }
__device__ __forceinline__ unsigned xb_xcc_id() { return (unsigned)__builtin_amdgcn_s_getreg((3 << 11) | 20) & 0xFu; }
#define XB_SPIN(cond, bar) do { unsigned _sp = 0; while (cond) { __builtin_amdgcn_s_sleep(1); \
    if ((++_sp & 255u) == 0u) { if (xb_ld(&(bar)[XB_TMO])) break; if (_sp > XB_SPIN_CAP) { atomicAdd(&(bar)[XB_TMO], 1u); break; } } } } while (0)

struct XcdBarrier {
    unsigned* bar; unsigned x;
    volatile LAS unsigned* st;
};

__device__ __forceinline__ XcdBarrier xcd_barrier_post(unsigned* bar, volatile LAS unsigned* st) {
    XcdBarrier b; b.bar = bar; b.x = xb_xcc_id(); b.st = st;
    if (threadIdx.x == 0) (void)xb_add(&bar[XB_XCNT(b.x)], 1u);
    return b;
}
__device__ __forceinline__ void xcd_barrier_complete(unsigned* bar, unsigned x, unsigned& nloc, unsigned& nx) {
    const unsigned G = gridDim.x * gridDim.y * gridDim.z;
    unsigned sum, cnt, mine, sp = 0u;
    for (;;) {
        sum = 0u; cnt = 0u; mine = 0u;
#pragma unroll
        for (unsigned j = 0; j < 16; ++j) { const unsigned c = xb_ld(&bar[XB_XCNT(j)]); sum += c; cnt += (c > 0u) ? 1u : 0u; mine = (j == x) ? c : mine; }
        if (sum == G) break;
        __builtin_amdgcn_s_sleep(1);
        if ((++sp & 255u) == 0u) { if (xb_ld(&bar[XB_TMO])) break; if (sp > XB_SPIN_CAP) { atomicAdd(&bar[XB_TMO], 1u); break; } }
    }
    nloc = mine > 0u ? mine : 1u; nx = cnt > 0u ? cnt : 1u;
}

__device__ __forceinline__ void xcd_barrier(const XcdBarrier& b) {
    asm volatile("s_waitcnt vmcnt(0)" ::: "memory");
    __syncthreads();
    if (threadIdx.x == 0) {
        unsigned* bar = b.bar;
        __builtin_amdgcn_s_waitcnt(0);
        unsigned nloc = b.st[0], nx = b.st[1];
        if (nloc == 0u) { xcd_barrier_complete(bar, b.x, nloc, nx); b.st[0] = nloc; b.st[1] = nx; }
        const unsigned old = xb_add(&bar[XB_XSUB(b.x)], 1u);
        const unsigned gen = old / nloc;
        if (old + 1u == (gen + 1u) * nloc) {
            __builtin_amdgcn_fence(__ATOMIC_RELEASE, "agent");
            asm volatile("s_waitcnt vmcnt(0)" ::: "memory");
            const unsigned og = xb_add(&bar[XB_TOP], 1u);
            const unsigned tg = og / nx;
            if (og + 1u == (tg + 1u) * nx) xb_add(&bar[XB_TOPGEN], 1u);
            else XB_SPIN(xb_ld(&bar[XB_TOPGEN]) == tg, bar);
            __builtin_amdgcn_fence(__ATOMIC_ACQUIRE, "agent");
            xb_add(&bar[XB_XGEN(b.x)], 1u);
            asm volatile("s_waitcnt vmcnt(0)" ::: "memory");
        } else {
            XB_SPIN(xb_ld(&bar[XB_XGEN(b.x)]) == gen, bar);
            __builtin_amdgcn_fence(__ATOMIC_ACQUIRE, "agent");
            asm volatile("s_waitcnt vmcnt(0)" ::: "memory");
        }
    }
    __syncthreads();
}


__global__ void __launch_bounds__(NTHREADS, 2) fwd_kernel(Args args) {
    extern __shared__ __attribute__((aligned(16))) unsigned char lds[];
    const int tid = threadIdx.x, lane = tid & 63, wave = __builtin_amdgcn_readfirstlane(tid >> 6);
    const int G = gridDim.x, bx = blockIdx.x;
    const int vcu = (G % 8 == 0) ? (bx % 8) * (G / 8) + bx / 8 : bx;
    unsigned char* ws = args.ws;
    const float* x = args.in[0];
    bf16* WinT = (bf16*)(ws + WS_WIN); bf16* WpwT = (bf16*)(ws + WS_WPW); bf16* WoT = (bf16*)(ws + WS_WO); bf16* WoutT = (bf16*)(ws + WS_WOUT); bf16* WqT = (bf16*)(ws + WS_WQ);
    unsigned char* EU = ws + WS_EU; unsigned char* EV = ws + WS_EV; float* SU = (float*)(ws + WS_ESC); float* SV = SU + NEXP; float* SSQ = SV + NEXP; bf16* SKb = (bf16*)(ws + WS_SK);
    bf16* XN = (bf16*)(ws + WS_XN); bf16* Ub = (bf16*)(ws + WS_U); bf16* MG = (bf16*)(ws + WS_MG); bf16* XG2 = (bf16*)(ws + WS_XG2);
    bf16* Gt = (bf16*)(ws + WS_G); bf16* QP = (bf16*)(ws + WS_QP);
    bf16* Qb = (bf16*)(ws + WS_Q); bf16* Kb = (bf16*)(ws + WS_K); bf16* Vb = (bf16*)(ws + WS_V);
    int* IDX = (int*)(ws + WS_IDX); float* GATE = (float*)(ws + WS_GATE);
    bf16* CA = (bf16*)(ws + WS_CA);
    LAS unsigned char* lds3 = (LAS unsigned char*)lds;
    const int lo = args.ph_lo, hi = args.ph_hi;
    volatile LAS unsigned* MISC = (volatile LAS unsigned*)(lds3 + MISC_OFF);
    if (tid < 32) MISC[tid] = 0u;
    __syncthreads();
    XcdBarrier bar_; bar_.bar = (unsigned*)(ws + WS_CTL) + CW_BAR; bar_.x = 0; bar_.st = nullptr;
    if (hi - lo > 1) bar_ = xcd_barrier_post((unsigned*)(ws + WS_CTL) + CW_BAR, MISC + 8);
#define SEAM(k) do { if (IN(k) && IN((k) + 1)) xcd_barrier(bar_); } while (0)
#ifdef ONLY_PHASE
#define IN(k) ((k) == ONLY_PHASE && lo <= (k) && (k) < hi)
#else
#define IN(k) (lo <= (k) && (k) < hi)
#endif

    if (IN(0)) {
        LAS float* scr = (LAS float*)(lds3 + wave * 16384);
        const int gw = vcu * NWAVES + wave, NGW = G * NWAVES;
        constexpr int I_IN = 16 * (IN_DIM / 32), I_SQ = 16 * 32, I_Q = 16 * 64;
        constexpr int NITEMS = I_IN + 3 * I_SQ + I_Q;
        for (int it = gw; it < NITEMS; it += NGW) {
            int r = it;
            if (r < I_IN) { const int nblk = IN_DIM / 32, kb = r / nblk, nb = r % nblk; p0_transpose_item(args.in[2], D, IN_DIM, WinT, glu_row(32 * nb), scr, kb, nb, lane); continue; } r -= I_IN;
            if (r < I_SQ) { p0_transpose_item(args.in[7], D, D, WpwT, 32 * (r % 32), scr, r / 32, r % 32, lane); continue; } r -= I_SQ;
            if (r < I_SQ) { p0_transpose_item(args.in[9], D, D, WoT, 32 * (r % 32), scr, r / 32, r % 32, lane); continue; } r -= I_SQ;
            if (r < I_SQ) { p0_transpose_item(args.in[10], D, D, WoutT, 32 * (r % 32), scr, r / 32, r % 32, lane); continue; } r -= I_SQ;
            p0_transpose_item(args.in[12], D, 2048, WqT, 32 * (r % 64), scr, r / 64, r % 64, lane, args.in[11]);
        }
        const size_t gt = (size_t)vcu * NTHREADS + tid, ngt = (size_t)G * NTHREADS;
        for (size_t i = gt; i < (size_t)M; i += ngt) SSQ[i] = 0.f;
        cvt_stream(args.in[13], SKb, (size_t)2 * NKEYS * PHALF, gt, ngt);
        for (int r = gw; r < NEXP; r += NGW) { const int tb = r >= NEXP / 2, e = 2 * (r - tb * (NEXP / 2)); rows_to_fp6(args.in[14 + tb] + (size_t)e * D, (tb ? EV : EU) + (size_t)e * E4ROW, (tb ? SV : SU) + e, lane, tb ? nullptr : args.in[11], scr); }
        for (int m = gw; m < M; m += 4 * NGW) {
            f32x4 v[4][4]; float ssr[4];
#pragma unroll
            for (int r = 0; r < 4; ++r) { const f32x4* xr = (const f32x4*)(x + (size_t)(m + r * NGW) * D) + lane;
#pragma unroll
                for (int j = 0; j < 4; ++j) v[r][j] = xr[64 * j]; }
#pragma unroll
            for (int r = 0; r < 4; ++r) { float q = 0.f;
#pragma unroll
                for (int j = 0; j < 4; ++j) q += (v[r][j][0] * v[r][j][0] + v[r][j][1] * v[r][j][1]) + (v[r][j][2] * v[r][j][2] + v[r][j][3] * v[r][j][3]);
                ssr[r] = q; }
#pragma unroll
            for (int o = 1; o < 64; o <<= 1) {
#pragma unroll
                for (int r = 0; r < 4; ++r) ssr[r] += __shfl_xor(ssr[r], o); }
#pragma unroll
            for (int r = 0; r < 4; ++r) { const float rs = 1.0f / sqrtf(ssr[r] * (1.f / 1024.f) + EPS); v2u* o8 = (v2u*)(XN + (size_t)(m + r * NGW) * D) + lane;
#pragma unroll
                for (int j = 0; j < 4; ++j) { const f32x4 gg = ((const f32x4*)args.in[1])[lane + 64 * j]; v2u o; o.x = pk2(v[r][j][0] * rs * gg[0], v[r][j][1] * rs * gg[1]); o.y = pk2(v[r][j][2] * rs * gg[2], v[r][j][3] * rs * gg[3]); o8[64 * j] = o; } }
        }
    }
    SEAM(0);
    if (IN(1)) {
        pg8::Gemm g{XN, WinT, XN, WinT, M, IN_DIM, D}; pg8::StaticOrder S; S.init(M, IN_DIM, G, bx, 1);
        EpiInProj E{Ub, Qb, Kb, Vb, Gt};
        pg8::gemm_phase<EpiInProj>(lds3, g, S, E);
    }
    SEAM(1);
    if (IN(2)) {
        conv_phase(lds3, Ub, CA, args.in[3], args.in[4], args.in[5], args.in[6], vcu, G);
        __syncthreads();
        att::attn_phase(lds3, Qb, Kb, Vb, Qb, args.in[8], vcu, G);
    }
    SEAM(2);
    if (IN(3)) {
        pg8::Gemm g{CA, WpwT, Qb, WoT, M, D, D}; pg8::StaticOrder S; S.init(M, D, G, bx, 2);
        EpiMerge E{Gt, MG};
        pg8::gemm_phase<EpiMerge>(lds3, g, S, E);
    }
    SEAM(3);
    if (IN(4)) {
        pg8::Gemm g{MG, WoutT, MG, WoutT, M, D, D}; pg8::StaticOrder S; S.init(M, D, G, bx, 1);
        EpiResid E{x, XG2, SSQ};
        pg8::gemm_phase<EpiResid>(lds3, g, S, E);
    }
    SEAM(4);
    if (IN(5)) {
        pg8::Gemm g{XG2, WqT, XG2, WqT, M, 2048, D}; pg8::StaticOrder S; S.init(M, 2048, G, bx, 1);
        EpiBf16Rs E{QP, SSQ};
        pg8::gemm_phase<EpiBf16Rs>(lds3, g, S, E);
    }
    SEAM(5);
    if (IN(6)) tk::topk_phase(lds3, QP, SKb, IDX, GATE, vcu, G);
    SEAM(6);
    if (IN(7)) gather_phase(lds3, XG2, SSQ, EU, EV, SU, SV, IDX, GATE, GATE, args.in[16], args.out, vcu, G);
#undef IN
#undef SEAM
}

extern "C" void kernel_launch(void* const* d_in, const int* in_sizes, int n_in, void* d_out, int out_size, void* d_ws, size_t ws_size, hipStream_t stream) {
    static int grid = 0;
    if (grid == 0) {
        if (n_in != 17 || in_sizes[0] != M * D || out_size != M * D || ws_size < WS_END) { fprintf(stderr, "kernel_launch: unexpected shapes (n_in %d, in0 %d, out %d, ws %zu)\n", n_in, n_in > 0 ? in_sizes[0] : -1, out_size, ws_size); grid = -1; return; }
        int dev = 0, cus = 0;
        if (hipGetDevice(&dev) != hipSuccess || hipDeviceGetAttribute(&cus, hipDeviceAttributeMultiprocessorCount, dev) != hipSuccess) { grid = -1; return; }
        if (hipFuncSetAttribute((const void*)fwd_kernel, hipFuncAttributeMaxDynamicSharedMemorySize, LDS_BYTES) != hipSuccess) { fprintf(stderr, "kernel_launch: hipFuncSetAttribute failed\n"); grid = -1; return; }
        int per_cu = 0;
        if (hipOccupancyMaxActiveBlocksPerMultiprocessor(&per_cu, (const void*)fwd_kernel, NTHREADS, LDS_BYTES) != hipSuccess || per_cu < 1) { fprintf(stderr, "kernel_launch: occupancy query says %d\n", per_cu); }
        (void)hipGetLastError();
        grid = cus;
    }
    if (grid < 0) return;
    Args a{};
    for (int i = 0; i < 17; ++i) a.in[i] = (const float*)d_in[i];
    a.out = (float*)d_out; a.ws = (unsigned char*)d_ws;
    if (MK_N_LAUNCHES == 1) {
        a.ph_lo = 0; a.ph_hi = 8;
        if (hipMemsetAsync((char*)d_ws + WS_CTL, 0, CTL_ZERO_BYTES, stream) != hipSuccess) { fprintf(stderr, "kernel_launch: memset failed\n"); return; }
        hipLaunchKernelGGL(fwd_kernel, dim3(grid), dim3(NTHREADS), LDS_BYTES, stream, a);
    } else {
        for (int p = 0; p < 8; ++p) {
            a.ph_lo = p; a.ph_hi = p + 1;
            hipLaunchKernelGGL(fwd_kernel, dim3(grid), dim3(NTHREADS), LDS_BYTES, stream, a);
        }
    }
}
```

```cpp
#include <hip/hip_runtime.h>
#include <cstdio>
#include <cstdint>

#ifndef MK_N_LAUNCHES
#define MK_N_LAUNCHES 1
#endif

constexpr int BATCH = 16, SEQ = 2048, D = 1024, M = BATCH * SEQ;
constexpr int CK = 31, CPAD = 15;
constexpr int NH = 16, NKV = 4, HD = 64, KVD = 256, WIN = 128;
constexpr int IN_DIM = 5632;
constexpr int PHD = 8, PKD = 256, PHALF = 128, NKEYS = 128, NEXP = 16384, TOPK = 16;
constexpr float EPS = 1e-6f;
constexpr int NWAVES = 8, NTHREADS = 512;
constexpr float LOG2E = 1.4426950408889634f, QSCALE = 0.125f * 1.4426950408889634f;

typedef unsigned short bf16;
typedef unsigned v4u __attribute__((ext_vector_type(4)));
typedef unsigned v2u __attribute__((ext_vector_type(2)));
typedef float f32x4 __attribute__((ext_vector_type(4)));
typedef float f32x2 __attribute__((ext_vector_type(2)));
typedef __bf16 bf16x2_t __attribute__((ext_vector_type(2)));
#define LAS __attribute__((address_space(3)))

__device__ __forceinline__ int opaque_tid() { int t = threadIdx.x; asm volatile("" : "+v"(t)); return t; }
__device__ __forceinline__ void fmac_s(float& acc, float a, float b) { asm volatile("v_fmac_f32 %0, %1, %2" : "+v"(acc) : "v"(a), "v"(b)); }
__device__ __forceinline__ void mul_s(float& x, float a) { asm volatile("v_mul_f32 %0, %0, %1" : "+v"(x) : "v"(a)); }
__device__ __forceinline__ unsigned pk2(float lo, float hi) { f32x2 v = {lo, hi}; bf16x2_t b = __builtin_convertvector(v, bf16x2_t); return __builtin_bit_cast(unsigned, b); }
__device__ __forceinline__ float bflo(unsigned u) { return __uint_as_float(u << 16); }
__device__ __forceinline__ float bfhi(unsigned u) { return __uint_as_float(u & 0xffff0000u); }
__device__ __forceinline__ float sigmoidf_(float x) { return __builtin_amdgcn_rcpf(1.0f + __builtin_amdgcn_exp2f(x * -1.4426950408889634f)); }
__device__ __forceinline__ float wave_sum(float v) {
#pragma unroll
    for (int o = 1; o < 64; o <<= 1) v += __shfl_xor(v, o);
    return v;
}

namespace pg8 {
typedef unsigned short bf16_t;
typedef short bf16x8 __attribute__((ext_vector_type(8)));
constexpr int BM = 256, BK = 64, HALF = 128, HTB = HALF * BK * 2, STAGE_BYTES = 8 * HTB, NXCD = 8, WGM = 8;

__host__ __device__ __forceinline__ int lds_byte(int r, int c) { const int st = (r >> 4) * 2 + (c >> 5), rr = r & 15, cc = c & 31, ob = rr * 64 + cc * 2; return st * 1024 + (ob ^ (((ob >> 9) & 1) << 5)); }
__host__ __device__ __forceinline__ void stage_rc(int b, int& R, int& C) { const int st = b / 1024, sb = b % 1024, swz = sb ^ (((sb >> 9) & 1) << 5); R = (st >> 1) * 16 + swz / 64; C = (st & 1) * 32 + (swz % 64) / 2; }
__host__ __device__ __forceinline__ int perm32(int rho) { const int n = rho >> 4, i = rho & 15; return 8 * (i >> 2) + 4 * n + (i & 3); }

struct Unit { int pm, pn, g; };
struct Gemm { const bf16_t* A0; const bf16_t* B0; const bf16_t* A1; const bf16_t* B1; int M, N, K; };

struct StaticOrder {
    int nM, nN, nwg, G, c, per;
    __host__ __device__ void init(int M_, int N_, int G_, int c_, int per_) { nM = M_ / BM; nN = N_ / BM; nwg = nM * nN; G = G_; c = c_; per = per_; }
    __host__ __device__ bool next(int i, Unit& u) const {
        const int ti = i / per; u.g = i % per;
        const long L = (long)ti * G + c; if (L >= nwg) return false;
        int wgid = (int)L; { const int q = nwg / NXCD, r = nwg % NXCD, xcd = wgid % NXCD, off = wgid / NXCD; wgid = (xcd < r ? xcd * (q + 1) : r * (q + 1) + (xcd - r) * q) + off; }
        const int nig = WGM * nN, gid = wgid / nig, fm = gid * WGM, gsz = (nM - fm) < WGM ? (nM - fm) : WGM;
        u.pm = fm + ((wgid % nig) % gsz); u.pn = (wgid % nig) / gsz; return true;
    }
};

template <class Epi>
__device__ __forceinline__ void gemm_phase(LAS unsigned char* lds, const Gemm g, const StaticOrder& S, const Epi& E) {
    const int tid = opaque_tid(), wid = __builtin_amdgcn_readfirstlane(tid >> 6), lane = tid & 63, wr = wid >> 2, wc = wid & 3, fr = lane & 15, fq = lane >> 4;
    const int K = g.K, nt = K / BK;
    unsigned voffA[2], voffB[2];
#pragma unroll
    for (int i = 0; i < 2; ++i) { int R, C; stage_rc(tid * 16 + i * 8192, R, C); const int Rb = Epi::PERM ? ((R & ~31) + perm32(R & 31)) : R;
        voffA[i] = (unsigned)(R * K + C) * 2u; voffB[i] = (unsigned)(Rb * K + C) * 2u; }
    const size_t kstep = (size_t)(BK * 2);
    const size_t hstep = (size_t)HALF * K * 2;
    const size_t tstep = 2 * hstep;
    const unsigned ldsw = (unsigned)wid * 1024u;
    const int aoff = lds_byte(wr * 64 + fr, fq * 8), boff = lds_byte(wc * 32 + fr, fq * 8);
#define PG8_SA(b, h) (((b) * 2 + (h)) * HTB)
#define PG8_SB(b, h) ((4 + (b) * 2 + (h)) * HTB)
#define PG8_STAGE(bufoff, gbase, voff) do { _Pragma("unroll") for (int _i = 0; _i < 2; ++_i) \
        __builtin_amdgcn_global_load_lds((const unsigned*)((const char*)(gbase) + (voff)[_i]), (LAS unsigned*)(lds + (bufoff) + ldsw + _i * 8192), 16, 0, 0); } while (0)
#define PG8_LDA(dst, b, h) do { _Pragma("unroll") for (int m = 0; m < 4; ++m) _Pragma("unroll") for (int k = 0; k < 2; ++k) dst[m][k] = *(const LAS bf16x8*)(lds + PG8_SA(b, h) + aoff + m * 2048 + k * 1024); } while (0)
#define PG8_LDB(dst, b, h) do { _Pragma("unroll") for (int n = 0; n < 2; ++n) _Pragma("unroll") for (int k = 0; k < 2; ++k) dst[n][k] = *(const LAS bf16x8*)(lds + PG8_SB(b, h) + boff + n * 2048 + k * 1024); } while (0)
#define PG8_MMA(ai, bj, At, Bt) do { __builtin_amdgcn_s_setprio(1); _Pragma("unroll") for (int m = 0; m < 4; ++m) _Pragma("unroll") for (int n = 0; n < 2; ++n) _Pragma("unroll") for (int k = 0; k < 2; ++k) \
        acc[ai][bj][m][n] = __builtin_amdgcn_mfma_f32_16x16x32_bf16(Bt[n][k], At[m][k], acc[ai][bj][m][n], 0, 0, 0); __builtin_amdgcn_s_setprio(0); } while (0)
#define PG8_WAIT_V(n) asm volatile("s_waitcnt vmcnt(" #n ")" ::: "memory")
#define PG8_WAIT_L(n) asm volatile("s_waitcnt lgkmcnt(" #n ")" ::: "memory")
#define PG8_BAR __builtin_amdgcn_s_barrier()
#define PG8_SCHED __builtin_amdgcn_sched_barrier(0)
    Unit cur, nxt; int ui = 0;
    if (!S.next(0, cur)) return;
    f32x4 acc[2][2][4][2];
#pragma unroll
    for (int a = 0; a < 2; ++a)
#pragma unroll
        for (int b = 0; b < 2; ++b)
#pragma unroll
            for (int m = 0; m < 4; ++m)
#pragma unroll
                for (int n = 0; n < 2; ++n) acc[a][b][m][n] = (f32x4){0.f, 0.f, 0.f, 0.f};
    bf16x8 At[4][2], B0[2][2], B1[2][2];
    const char* cA = (const char*)(cur.g ? g.A1 : g.A0) + (size_t)cur.pm * tstep; const char* cB = (const char*)(cur.g ? g.B1 : g.B0) + (size_t)cur.pn * tstep;
    PG8_STAGE(PG8_SB(0, 0), cB, voffB); PG8_STAGE(PG8_SB(0, 1), cB + hstep, voffB); PG8_STAGE(PG8_SA(0, 0), cA, voffA); PG8_STAGE(PG8_SA(0, 1), cA + hstep, voffA);
    if (wr == 1) PG8_BAR;
    PG8_WAIT_V(2); PG8_BAR;
    PG8_STAGE(PG8_SB(1, 0), cB + kstep, voffB); PG8_STAGE(PG8_SA(1, 0), cA + kstep, voffA); PG8_STAGE(PG8_SB(1, 1), cB + hstep + kstep, voffB);
    PG8_WAIT_V(6); PG8_BAR;
    for (;;) {
        const bool has_next = S.next(ui + 1, nxt);
        const char* nA = has_next ? (const char*)(nxt.g ? g.A1 : g.A0) + (size_t)nxt.pm * tstep : cA; const char* nB = has_next ? (const char*)(nxt.g ? g.B1 : g.B0) + (size_t)nxt.pn * tstep : cB;
        for (int t = 0; t < nt; t += 2) {
            const bool last = (t == nt - 2);
            const char* a1 = cA + (size_t)(t + 1) * kstep;
            const char* a2 = last ? nA : cA + (size_t)(t + 2) * kstep; const char* b2 = last ? nB : cB + (size_t)(t + 2) * kstep;
            const char* a3 = a2 + kstep; const char* b3 = b2 + kstep;
            PG8_LDB(B0, 0, 0); PG8_LDB(B1, 0, 1); PG8_SCHED; PG8_LDA(At, 0, 0); PG8_STAGE(PG8_SA(1, 1), a1 + hstep, voffA);
            PG8_WAIT_V(8); PG8_WAIT_L(0); PG8_BAR; PG8_MMA(0, 0, At, B0); PG8_MMA(0, 1, At, B1); PG8_BAR; PG8_SCHED;
            PG8_LDA(At, 0, 1); PG8_STAGE(PG8_SB(0, 0), b2, voffB); PG8_STAGE(PG8_SB(0, 1), b2 + hstep, voffB); PG8_STAGE(PG8_SA(0, 0), a2, voffA);
            PG8_WAIT_V(8); PG8_WAIT_L(0); PG8_BAR; PG8_MMA(1, 0, At, B0); PG8_MMA(1, 1, At, B1); PG8_BAR; PG8_SCHED;
            PG8_LDB(B0, 1, 0); PG8_LDB(B1, 1, 1); PG8_SCHED; PG8_LDA(At, 1, 0); PG8_STAGE(PG8_SA(0, 1), a2 + hstep, voffA);
            PG8_WAIT_V(8); PG8_WAIT_L(0); PG8_BAR; PG8_MMA(0, 0, At, B0); PG8_MMA(0, 1, At, B1); PG8_BAR; PG8_SCHED;
            PG8_LDA(At, 1, 1); PG8_STAGE(PG8_SB(1, 0), b3, voffB); PG8_STAGE(PG8_SB(1, 1), b3 + hstep, voffB); PG8_STAGE(PG8_SA(1, 0), a3, voffA);
            PG8_WAIT_V(8); PG8_WAIT_L(0); PG8_BAR; PG8_MMA(1, 0, At, B0); PG8_MMA(1, 1, At, B1); PG8_BAR; PG8_SCHED;
        }
        if (wr == 0) PG8_BAR;
        E(acc, cur, wr, wc, fr, fq);
        if (!has_next) break;
        if (!(Epi::CHAIN && cur.g == 0))
#pragma unroll
        for (int a = 0; a < 2; ++a)
#pragma unroll
            for (int b = 0; b < 2; ++b)
#pragma unroll
                for (int m = 0; m < 4; ++m)
#pragma unroll
                    for (int n = 0; n < 2; ++n) acc[a][b][m][n] = (f32x4){0.f, 0.f, 0.f, 0.f};
        cur = nxt; cA = nA; cB = nB; ++ui;
        if (wr == 1) PG8_BAR;
    }
    PG8_WAIT_V(0);
    PG8_BAR;
#undef PG8_SA
#undef PG8_SB
#undef PG8_STAGE
#undef PG8_LDA
#undef PG8_LDB
#undef PG8_MMA
#undef PG8_WAIT_V
#undef PG8_WAIT_L
#undef PG8_BAR
#undef PG8_SCHED
}
}

constexpr size_t MiB = 1u << 20;
constexpr size_t WS_CTL = 0;
constexpr size_t WS_WIN = 2 * MiB, WS_WPW = 13 * MiB, WS_WO = 15 * MiB, WS_WOUT = 17 * MiB, WS_WQ = 19 * MiB, WS_SK = 23 * MiB;
constexpr size_t WS_EU = 24 * MiB, WS_EV = 40 * MiB, WS_ESC = 56 * MiB;
constexpr size_t WS_XN = 88 * MiB, WS_U = 152 * MiB;
constexpr size_t WS_MG = 88 * MiB, WS_XG2 = 152 * MiB;
constexpr size_t WS_G = 216 * MiB;
constexpr size_t WS_QP = 216 * MiB;
constexpr size_t WS_Q = 344 * MiB, WS_K = 408 * MiB, WS_V = 424 * MiB;
constexpr size_t WS_IDX = 344 * MiB, WS_GATE = 360 * MiB;
constexpr size_t WS_CA = 440 * MiB;
constexpr size_t WS_END = 504 * MiB;
constexpr int LDS_BYTES = 147456;
constexpr int MISC_OFF = 131072 + 8192;
constexpr int CW_BAR = 4096;
constexpr size_t CTL_ZERO_BYTES = 65536;

struct Args { const float* in[17]; float* out; unsigned char* ws; int ph_lo, ph_hi; };

struct EpiInProj {
    static constexpr bool PERM = true, CHAIN = false;
    bf16 *U, *Q, *K, *V, *G;
    __device__ __forceinline__ void operator()(f32x4 (&acc)[2][2][4][2], const pg8::Unit& u, int wr, int wc, int fr, int fq) const {
        const int row0 = u.pm * 256 + wr * 64 + fr; const int cw = wc * 32 + 8 * fq;
        if (u.pn < 8) {
#pragma unroll
            for (int ai = 0; ai < 2; ++ai)
#pragma unroll
                for (int m = 0; m < 4; ++m) { const size_t row = (size_t)(row0 + ai * 128 + m * 16);
                    f32x4 a0 = acc[ai][0][m][0], a1 = acc[ai][0][m][1], b0 = acc[ai][1][m][0], b1 = acc[ai][1][m][1];
                    v4u w; w.x = pk2(a0[0] * sigmoidf_(b0[0]), a0[1] * sigmoidf_(b0[1])); w.y = pk2(a0[2] * sigmoidf_(b0[2]), a0[3] * sigmoidf_(b0[3]));
                    w.z = pk2(a1[0] * sigmoidf_(b1[0]), a1[1] * sigmoidf_(b1[1])); w.w = pk2(a1[2] * sigmoidf_(b1[2]), a1[3] * sigmoidf_(b1[3]));
                    *(v4u*)(U + row * 1024 + u.pn * 128 + cw) = w; }
        } else if (u.pn >= 14) {
            const int p = u.pn - 14; unsigned char* G8 = (unsigned char*)G;
#pragma unroll
            for (int ai = 0; ai < 2; ++ai)
#pragma unroll
                for (int m = 0; m < 4; ++m) { unsigned char* rowp = G8 + (size_t)(row0 + ai * 128 + m * 16) * 2048 + (size_t)(p * 128 + cw) * 2;
                    v4u w = {0u, 0u, 0u, 0u};
#pragma unroll
                    for (int j = 0; j < 4; ++j) { w.x = __builtin_amdgcn_cvt_pk_u8_f32(sigmoidf_(acc[ai][0][m][0][j]) * 255.0f, j, w.x); w.y = __builtin_amdgcn_cvt_pk_u8_f32(sigmoidf_(acc[ai][0][m][1][j]) * 255.0f, j, w.y);
                        w.z = __builtin_amdgcn_cvt_pk_u8_f32(sigmoidf_(acc[ai][1][m][0][j]) * 255.0f, j, w.z); w.w = __builtin_amdgcn_cvt_pk_u8_f32(sigmoidf_(acc[ai][1][m][1][j]) * 255.0f, j, w.w); }
                    *(v4u*)rowp = w; }
        } else {
            bf16* base; int ld, col0; float sc = 1.0f;
            if (u.pn < 12) { base = Q; ld = 1024; col0 = (u.pn - 8) * 256; sc = QSCALE; }
            else if (u.pn == 12) { base = K; ld = 256; col0 = 0; }
            else { base = V; ld = 256; col0 = 0; }
#pragma unroll
            for (int ai = 0; ai < 2; ++ai)
#pragma unroll
                for (int m = 0; m < 4; ++m) { bf16* rowp = base + (size_t)(row0 + ai * 128 + m * 16) * ld + col0 + cw;
#pragma unroll
                    for (int bj = 0; bj < 2; ++bj) { f32x4 v0 = acc[ai][bj][m][0] * sc, v1 = acc[ai][bj][m][1] * sc;
                        v4u w; w.x = pk2(v0[0], v0[1]); w.y = pk2(v0[2], v0[3]); w.z = pk2(v1[0], v1[1]); w.w = pk2(v1[2], v1[3]);
                        *(v4u*)(rowp + bj * 128) = w; } }
        }
    }
};
struct EpiMerge {
    static constexpr bool PERM = true, CHAIN = true;
    const bf16* G; bf16* MG;
    __device__ __forceinline__ void operator()(f32x4 (&acc)[2][2][4][2], const pg8::Unit& u, int wr, int wc, int fr, int fq) const {
        const int row0 = u.pm * 256 + wr * 64 + fr; const int col0 = u.pn * 256 + wc * 32 + 8 * fq;
        const unsigned char* G8 = (const unsigned char*)G;
#pragma unroll
        for (int ai = 0; ai < 2; ++ai) { const size_t row = (size_t)(row0 + ai * 128);
            const unsigned char* gp = G8 + row * 2048 + (size_t)col0 * 2; bf16* mp = MG + row * 1024 + col0;
            v4u gw[4][2];
#pragma unroll
            for (int m = 0; m < 4; ++m)
#pragma unroll
                for (int bj = 0; bj < 2; ++bj) gw[m][bj] = *(const v4u*)(gp + (size_t)(m * 16) * 2048 + bj * 256);
#pragma unroll
            for (int m = 0; m < 4; ++m)
#pragma unroll
                for (int bj = 0; bj < 2; ++bj) { const v4u g4 = gw[m][bj]; f32x4 v0 = acc[ai][bj][m][0], v1 = acc[ai][bj][m][1];
                    float fb[8];
#pragma unroll
                    for (int j = 0; j < 4; ++j) { fb[j] = fmaxf((float)((g4.z >> (8 * j)) & 0xffu), 1.0f); fb[4 + j] = fmaxf((float)((g4.w >> (8 * j)) & 0xffu), 1.0f); }
                    if (u.g) {
#pragma unroll
                        for (int j = 0; j < 4; ++j) { v0[j] *= fb[j] * (1.0f / 255.0f); v1[j] *= fb[4 + j] * (1.0f / 255.0f); }
                        v4u w; w.x = pk2(v0[0], v0[1]); w.y = pk2(v0[2], v0[3]); w.z = pk2(v1[0], v1[1]); w.w = pk2(v1[2], v1[3]); *(v4u*)(mp + (size_t)(m * 16) * 1024 + bj * 128) = w;
                    } else {
#pragma unroll
                        for (int j = 0; j < 4; ++j) { v0[j] *= (float)((g4.x >> (8 * j)) & 0xffu) * __builtin_amdgcn_rcpf(fb[j]); v1[j] *= (float)((g4.y >> (8 * j)) & 0xffu) * __builtin_amdgcn_rcpf(fb[4 + j]); }
                        acc[ai][bj][m][0] = v0; acc[ai][bj][m][1] = v1; } } }
    }
};
struct EpiResid {
    static constexpr bool PERM = true, CHAIN = false;
    const float* X; bf16* XG; float* SSQ;
    __device__ __forceinline__ void operator()(f32x4 (&acc)[2][2][4][2], const pg8::Unit& u, int wr, int wc, int fr, int fq) const {
        const int row0 = u.pm * 256 + wr * 64 + fr; const int col0 = u.pn * 256 + wc * 32 + 8 * fq;
#pragma unroll
        for (int ai = 0; ai < 2; ++ai) {
            f32x4 xv[4][2][2];
#pragma unroll
            for (int m = 0; m < 4; ++m) { const size_t off = (size_t)(row0 + ai * 128 + m * 16) * 1024 + col0;
#pragma unroll
                for (int bj = 0; bj < 2; ++bj)
#pragma unroll
                    for (int n = 0; n < 2; ++n) xv[m][bj][n] = *(const f32x4*)(X + off + bj * 128 + n * 4); }
#pragma unroll
            for (int m = 0; m < 4; ++m) { const int row = row0 + ai * 128 + m * 16; const size_t off = (size_t)row * 1024 + col0; float ss = 0.f;
#pragma unroll
                for (int bj = 0; bj < 2; ++bj) { const f32x4 x0 = xv[m][bj][0] + acc[ai][bj][m][0], x1 = xv[m][bj][1] + acc[ai][bj][m][1];
                    ss += ((x0[0] * x0[0] + x0[1] * x0[1]) + (x0[2] * x0[2] + x0[3] * x0[3])) + ((x1[0] * x1[0] + x1[1] * x1[1]) + (x1[2] * x1[2] + x1[3] * x1[3]));
                    v4u w; w.x = pk2(x0[0], x0[1]); w.y = pk2(x0[2], x0[3]); w.z = pk2(x1[0], x1[1]); w.w = pk2(x1[2], x1[3]); *(v4u*)(XG + off + bj * 128) = w; }
                ss += __shfl_xor(ss, 16); ss += __shfl_xor(ss, 32);
                if (fq == 0) atomicAdd(SSQ + row, ss); }
        }
    }
};
struct EpiBf16Rs {
    static constexpr bool PERM = true, CHAIN = false;
    bf16* O; const float* SSQ;
    __device__ __forceinline__ void operator()(f32x4 (&acc)[2][2][4][2], const pg8::Unit& u, int wr, int wc, int fr, int fq) const {
        const int row0 = u.pm * 256 + wr * 64 + fr;
        float ssq[2][4];
#pragma unroll
        for (int ai = 0; ai < 2; ++ai)
#pragma unroll
            for (int m = 0; m < 4; ++m) ssq[ai][m] = SSQ[row0 + ai * 128 + m * 16];
        const int sidx = 2 * wc + (fq >> 1), hh = fq & 1;
#pragma unroll
        for (int ai = 0; ai < 2; ++ai)
#pragma unroll
            for (int m = 0; m < 4; ++m) { const int row = row0 + ai * 128 + m * 16; const int tile = row >> 5, r32 = row & 31;
                const float rs = 1.0f / sqrtf(ssq[ai][m] * (1.f / 1024.f) + EPS);
#pragma unroll
                for (int bj = 0; bj < 2; ++bj) { const f32x4 v0 = acc[ai][bj][m][0] * rs, v1 = acc[ai][bj][m][1] * rs;
                    v4u w; w.x = pk2(v0[0], v0[1]); w.y = pk2(v0[2], v0[3]); w.z = pk2(v1[0], v1[1]); w.w = pk2(v1[2], v1[3]);
                    *(v4u*)(O + ((((size_t)(tile * 8 + u.pn) * 2 + bj) * 8 + sidx) * 64 + r32 + 32 * hh) * 8) = w; } }
    }
};

__device__ __forceinline__ void p0_transpose_item(const float* W, int K, int N, bf16* WT, int dst0, LAS float* scr, int kb, int nb, int lane, const float* kscale = nullptr) {
    const int k0 = 64 * kb, n0 = 32 * nb;
#pragma unroll 8
    for (int i = 0; i < 32; ++i) { const int kk = 2 * i + (lane >> 5); float wv_ = W[(size_t)(k0 + kk) * N + n0 + (lane & 31)]; if (kscale) wv_ *= kscale[k0 + kk]; scr[kk * 33 + (lane & 31)] = wv_; }
    asm volatile("s_waitcnt lgkmcnt(0)" ::: "memory");
    const int c = lane & 7;
#pragma unroll
    for (int j = 0; j < 4; ++j) { const int n = (lane >> 3) + 8 * j; const LAS float* s = scr + (8 * c) * 33 + n;
        v4u o; o.x = pk2(s[0 * 33], s[1 * 33]); o.y = pk2(s[2 * 33], s[3 * 33]); o.z = pk2(s[4 * 33], s[5 * 33]); o.w = pk2(s[6 * 33], s[7 * 33]);
        *(v4u*)(WT + (size_t)(dst0 + n) * K + k0 + 8 * c) = o; }
    asm volatile("s_waitcnt lgkmcnt(0)" ::: "memory");
}
__device__ __forceinline__ int glu_row(int n0) {
    if (n0 < 1024) return 256 * (n0 >> 7) + (n0 & 127);
    if (n0 < 2048) { const int n1 = n0 - 1024; return 256 * (n1 >> 7) + 128 + (n1 & 127); }
    if (n0 < 3584) return n0;
    if (n0 < 4608) { const int n1 = n0 - 3584; return 3584 + 256 * (n1 >> 7) + (n1 & 127); }
    { const int n1 = n0 - 4608; return 3584 + 256 * (n1 >> 7) + 128 + (n1 & 127); }
}
__device__ __forceinline__ void cvt_stream(const float* src, bf16* dst, size_t n, size_t gtid, size_t gthreads) {
    for (size_t i = gtid * 8; i < n; i += gthreads * 8) {
        const f32x4 a = *(const f32x4*)(src + i), b = *(const f32x4*)(src + i + 4);
        v4u o; o.x = pk2(a[0], a[1]); o.y = pk2(a[2], a[3]); o.z = pk2(b[0], b[1]); o.w = pk2(b[2], b[3]);
        *(v4u*)(dst + i) = o; }
}
typedef float v16f __attribute__((ext_vector_type(16)));
typedef float v32f __attribute__((ext_vector_type(32)));
typedef unsigned v6u __attribute__((ext_vector_type(6)));
typedef __bf16 v32bf __attribute__((ext_vector_type(32)));
constexpr int E6ROW = 768, E4ROW = 512;
__device__ __forceinline__ void rows_to_fp6(const float* x2rows, unsigned char* o2rows, float* inv_scale2, int lane, const float* cscale, LAS float* scr) {
    const int c = lane & 31, hf = lane >> 5;
    { f32x4 t[8];
#pragma unroll
      for (int i = 0; i < 8; ++i) t[i] = *(const f32x4*)(x2rows + i * 256 + lane * 4);
#pragma unroll
      for (int i = 0; i < 8; ++i) { const int e = i * 256 + lane * 4; *(LAS f32x4*)((LAS unsigned char*)scr + (e >> 5) * 144 + (e & 31) * 4) = t[i]; }
      asm volatile("s_waitcnt lgkmcnt(0)" ::: "memory"); }
    const LAS f32x4* xr = (const LAS f32x4*)((LAS unsigned char*)scr + lane * 144);
    v16f a, b; float am = 0.f;
#pragma unroll
    for (int j = 0; j < 4; ++j) { f32x4 u = xr[j], w = xr[4 + j];
        if (cscale) { u = u * *(const f32x4*)(cscale + c * 32 + 4 * j); w = w * *(const f32x4*)(cscale + c * 32 + 16 + 4 * j); }
#pragma unroll
        for (int k = 0; k < 4; ++k) { am = fmaxf(am, fmaxf(fabsf(u[k]), fabsf(w[k]))); }
        a[2 * j] = u[0]; b[2 * j] = u[1]; a[2 * j + 1] = u[2]; b[2 * j + 1] = u[3];
        a[8 + 2 * j] = w[0]; b[8 + 2 * j] = w[1]; a[8 + 2 * j + 1] = w[2]; b[8 + 2 * j + 1] = w[3]; }
#pragma unroll
    for (int o = 1; o < 32; o <<= 1) am = fmaxf(am, __shfl_xor(am, o));
    am = fmaxf(am, 1e-30f);
    {
        const float s4 = 6.0f / am; unsigned d4[4] = {0u, 0u, 0u, 0u};
#define F4Q(i_) d4[(i_) >> 2] = __builtin_amdgcn_cvt_scalef32_pk_fp4_f32(d4[(i_) >> 2], a[i_] * s4, b[i_] * s4, 1.0f, (i_) & 3)
        F4Q(0); F4Q(1); F4Q(2); F4Q(3); F4Q(4); F4Q(5); F4Q(6); F4Q(7); F4Q(8); F4Q(9); F4Q(10); F4Q(11); F4Q(12); F4Q(13); F4Q(14); F4Q(15);
#undef F4Q
        *(v4u*)(o2rows + (size_t)hf * E4ROW + c * 16) = (v4u){d4[0], d4[1], d4[2], d4[3]};
        if (c == 0) inv_scale2[hf] = am * (1.0f / 6.0f);
        asm volatile("s_waitcnt lgkmcnt(0)" ::: "memory");
    }
}
__device__ __forceinline__ void rms_row_to_bf16(const float* xrow, const float* g, bf16* orow, int lane) {
    const f32x4* xr = (const f32x4*)xrow + lane; const f32x4* gr = (const f32x4*)g + lane;
    f32x4 v[4]; float s = 0.f;
#pragma unroll
    for (int j = 0; j < 4; ++j) { v[j] = xr[64 * j]; s += (v[j][0] * v[j][0] + v[j][1] * v[j][1]) + (v[j][2] * v[j][2] + v[j][3] * v[j][3]); }
    const float rs = 1.0f / sqrtf(wave_sum(s) * (1.f / 1024.f) + EPS);
    v2u* o8 = (v2u*)orow + lane;
#pragma unroll
    for (int j = 0; j < 4; ++j) { const f32x4 gg = gr[64 * j]; v2u o; o.x = pk2(v[j][0] * rs * gg[0], v[j][1] * rs * gg[1]); o.y = pk2(v[j][2] * rs * gg[2], v[j][3] * rs * gg[3]); o8[64 * j] = o; }
}

__device__ __forceinline__ void conv_phase(LAS unsigned char* lds, const bf16* U, bf16* CA, const float* dw_w, const float* dw_b, const float* ln_g, const float* ln_b, int vcu, int G) {
    const int tid = opaque_tid(), lane = tid & 63, wave = tid >> 6;
    const int c0 = 2 * tid;
    constexpr int TT = 32, ROWS = TT + 2 * CPAD, TILE_B = ROWS * 2048;
    f32x2 wv[CK];
#pragma unroll
    for (int j = 0; j < CK; ++j) wv[j] = *(const f32x2*)(dw_w + j * 1024 + c0);
    const f32x2 bi = *(const f32x2*)(dw_b + c0), lg = *(const f32x2*)(ln_g + c0), lb = *(const f32x2*)(ln_b + c0);
    LAS float* red = (LAS float*)(lds + TILE_B);
    LAS float* stat = red + 512;
    const LAS unsigned char* xb = lds + c0 * 2;
    for (int item = vcu; item < BATCH * (SEQ / TT); item += G) {
        const int b = item / (SEQ / TT), t0 = (item % (SEQ / TT)) * TT;
#pragma unroll
        for (int hb = 0; hb < 2; ++hb) {
            v4u val[8];
#pragma unroll
            for (int it = 0; it < 8; ++it) { const int i = tid + (hb * 8 + it) * NTHREADS; const int row = i >> 7, ch = i & 127, tt = t0 - CPAD + row; const bool ok = (i < ROWS * 128) && (tt >= 0) && (tt < SEQ);
                val[it] = *(const v4u*)(U + ((size_t)b * SEQ + (ok ? tt : t0)) * 1024 + ch * 8); if (!ok) val[it] = (v4u){0u, 0u, 0u, 0u}; }
#pragma unroll
            for (int it = 0; it < 8; ++it) { const int i = tid + (hb * 8 + it) * NTHREADS; const int row = i >> 7, ch = i & 127; if (i < ROWS * 128) *(LAS v4u*)(lds + row * 2048 + ch * 16) = val[it]; }
        }
        __syncthreads();
#pragma unroll 1
        for (int rd = 0; rd < 2; ++rd) {
            const LAS unsigned char* xr = xb + rd * 16 * 2048;
            float ac0[16], ac1[16];
#pragma unroll
            for (int t = 0; t < 16; ++t) { ac0[t] = bi[0]; ac1[t] = bi[1]; }
#pragma clang loop unroll(full)
            for (int r = 0; r < 16 + 2 * CPAD; ++r) {
                const unsigned raw = *(const LAS unsigned*)(xr + r * 2048); const float x0 = bflo(raw), x1 = bfhi(raw);
#pragma clang loop unroll(full)
                for (int j = 0; j < CK; ++j) { const int t = r - j; if (t >= 0 && t < 16) { fmac_s(ac0[t], wv[j][0], x0); fmac_s(ac1[t], wv[j][1], x1); } }
            }
            float v[32];
#pragma unroll
            for (int t = 0; t < 16; ++t) { v[2 * t] = ac0[t] + ac1[t]; v[2 * t + 1] = ac0[t] * ac0[t] + ac1[t] * ac1[t]; }
#pragma unroll
            for (int o = 32, n = 16; n >= 1; o >>= 1, n >>= 1) { const bool hi = (lane & o) != 0;
#pragma unroll
                for (int k = 0; k < n; ++k) { const float a = v[k], bb = v[k + n]; const float send = hi ? a : bb, keep = hi ? bb : a; v[k] = keep + __shfl_xor(send, o); } }
            const float rr = v[0] + __shfl_xor(v[0], 1);
            if ((lane & 1) == 0) red[wave * 32 + (lane >> 1)] = rr;
            __syncthreads();
            if (tid < 16) { float s1 = 0.f, s2 = 0.f;
#pragma unroll
                for (int w = 0; w < 8; ++w) { s1 += red[w * 32 + 2 * tid]; s2 += red[w * 32 + 2 * tid + 1]; }
                const float mean = s1 * (1.f / 1024.f); const float var = s2 * (1.f / 1024.f) - mean * mean;
                stat[2 * tid] = mean; stat[2 * tid + 1] = 1.0f / sqrtf(var + EPS); }
            __syncthreads();
            bf16* Cb = CA + ((size_t)b * SEQ + t0 + 16 * rd) * 1024 + c0;
#pragma unroll
            for (int t = 0; t < 16; ++t) { const float mean = stat[2 * t], rstd = stat[2 * t + 1];
                float y0 = (ac0[t] - mean) * rstd * lg[0] + lb[0], y1 = (ac1[t] - mean) * rstd * lg[1] + lb[1];
                y0 = y0 * sigmoidf_(y0); y1 = y1 * sigmoidf_(y1);
                *(unsigned*)(Cb + (size_t)t * 1024) = pk2(y0, y1); }
            __syncthreads();
        }
    }
}

namespace att {
typedef short bf16x8 __attribute__((ext_vector_type(8)));
typedef short s16x4 __attribute__((ext_vector_type(4)));
typedef float f32x16 __attribute__((ext_vector_type(16)));
constexpr int KP = 144, SPAN = 320, VOFF = SPAN * KP, WSTG = 2 * SPAN * KP;
__device__ __forceinline__ s16x4 vtr(const LAS unsigned char* p) { return __builtin_bit_cast(s16x4, __builtin_amdgcn_ds_read_tr16_b64_v4i16((LAS s16x4*)p)); }
__device__ __forceinline__ void attn_phase(LAS unsigned char* lds, const bf16* Q, const bf16* K, const bf16* V, bf16* AO, const float* sink, int vcu, int G) {
    const int tid = opaque_tid(), lane = tid & 63, wave = __builtin_amdgcn_readfirstlane(tid >> 6), r32 = lane & 31, hh = lane >> 5;
    v4u kreg[5], vreg[5];
#define ATT_STAGE_LOAD(UNIT) do { const int qb_ = (UNIT) % (SEQ / 64), kvh_ = ((UNIT) / (SEQ / 64)) % NKV, b_ = (UNIT) / ((SEQ / 64) * NKV); const int t0_ = qb_ * 64, s0_ = t0_ - WIN; \
        _Pragma("unroll") for (int it = 0; it < 5; ++it) { const int i = tid + it * NTHREADS; const int row = i >> 3, ch = i & 7, sp = s0_ + row; const bool ok = (sp >= 0) && (sp < SEQ); \
            const size_t go = ((size_t)b_ * SEQ + (ok ? sp : t0_)) * KVD + kvh_ * 64 + ch * 8; kreg[it] = *(const v4u*)(K + go); vreg[it] = *(const v4u*)(V + go); } } while (0)
    if (vcu < BATCH * NKV * (SEQ / 64)) ATT_STAGE_LOAD(vcu);
    for (int unit = vcu; unit < BATCH * NKV * (SEQ / 64); unit += G) {
        const int qb = unit % (SEQ / 64), kvh = (unit / (SEQ / 64)) % NKV, b = unit / ((SEQ / 64) * NKV);
        const int t0 = qb * 64;
#pragma unroll
        for (int it = 0; it < 5; ++it) { const int i = tid + it * NTHREADS; const int row = i >> 3, ch = i & 7;
            *(LAS v4u*)(lds + row * KP + ch * 16) = kreg[it]; *(LAS v4u*)(lds + VOFF + row * KP + ch * 16) = vreg[it]; }
        if (unit + G < BATCH * NKV * (SEQ / 64)) ATT_STAGE_LOAD(unit + G);
        __syncthreads();
        {
            const int head = kvh * 4 + (wave >> 1), qoff = (wave & 1) * 32, q0 = t0 + qoff;
            const float slope2 = exp2f(-0.5f * (float)(head + 1)) * LOG2E, sink2 = sink[head] * LOG2E;
            LAS unsigned char* stg = lds + WSTG + wave * (32 * KP);
            const size_t qbase = ((size_t)b * SEQ + q0) * 1024 + head * 64;
#pragma unroll
            for (int i = 0; i < 4; ++i) { const int id = i * 64 + lane, row = id >> 3, ch = id & 7; *(LAS v4u*)(stg + row * KP + ch * 16) = *(const v4u*)(Q + qbase + (size_t)row * 1024 + ch * 8); }
            bf16x8 qf[4];
#pragma unroll
            for (int s = 0; s < 4; ++s) qf[s] = *(const LAS bf16x8*)(stg + r32 * KP + (2 * s + hh) * 16);
            float m = sink2, l = (hh == 0) ? 1.0f : 0.0f;
            f32x16 O0, O1, negm;
#pragma unroll
            for (int r = 0; r < 16; ++r) { O0[r] = 0.f; O1[r] = 0.f; negm[r] = -sink2; }
            const int q4 = (lane & 15) >> 2, p4 = lane & 3, g16 = (lane >> 4) & 1;
#pragma unroll 1
            for (int it = 0; it < 9; ++it) {
                const int j = (it & 1) ? 4 - ((it + 1) >> 1) : 4 + (it >> 1);
                const int kt0 = q0 - WIN + 32 * j;
                if (kt0 < 0 || kt0 >= SEQ) continue;
                const int lrow0 = qoff + 32 * j;
                f32x16 sa = negm;
#pragma unroll
                for (int s = 0; s < 4; ++s) { const bf16x8 kf = *(const LAS bf16x8*)(lds + (lrow0 + r32) * KP + 32 * s + 16 * hh); sa = __builtin_amdgcn_mfma_f32_32x32x16_bf16(kf, qf[s], sa, 0, 0, 0); }
                const float cf = (float)(WIN - 32 * j + r32 - 4 * hh);
                if (j == 0 || j == 8) {
#pragma unroll
                    for (int r = 0; r < 16; ++r) { const float d = cf - (float)((r & 3) + 8 * (r >> 2)); float v = fmaf(-slope2, fabsf(d), sa[r]); v = (fabsf(d) > (float)WIN) ? -1e30f : v; sa[r] = v; }
                } else {
#pragma unroll
                    for (int r = 0; r < 16; ++r) { const float d = cf - (float)((r & 3) + 8 * (r >> 2)); sa[r] = fmaf(-slope2, fabsf(d), sa[r]); }
                }
                float tmax = fmaxf(fmaxf(sa[0], sa[1]), sa[2]);
#pragma unroll
                for (int r = 3; r < 15; r += 2) tmax = fmaxf(fmaxf(tmax, sa[r]), sa[r + 1]);
                tmax = fmaxf(tmax, sa[15]);
                if (__any(tmax > 16.0f)) {
                    tmax = fmaxf(tmax, __shfl_xor(tmax, 32));
                    const float dl = fmaxf(tmax, 0.f), alpha = __builtin_amdgcn_exp2f(-dl); m += dl; l *= alpha;
#pragma unroll
                    for (int r = 0; r < 16; ++r) { O0[r] *= alpha; O1[r] *= alpha; sa[r] -= dl; negm[r] = -m; }
                }
                float ls0 = 0.f, ls1 = 0.f;
#pragma unroll
                for (int r = 0; r < 16; r += 2) { sa[r] = __builtin_amdgcn_exp2f(sa[r]); sa[r + 1] = __builtin_amdgcn_exp2f(sa[r + 1]); ls0 += sa[r]; ls1 += sa[r + 1]; }
                l += ls0 + ls1;
                v4u pw0, pw1;
                pw0.x = pk2(sa[0], sa[1]); pw0.y = pk2(sa[2], sa[3]); pw0.z = pk2(sa[4], sa[5]); pw0.w = pk2(sa[6], sa[7]);
                pw1.x = pk2(sa[8], sa[9]); pw1.y = pk2(sa[10], sa[11]); pw1.z = pk2(sa[12], sa[13]); pw1.w = pk2(sa[14], sa[15]);
                const bf16x8 pb0 = __builtin_bit_cast(bf16x8, pw0), pb1 = __builtin_bit_cast(bf16x8, pw1);
                const LAS unsigned char* vb = lds + VOFF + (lrow0 + 4 * hh + q4) * KP + (16 * g16 + 4 * p4) * 2;
#pragma unroll
                for (int s2 = 0; s2 < 2; ++s2) {
                    const s16x4 a0l = vtr(vb + (16 * s2) * KP), a0h = vtr(vb + (16 * s2 + 8) * KP);
                    const s16x4 a1l = vtr(vb + (16 * s2) * KP + 64), a1h = vtr(vb + (16 * s2 + 8) * KP + 64);
                    const bf16x8 A0 = (bf16x8){a0l[0], a0l[1], a0l[2], a0l[3], a0h[0], a0h[1], a0h[2], a0h[3]};
                    const bf16x8 A1 = (bf16x8){a1l[0], a1l[1], a1l[2], a1l[3], a1h[0], a1h[1], a1h[2], a1h[3]};
                    O0 = __builtin_amdgcn_mfma_f32_32x32x16_bf16(A0, s2 ? pb1 : pb0, O0, 0, 0, 0);
                    O1 = __builtin_amdgcn_mfma_f32_32x32x16_bf16(A1, s2 ? pb1 : pb0, O1, 0, 0, 0);
                }
            }
            const float inv = 1.0f / (l + __shfl_xor(l, 32));
#pragma unroll
            for (int g4 = 0; g4 < 4; ++g4) { v2u w0, w1;
                w0.x = pk2(O0[4 * g4] * inv, O0[4 * g4 + 1] * inv); w0.y = pk2(O0[4 * g4 + 2] * inv, O0[4 * g4 + 3] * inv);
                w1.x = pk2(O1[4 * g4] * inv, O1[4 * g4 + 1] * inv); w1.y = pk2(O1[4 * g4 + 2] * inv, O1[4 * g4 + 3] * inv);
                *(LAS v2u*)(stg + r32 * KP + (8 * g4 + 4 * hh) * 2) = w0; *(LAS v2u*)(stg + r32 * KP + (32 + 8 * g4 + 4 * hh) * 2) = w1; }
#pragma unroll
            for (int i = 0; i < 4; ++i) { const int id = i * 64 + lane, row = id >> 3, ch = id & 7; *(v4u*)(AO + qbase + (size_t)row * 1024 + ch * 8) = *(const LAS v4u*)(stg + row * KP + ch * 16); }
        }
        __syncthreads();
    }
}
#undef ATT_STAGE_LOAD
}

namespace tk {
typedef short bf16x8 __attribute__((ext_vector_type(8)));
typedef float f32x16 __attribute__((ext_vector_type(16)));
constexpr int SKP = 272;
#define TK_CAND50(X) X(0,0,0) X(1,0,1) X(2,0,2) X(3,0,3) X(4,0,4) X(5,0,5) X(6,0,6) X(7,0,7) X(8,0,8) X(9,0,9) X(10,0,10) X(11,0,11) X(12,0,12) X(13,0,13) X(14,0,14) X(15,0,15) X(16,1,0) X(17,1,1) X(18,1,2) X(19,1,3) X(20,1,4) X(21,1,5) X(22,1,6) X(23,1,7) X(24,2,0) X(25,2,1) X(26,2,2) X(27,2,3) X(28,2,4) X(29,3,0) X(30,3,1) X(31,3,2) X(32,3,3) X(33,4,0) X(34,4,1) X(35,4,2) X(36,5,0) X(37,5,1) X(38,6,0) X(39,6,1) X(40,7,0) X(41,7,1) X(42,8,0) X(43,9,0) X(44,10,0) X(45,11,0) X(46,12,0) X(47,13,0) X(48,14,0) X(49,15,0)
#define TK_PAIR25(X) X(0,0,0,2,1) X(1,0,1,2,2) X(2,0,2,2,3) X(3,0,3,2,4) X(4,0,4,3,0) X(5,0,5,3,1) X(6,0,6,3,2) X(7,0,7,3,3) X(8,0,8,4,0) X(9,0,9,4,1) X(10,0,10,4,2) X(11,0,11,5,0) X(12,0,12,5,1) X(13,0,13,6,0) X(14,0,14,6,1) X(15,0,15,7,0) X(16,1,0,7,1) X(17,1,1,8,0) X(18,1,2,9,0) X(19,1,3,10,0) X(20,1,4,11,0) X(21,1,5,12,0) X(22,1,6,13,0) X(23,1,7,14,0) X(24,2,0,15,0)
template <int OFF> __device__ __forceinline__ void sort16(float (&v)[64]) {
#pragma unroll
    for (int k = 2; k <= 16; k <<= 1)
#pragma unroll
        for (int j = k >> 1; j > 0; j >>= 1)
#pragma unroll
            for (int i = 0; i < 16; ++i) { const int l = i ^ j; if (l > i) { const float a = v[OFF + i], b = v[OFF + l]; const float hi = fmaxf(a, b), lo = fminf(a, b);
                if ((i & k) == 0) { v[OFF + i] = hi; v[OFF + l] = lo; } else { v[OFF + i] = lo; v[OFF + l] = hi; } } }
}
template <int OFF> __device__ __forceinline__ void merge16(float (&v)[64]) {
#pragma unroll
    for (int j = 8; j > 0; j >>= 1)
#pragma unroll
        for (int i = 0; i < 16; ++i) { const int l = i ^ j; if (l > i) { const float a = v[OFF + i], b = v[OFF + l]; v[OFF + i] = fmaxf(a, b); v[OFF + l] = fminf(a, b); } }
}
template <int A, int B> __device__ __forceinline__ void top16_merge(float (&v)[64]) {
#pragma unroll
    for (int i = 0; i < 16; ++i) v[A + i] = fmaxf(v[A + i], v[B + 15 - i]);
    merge16<A>(v);
}
__device__ __forceinline__ void top16_of_64(float (&v)[64]) {
    sort16<0>(v); sort16<16>(v); sort16<32>(v); sort16<48>(v);
    top16_merge<0, 16>(v); top16_merge<32, 48>(v); top16_merge<0, 32>(v);
}
__device__ __forceinline__ void topk_phase(LAS unsigned char* lds, const bf16* QP, const bf16* SKb, int* IDX, float* GATE, int vcu, int G) {
    const int tid = opaque_tid(), lane = tid & 63, wave = __builtin_amdgcn_readfirstlane(tid >> 6), r32 = lane & 31, hh = lane >> 5;
    for (int i = tid; i < 256 * 16; i += NTHREADS) { const int row = i >> 4, ch = i & 15; *(LAS v4u*)(lds + row * SKP + ch * 16) = *(const v4u*)(SKb + row * 128 + ch * 8); }
    __syncthreads();
    for (int unit = vcu * NWAVES + wave; unit < (M / 32) * PHD; unit += G * NWAVES) {
        const int tile = unit >> 3, h = unit & 7; const int tok = tile * 32 + r32;
        float L[2][16];
#pragma unroll
        for (int p = 0; p < 2; ++p) {
            bf16x8 qf[8];
#pragma unroll
            for (int sidx = 0; sidx < 8; ++sidx) qf[sidx] = *(const bf16x8*)(QP + ((((size_t)(tile * 8 + h) * 2 + p) * 8 + sidx) * 64 + lane) * 8);
            float v[64];
#define TK_KT(kt) { f32x16 acc; \
                _Pragma("unroll") for (int r = 0; r < 16; ++r) acc[r] = 0.f; \
                _Pragma("unroll") for (int sidx = 0; sidx < 8; ++sidx) { const bf16x8 kf = *(const LAS bf16x8*)(lds + (p * 128 + 32 * kt + r32) * SKP + 32 * sidx + 16 * hh); acc = __builtin_amdgcn_mfma_f32_32x32x16_bf16(kf, qf[sidx], acc, 0, 0, 0); } \
                _Pragma("unroll") for (int r = 0; r < 16; ++r) { const unsigned kidx = (unsigned)(32 * kt + (r & 3) + 8 * (r >> 2)); v[16 * kt + r] = __uint_as_float(((__float_as_uint(acc[r]) & 0xffffff80u) | (unsigned)(hh << 2)) | kidx); } \
                sort16<16 * kt>(v); __builtin_amdgcn_sched_barrier(0); }
            TK_KT(0) TK_KT(1) top16_merge<0, 16>(v); __builtin_amdgcn_sched_barrier(0);
            TK_KT(2) TK_KT(3) top16_merge<32, 48>(v); __builtin_amdgcn_sched_barrier(0);
            top16_merge<0, 32>(v); __builtin_amdgcn_sched_barrier(0);
#undef TK_KT
            float t[16];
#pragma unroll
            for (int i = 0; i < 16; ++i) t[i] = __shfl_xor(v[15 - i], 32);
#pragma unroll
            for (int i = 0; i < 16; ++i) v[i] = fmaxf(v[i], t[i]);
            merge16<0>(v);
#pragma unroll
            for (int i = 0; i < 16; ++i) L[p][i] = v[i];
        }
        float sm[25];
#define X(c, i0, j0, i1, j1) { const float s0 = L[0][i0] + L[1][j0], s1 = L[0][i1] + L[1][j1]; sm[c] = hh ? s1 : s0; }
        TK_PAIR25(X)
#undef X
        float v[64];
#pragma unroll
        for (int c = 0; c < 25; ++c) v[c] = sm[c];
#pragma unroll
        for (int c = 25; c < 32; ++c) v[c] = -3.0e38f;
        sort16<0>(v); sort16<16>(v); top16_merge<0, 16>(v);
        float T;
        { float t[16];
#pragma unroll
          for (int i = 0; i < 16; ++i) t[i] = __shfl_xor(v[15 - i], 32);
#pragma unroll
          for (int i = 0; i < 16; ++i) t[i] = fmaxf(v[i], t[i]);
          T = fminf(fminf(t[0], t[1]), t[2]);
#pragma unroll
          for (int i = 3; i < 15; i += 2) T = fminf(fminf(T, t[i]), t[i + 1]);
          T = fminf(T, t[15]); }
        const float smax = L[0][0] + L[1][0];
        unsigned ia[16], ib[16];
#pragma unroll
        for (int i = 0; i < 16; ++i) { ia[i] = (__float_as_uint(L[0][i]) & 127u) << 7; ib[i] = __float_as_uint(L[1][i]) & 127u; }
        float pe[25]; float den = 0.f; int cnt = 0;
#pragma unroll
        for (int c = 0; c < 25; ++c) { const bool sel = sm[c] >= T; const float e = __builtin_amdgcn_exp2f((sm[c] - smax) * LOG2E); pe[c] = e; den += sel ? e : 0.f; cnt += sel ? 1 : 0; }
        den += __shfl_xor(den, 32);
        const int ocnt = __shfl_xor(cnt, 32);
        int pos = hh ? ocnt : 0;
        const float inv = 1.0f / den;
        LAS float* lg = (LAS float*)(lds + 256 * SKP + wave * 4096); LAS int* li = (LAS int*)(lg + 512);
#define X(c, i0, j0, i1, j1) { const unsigned e0 = ia[i0] + ib[j0], e1 = ia[i1] + ib[j1]; const unsigned em = hh ? e1 : e0; \
            const bool sel = sm[c] >= T; \
            if (sel && pos < 16) { lg[r32 * 16 + pos] = pe[c] * inv; li[r32 * 16 + pos] = (int)em; } \
            pos += sel ? 1 : 0; }
        TK_PAIR25(X)
#undef X
        asm volatile("s_waitcnt lgkmcnt(0)" ::: "memory");
#pragma unroll
        for (int rr = 0; rr < 2; ++rr) { const int tl = rr * 16 + (lane >> 2), pg = lane & 3; const size_t ob = (size_t)(tile * 32 + tl) * 128 + h * 16 + 4 * pg;
            *(f32x4*)(GATE + ob) = *(const LAS f32x4*)(lg + tl * 16 + 4 * pg); *(v4u*)(IDX + ob) = *(const LAS v4u*)(li + tl * 16 + 4 * pg); }
        asm volatile("s_waitcnt lgkmcnt(0)" ::: "memory");
    }
}
}

__device__ __forceinline__ float dot2bf(unsigned a, unsigned b, float c) { return __builtin_amdgcn_fdot2_f32_bf16(__builtin_bit_cast(bf16x2_t, a), __builtin_bit_cast(bf16x2_t, b), c, false); }
__device__ __forceinline__ float gelu_erf(float x) { return 0.5f * x * (1.0f + erff(x * 0.70710678118654752f)); }
typedef int v8i __attribute__((ext_vector_type(8)));
typedef int v4i __attribute__((ext_vector_type(4)));
__device__ __forceinline__ void gather_phase(LAS unsigned char* lds, const bf16* XG2, const float* SSQ, const unsigned char* EU, const unsigned char* EV, const float* SU, const float* SV, const int* IDX, const float* GATE, float* WGT, const float* fg, float* OUT, int vcu, int G) {
    const int tid = opaque_tid(), lane = tid & 63, wave = tid >> 6, c32 = lane & 31, hf = lane >> 5;
    const int emap = 16 * (lane & 3) + 2 * ((lane >> 2) & 7) + hf;
    const unsigned loff = (unsigned)c32 * 16u;
    struct __attribute__((packed, aligned(4))) U6 { unsigned d[6]; };
    {
    constexpr int WLDS = 3072 + 8192;
    const int wv = __builtin_amdgcn_readfirstlane(wave);
    LAS unsigned char* wl_ = lds + wv * WLDS;
    LAS unsigned char* rb = wl_ + 3072;
    const int r16 = lane & 15, q4 = lane >> 4;
    const unsigned cx = (unsigned)(c32 ^ hf);
    const LAS unsigned char* rab = rb + 512 * r16 + 128 * (q4 ^ (r16 >> 3));
#define DMA_HEAD(idxv_, hh_) do { _Pragma("unroll") for (int j_ = 0; j_ < 8; ++j_) { \
        const int sa_ = __builtin_amdgcn_readlane((idxv_), ((hh_) & 3) * 16 + 2 * j_), sb_ = __builtin_amdgcn_readlane((idxv_), ((hh_) & 3) * 16 + 2 * j_ + 1); \
        __builtin_amdgcn_global_load_lds((const unsigned*)(EU + (size_t)(hf ? sb_ : sa_) * E4ROW + ((cx ^ (2u * j_)) << 4)), (LAS unsigned*)(rb + 1024 * j_), 16, 0, 0); } } while (0)
    const int tok0 = vcu * NWAVES + wave;
    int nidx0 = 0, nidx1 = 0;
    if (tok0 < M) { nidx0 = IDX[(size_t)tok0 * 128 + lane]; nidx1 = IDX[(size_t)tok0 * 128 + 64 + lane]; }
    for (int tok = tok0; tok < M; tok += G * NWAVES) {
        const int idx0 = nidx0, idx1 = nidx1;
        DMA_HEAD(idx0, 0);
        { const int nt = tok + G * NWAVES; if (nt < M) { nidx0 = IDX[(size_t)nt * 128 + lane]; nidx1 = IDX[(size_t)nt * 128 + 64 + lane]; } }
        const float rs2 = 1.0f / sqrtf(SSQ[tok] * (1.f / 1024.f) + EPS);
        { const v4u* hp = (const v4u*)(XG2 + (size_t)tok * 1024 + lane * 16); const v4u w0 = hp[0], w1 = hp[1];
          const unsigned ww[8] = {w0.x, w0.y, w0.z, w0.w, w1.x, w1.y, w1.z, w1.w};
          float xv[16];
#pragma unroll
          for (int j = 0; j < 8; ++j) { xv[2 * j] = bflo(ww[j]) * rs2; xv[2 * j + 1] = bfhi(ww[j]) * rs2; }
          unsigned hi4[4], lo4[4];
#pragma unroll
          for (int j = 0; j < 4; ++j) {
              const float x0 = xv[4 * j], x1 = xv[4 * j + 1], x2 = xv[4 * j + 2], x3 = xv[4 * j + 3];
              int h = __builtin_amdgcn_cvt_pk_fp8_f32(x0, x1, 0, false); h = __builtin_amdgcn_cvt_pk_fp8_f32(x2, x3, h, true);
              const float r0 = x0 - __builtin_amdgcn_cvt_f32_fp8(h, 0), r1 = x1 - __builtin_amdgcn_cvt_f32_fp8(h, 1), r2 = x2 - __builtin_amdgcn_cvt_f32_fp8(h, 2), r3 = x3 - __builtin_amdgcn_cvt_f32_fp8(h, 3);
              int l = __builtin_amdgcn_cvt_pk_fp8_f32(r0, r1, 0, false); l = __builtin_amdgcn_cvt_pk_fp8_f32(r2, r3, l, true);
              hi4[j] = (unsigned)h; lo4[j] = (unsigned)l; }
          *(LAS v4u*)(wl_ + lane * 16) = (v4u){hi4[0], hi4[1], hi4[2], hi4[3]}; *(LAS v4u*)(wl_ + 1024 + lane * 16) = (v4u){lo4[0], lo4[1], lo4[2], lo4[3]};
        }
        const float g0 = GATE[(size_t)tok * 128 + lane], g1 = GATE[(size_t)tok * 128 + 64 + lane];
        const float su0 = SU[idx0], su1 = SU[idx1], sv0 = SV[idx0], sv1 = SV[idx1];
        v8i Bx[8];
        {
          const LAS unsigned char* bpa = wl_ + (r16 == 1 ? 1024 : 0) + 256 * (q4 >> 1) + 16 * (q4 & 1); const LAS unsigned char* bpb = bpa + 512;
#pragma unroll
          for (int s = 0; s < 8; ++s) { const v4u a = *(const LAS v4u*)(bpa + s * 32), b = *(const LAS v4u*)(bpb + s * 32);
              Bx[s] = (v8i){(int)a.x, (int)a.y, (int)a.z, (int)a.w, (int)b.x, (int)b.y, (int)b.z, (int)b.w}; } }
#pragma unroll
        for (int h = 0; h < 8; ++h) {
            asm volatile("s_waitcnt vmcnt(0)" ::: "memory");
            v4i L[8];
#pragma unroll
            for (int i = 0; i < 8; ++i) L[i] = *(const LAS v4i*)(rab + 16 * (i ^ (r16 & 7)));
            asm volatile("s_waitcnt lgkmcnt(0)" ::: "memory");
            __builtin_amdgcn_sched_barrier(0);
            if (h < 7) DMA_HEAD(h + 1 < 4 ? idx0 : idx1, h + 1);
            __builtin_amdgcn_sched_barrier(0);
            f32x4 acc = {0.f, 0.f, 0.f, 0.f};
#pragma unroll
            for (int s = 0; s < 8; ++s) {
                const v8i A = __builtin_shufflevector(L[s], L[s], 0, 1, 2, 3, -1, -1, -1, -1);
                acc = __builtin_amdgcn_mfma_scale_f32_16x16x128_f8f6f4(A, Bx[s], acc, 4, 0, 0, 0, 0, 0);
            }
            if (r16 < 2) *(LAS f32x4*)(wl_ + 2048 + r16 * 512 + (h * 16 + 4 * q4) * 4) = acc;
        }
        const float d0 = *(const LAS float*)(wl_ + 2048 + lane * 4) + *(const LAS float*)(wl_ + 2560 + lane * 4);
        const float d1 = *(const LAS float*)(wl_ + 2048 + 256 + lane * 4) + *(const LAS float*)(wl_ + 2560 + 256 + lane * 4);
        WGT[(size_t)tok * 128 + lane] = g0 * gelu_erf(d0 * su0) * sv0;
        WGT[(size_t)tok * 128 + 64 + lane] = g1 * gelu_erf(d1 * su1) * sv1;
    }
#undef DMA_HEAD
    }
    for (int tok = vcu * NWAVES + wave; tok < M; tok += G * NWAVES) {
        int idxl[2]; float wl[2];
#pragma unroll
        for (int blk = 0; blk < 2; ++blk) { idxl[blk] = IDX[(size_t)tok * 128 + blk * 64 + emap]; wl[blk] = WGT[(size_t)tok * 128 + blk * 64 + emap]; }
        v32f acc;
#pragma unroll
        for (int k = 0; k < 32; ++k) acc[k] = 0.f;
#pragma unroll
        for (int blk = 0; blk < 2; ++blk) {
#pragma unroll 1
            for (int bt = 0; bt < 2; ++bt) {
                v4u vr[16];
#pragma unroll
                for (int i = 0; i < 16; ++i) { const int pr = bt * 16 + i; const int ia = __builtin_amdgcn_readlane(idxl[blk], pr), ib = __builtin_amdgcn_readlane(idxl[blk], 32 + pr);
                    vr[i] = *(const v4u*)(EV + (size_t)(hf ? ib : ia) * E4ROW + loff); }
#pragma unroll
                for (int i = 0; i < 16; ++i) { const int pr = bt * 16 + i;
                    const int wa = __builtin_amdgcn_readlane((int)__float_as_uint(wl[blk]), pr), wb = __builtin_amdgcn_readlane((int)__float_as_uint(wl[blk]), 32 + pr);
                    const float w = __uint_as_float((unsigned)(hf ? wb : wa));
                    v32f rv;
#define F4D(j_) { const f32x2 p_ = __builtin_amdgcn_cvt_scalef32_pk_f32_fp4(vr[i][(j_) >> 2], 1.0f, (j_) & 3); rv[2 * (j_)] = p_[0]; rv[2 * (j_) + 1] = p_[1]; }
                    F4D(0) F4D(1) F4D(2) F4D(3) F4D(4) F4D(5) F4D(6) F4D(7) F4D(8) F4D(9) F4D(10) F4D(11) F4D(12) F4D(13) F4D(14) F4D(15)
#undef F4D
                    acc = acc + rv * w; }
            }
        }
        float o16[16];
#pragma unroll
        for (int k = 0; k < 16; ++k) { const float lo = acc[k], hi = acc[16 + k]; const float mine = hf ? hi : lo, other = hf ? lo : hi; o16[k] = mine + __shfl_xor(other, 32); }
        const size_t co = (size_t)tok * 1024 + c32 * 32 + hf * 16;
        float* orow = OUT + co; float ss = 0.f; f32x4 x2[4];
        { const v4u* xp = (const v4u*)(XG2 + co); const v4u w0 = xp[0], w1 = xp[1];
          x2[0] = (f32x4){bflo(w0.x) + o16[0], bfhi(w0.x) + o16[1], bflo(w0.y) + o16[2], bfhi(w0.y) + o16[3]};
          x2[1] = (f32x4){bflo(w0.z) + o16[4], bfhi(w0.z) + o16[5], bflo(w0.w) + o16[6], bfhi(w0.w) + o16[7]};
          x2[2] = (f32x4){bflo(w1.x) + o16[8], bfhi(w1.x) + o16[9], bflo(w1.y) + o16[10], bfhi(w1.y) + o16[11]};
          x2[3] = (f32x4){bflo(w1.z) + o16[12], bfhi(w1.z) + o16[13], bflo(w1.w) + o16[14], bfhi(w1.w) + o16[15]}; }
#pragma unroll
        for (int j = 0; j < 4; ++j) ss += (x2[j][0] * x2[j][0] + x2[j][1] * x2[j][1]) + (x2[j][2] * x2[j][2] + x2[j][3] * x2[j][3]);
        const float rs = 1.0f / sqrtf(wave_sum(ss) * (1.f / 1024.f) + EPS);
#pragma unroll
        for (int j = 0; j < 4; ++j) { const f32x4 g4 = *(const f32x4*)(fg + c32 * 32 + hf * 16 + 4 * j); *(f32x4*)(orow + 4 * j) = x2[j] * rs * g4; }
    }
}

#define RLX_AGENT __ATOMIC_RELAXED, __HIP_MEMORY_SCOPE_AGENT
#define XB_TMO      128
#define XB_XCNT(j)  (256  + 64 * (j))
#define XB_XSUB(j)  (1280 + 64 * (j))
#define XB_XGEN(j)  (2304 + 64 * (j))
#define XB_TOP      3328
#define XB_TOPGEN   3392
#define XCD_BAR_WORDS 3456
#define XB_SPIN_CAP (1u << 18)

__device__ __forceinline__ unsigned xb_ld(unsigned* p)              { return __hip_atomic_load(p, __ATOMIC_RELAXED, __HIP_MEMORY_SCOPE_AGENT); }
__device__ __forceinline__ unsigned xb_add(unsigned* p, unsigned v) { return __hip_atomic_fetch_add(p, v, __ATOMIC_RELAXED, __HIP_MEMORY_SCOPE_AGENT); }
__device__ __forceinline__ unsigned xb_xcc_id() { return (unsigned)__builtin_amdgcn_s_getreg((3 << 11) | 20) & 0xFu; }
#define XB_SPIN(cond, bar) do { unsigned _sp = 0; while (cond) { __builtin_amdgcn_s_sleep(1); \
    if ((++_sp & 255u) == 0u) { if (xb_ld(&(bar)[XB_TMO])) break; if (_sp > XB_SPIN_CAP) { atomicAdd(&(bar)[XB_TMO], 1u); break; } } } } while (0)

struct XcdBarrier {
    unsigned* bar; unsigned x;
    volatile LAS unsigned* st;
};

__device__ __forceinline__ XcdBarrier xcd_barrier_post(unsigned* bar, volatile LAS unsigned* st) {
    XcdBarrier b; b.bar = bar; b.x = xb_xcc_id(); b.st = st;
    if (threadIdx.x == 0) (void)xb_add(&bar[XB_XCNT(b.x)], 1u);
    return b;
}
__device__ __forceinline__ void xcd_barrier_complete(unsigned* bar, unsigned x, unsigned& nloc, unsigned& nx) {
    const unsigned G = gridDim.x * gridDim.y * gridDim.z;
    unsigned sum, cnt, mine, sp = 0u;
    for (;;) {
        sum = 0u; cnt = 0u; mine = 0u;
#pragma unroll
        for (unsigned j = 0; j < 16; ++j) { const unsigned c = xb_ld(&bar[XB_XCNT(j)]); sum += c; cnt += (c > 0u) ? 1u : 0u; mine = (j == x) ? c : mine; }
        if (sum == G) break;
        __builtin_amdgcn_s_sleep(1);
        if ((++sp & 255u) == 0u) { if (xb_ld(&bar[XB_TMO])) break; if (sp > XB_SPIN_CAP) { atomicAdd(&bar[XB_TMO], 1u); break; } }
    }
    nloc = mine > 0u ? mine : 1u; nx = cnt > 0u ? cnt : 1u;
}

__device__ __forceinline__ void xcd_barrier(const XcdBarrier& b) {
    asm volatile("s_waitcnt vmcnt(0)" ::: "memory");
    __syncthreads();
    if (threadIdx.x == 0) {
        unsigned* bar = b.bar;
        __builtin_amdgcn_s_waitcnt(0);
        unsigned nloc = b.st[0], nx = b.st[1];
        if (nloc == 0u) { xcd_barrier_complete(bar, b.x, nloc, nx); b.st[0] = nloc; b.st[1] = nx; }
        const unsigned old = xb_add(&bar[XB_XSUB(b.x)], 1u);
        const unsigned gen = old / nloc;
        if (old + 1u == (gen + 1u) * nloc) {
            __builtin_amdgcn_fence(__ATOMIC_RELEASE, "agent");
            asm volatile("s_waitcnt vmcnt(0)" ::: "memory");
            const unsigned og = xb_add(&bar[XB_TOP], 1u);
            const unsigned tg = og / nx;
            if (og + 1u == (tg + 1u) * nx) xb_add(&bar[XB_TOPGEN], 1u);
            else XB_SPIN(xb_ld(&bar[XB_TOPGEN]) == tg, bar);
            __builtin_amdgcn_fence(__ATOMIC_ACQUIRE, "agent");
            xb_add(&bar[XB_XGEN(b.x)], 1u);
            asm volatile("s_waitcnt vmcnt(0)" ::: "memory");
        } else {
            XB_SPIN(xb_ld(&bar[XB_XGEN(b.x)]) == gen, bar);
            __builtin_amdgcn_fence(__ATOMIC_ACQUIRE, "agent");
            asm volatile("s_waitcnt vmcnt(0)" ::: "memory");
        }
    }
    __syncthreads();
}


__global__ void __launch_bounds__(NTHREADS, 2) fwd_kernel(Args args) {
    extern __shared__ __attribute__((aligned(16))) unsigned char lds[];
    const int tid = threadIdx.x, lane = tid & 63, wave = __builtin_amdgcn_readfirstlane(tid >> 6);
    const int G = gridDim.x, bx = blockIdx.x;
    const int vcu = (G % 8 == 0) ? (bx % 8) * (G / 8) + bx / 8 : bx;
    unsigned char* ws = args.ws;
    const float* x = args.in[0];
    bf16* WinT = (bf16*)(ws + WS_WIN); bf16* WpwT = (bf16*)(ws + WS_WPW); bf16* WoT = (bf16*)(ws + WS_WO); bf16* WoutT = (bf16*)(ws + WS_WOUT); bf16* WqT = (bf16*)(ws + WS_WQ);
    unsigned char* EU = ws + WS_EU; unsigned char* EV = ws + WS_EV; float* SU = (float*)(ws + WS_ESC); float* SV = SU + NEXP; float* SSQ = SV + NEXP; bf16* SKb = (bf16*)(ws + WS_SK);
    bf16* XN = (bf16*)(ws + WS_XN); bf16* Ub = (bf16*)(ws + WS_U); bf16* MG = (bf16*)(ws + WS_MG); bf16* XG2 = (bf16*)(ws + WS_XG2);
    bf16* Gt = (bf16*)(ws + WS_G); bf16* QP = (bf16*)(ws + WS_QP);
    bf16* Qb = (bf16*)(ws + WS_Q); bf16* Kb = (bf16*)(ws + WS_K); bf16* Vb = (bf16*)(ws + WS_V);
    int* IDX = (int*)(ws + WS_IDX); float* GATE = (float*)(ws + WS_GATE);
    bf16* CA = (bf16*)(ws + WS_CA);
    LAS unsigned char* lds3 = (LAS unsigned char*)lds;
    const int lo = args.ph_lo, hi = args.ph_hi;
    volatile LAS unsigned* MISC = (volatile LAS unsigned*)(lds3 + MISC_OFF);
    if (tid < 32) MISC[tid] = 0u;
    __syncthreads();
    XcdBarrier bar_; bar_.bar = (unsigned*)(ws + WS_CTL) + CW_BAR; bar_.x = 0; bar_.st = nullptr;
    if (hi - lo > 1) bar_ = xcd_barrier_post((unsigned*)(ws + WS_CTL) + CW_BAR, MISC + 8);
#define SEAM(k) do { if (IN(k) && IN((k) + 1)) xcd_barrier(bar_); } while (0)
#ifdef ONLY_PHASE
#define IN(k) ((k) == ONLY_PHASE && lo <= (k) && (k) < hi)
#else
#define IN(k) (lo <= (k) && (k) < hi)
#endif

    if (IN(0)) {
        LAS float* scr = (LAS float*)(lds3 + wave * 16384);
        const int gw = vcu * NWAVES + wave, NGW = G * NWAVES;
        constexpr int I_IN = 16 * (IN_DIM / 32), I_SQ = 16 * 32, I_Q = 16 * 64;
        constexpr int NITEMS = I_IN + 3 * I_SQ + I_Q;
        for (int it = gw; it < NITEMS; it += NGW) {
            int r = it;
            if (r < I_IN) { const int nblk = IN_DIM / 32, kb = r / nblk, nb = r % nblk; p0_transpose_item(args.in[2], D, IN_DIM, WinT, glu_row(32 * nb), scr, kb, nb, lane); continue; } r -= I_IN;
            if (r < I_SQ) { p0_transpose_item(args.in[7], D, D, WpwT, 32 * (r % 32), scr, r / 32, r % 32, lane); continue; } r -= I_SQ;
            if (r < I_SQ) { p0_transpose_item(args.in[9], D, D, WoT, 32 * (r % 32), scr, r / 32, r % 32, lane); continue; } r -= I_SQ;
            if (r < I_SQ) { p0_transpose_item(args.in[10], D, D, WoutT, 32 * (r % 32), scr, r / 32, r % 32, lane); continue; } r -= I_SQ;
            p0_transpose_item(args.in[12], D, 2048, WqT, 32 * (r % 64), scr, r / 64, r % 64, lane, args.in[11]);
        }
        const size_t gt = (size_t)vcu * NTHREADS + tid, ngt = (size_t)G * NTHREADS;
        for (size_t i = gt; i < (size_t)M; i += ngt) SSQ[i] = 0.f;
        cvt_stream(args.in[13], SKb, (size_t)2 * NKEYS * PHALF, gt, ngt);
        for (int r = gw; r < NEXP; r += NGW) { const int tb = r >= NEXP / 2, e = 2 * (r - tb * (NEXP / 2)); rows_to_fp6(args.in[14 + tb] + (size_t)e * D, (tb ? EV : EU) + (size_t)e * E4ROW, (tb ? SV : SU) + e, lane, tb ? nullptr : args.in[11], scr); }
        for (int m = gw; m < M; m += 4 * NGW) {
            f32x4 v[4][4]; float ssr[4];
#pragma unroll
            for (int r = 0; r < 4; ++r) { const f32x4* xr = (const f32x4*)(x + (size_t)(m + r * NGW) * D) + lane;
#pragma unroll
                for (int j = 0; j < 4; ++j) v[r][j] = xr[64 * j]; }
#pragma unroll
            for (int r = 0; r < 4; ++r) { float q = 0.f;
#pragma unroll
                for (int j = 0; j < 4; ++j) q += (v[r][j][0] * v[r][j][0] + v[r][j][1] * v[r][j][1]) + (v[r][j][2] * v[r][j][2] + v[r][j][3] * v[r][j][3]);
                ssr[r] = q; }
#pragma unroll
            for (int o = 1; o < 64; o <<= 1) {
#pragma unroll
                for (int r = 0; r < 4; ++r) ssr[r] += __shfl_xor(ssr[r], o); }
#pragma unroll
            for (int r = 0; r < 4; ++r) { const float rs = 1.0f / sqrtf(ssr[r] * (1.f / 1024.f) + EPS); v2u* o8 = (v2u*)(XN + (size_t)(m + r * NGW) * D) + lane;
#pragma unroll
                for (int j = 0; j < 4; ++j) { const f32x4 gg = ((const f32x4*)args.in[1])[lane + 64 * j]; v2u o; o.x = pk2(v[r][j][0] * rs * gg[0], v[r][j][1] * rs * gg[1]); o.y = pk2(v[r][j][2] * rs * gg[2], v[r][j][3] * rs * gg[3]); o8[64 * j] = o; } }
        }
    }
    SEAM(0);
    if (IN(1)) {
        pg8::Gemm g{XN, WinT, XN, WinT, M, IN_DIM, D}; pg8::StaticOrder S; S.init(M, IN_DIM, G, bx, 1);
        EpiInProj E{Ub, Qb, Kb, Vb, Gt};
        pg8::gemm_phase<EpiInProj>(lds3, g, S, E);
    }
    SEAM(1);
    if (IN(2)) {
        conv_phase(lds3, Ub, CA, args.in[3], args.in[4], args.in[5], args.in[6], vcu, G);
        __syncthreads();
        att::attn_phase(lds3, Qb, Kb, Vb, Qb, args.in[8], vcu, G);
    }
    SEAM(2);
    if (IN(3)) {
        pg8::Gemm g{CA, WpwT, Qb, WoT, M, D, D}; pg8::StaticOrder S; S.init(M, D, G, bx, 2);
        EpiMerge E{Gt, MG};
        pg8::gemm_phase<EpiMerge>(lds3, g, S, E);
    }
    SEAM(3);
    if (IN(4)) {
        pg8::Gemm g{MG, WoutT, MG, WoutT, M, D, D}; pg8::StaticOrder S; S.init(M, D, G, bx, 1);
        EpiResid E{x, XG2, SSQ};
        pg8::gemm_phase<EpiResid>(lds3, g, S, E);
    }
    SEAM(4);
    if (IN(5)) {
        pg8::Gemm g{XG2, WqT, XG2, WqT, M, 2048, D}; pg8::StaticOrder S; S.init(M, 2048, G, bx, 1);
        EpiBf16Rs E{QP, SSQ};
        pg8::gemm_phase<EpiBf16Rs>(lds3, g, S, E);
    }
    SEAM(5);
    if (IN(6)) tk::topk_phase(lds3, QP, SKb, IDX, GATE, vcu, G);
    SEAM(6);
    if (IN(7)) gather_phase(lds3, XG2, SSQ, EU, EV, SU, SV, IDX, GATE, GATE, args.in[16], args.out, vcu, G);
#undef IN
#undef SEAM
}

extern "C" void kernel_launch(void* const* d_in, const int* in_sizes, int n_in, void* d_out, int out_size, void* d_ws, size_t ws_size, hipStream_t stream) {
    static int grid = 0;
    if (grid == 0) {
        if (n_in != 17 || in_sizes[0] != M * D || out_size != M * D || ws_size < WS_END) { fprintf(stderr, "kernel_launch: unexpected shapes (n_in %d, in0 %d, out %d, ws %zu)\n", n_in, n_in > 0 ? in_sizes[0] : -1, out_size, ws_size); grid = -1; return; }
        int dev = 0, cus = 0;
        if (hipGetDevice(&dev) != hipSuccess || hipDeviceGetAttribute(&cus, hipDeviceAttributeMultiprocessorCount, dev) != hipSuccess) { grid = -1; return; }
        if (hipFuncSetAttribute((const void*)fwd_kernel, hipFuncAttributeMaxDynamicSharedMemorySize, LDS_BYTES) != hipSuccess) { fprintf(stderr, "kernel_launch: hipFuncSetAttribute failed\n"); grid = -1; return; }
        int per_cu = 0;
        if (hipOccupancyMaxActiveBlocksPerMultiprocessor(&per_cu, (const void*)fwd_kernel, NTHREADS, LDS_BYTES) != hipSuccess || per_cu < 1) { fprintf(stderr, "kernel_launch: occupancy query says %d\n", per_cu); }
        (void)hipGetLastError();
        grid = cus;
    }
    if (grid < 0) return;
    Args a{};
    for (int i = 0; i < 17; ++i) a.in[i] = (const float*)d_in[i];
    a.out = (float*)d_out; a.ws = (unsigned char*)d_ws;
    if (MK_N_LAUNCHES == 1) {
        a.ph_lo = 0; a.ph_hi = 8;
        if (hipMemsetAsync((char*)d_ws + WS_CTL, 0, CTL_ZERO_BYTES, stream) != hipSuccess) { fprintf(stderr, "kernel_launch: memset failed\n"); return; }
        hipLaunchKernelGGL(fwd_kernel, dim3(grid), dim3(NTHREADS), LDS_BYTES, stream, a);
    } else {
        for (int p = 0; p < 8; ++p) {
            a.ph_lo = p; a.ph_hi = p + 1;
            hipLaunchKernelGGL(fwd_kernel, dim3(grid), dim3(NTHREADS), LDS_BYTES, stream, a);
        }
    }
}
```
